# Optimizing an MI355X kernel written in HIP

```python
import math
import jax
import jax.numpy as jnp
from jax import lax
import numpy as np

D_MODEL = 1024
BATCH = 8
SEQ = 2048
DEPTH = 2

CHUNK = 64
Q_BLOCK = 128
RMS_EPS = 1e-6
MAX_POS_OFFSET = 4096

MIX_WIDTH = D_MODEL
GROUP_WIDTH = MIX_WIDTH // 4

CONV_A_WIDTH = 3
A_COLS = 3 * GROUP_WIDTH

FOX_HEAD_DIM = 64
FOX_HEADS = GROUP_WIDTH // FOX_HEAD_DIM
B_COLS = 3 * GROUP_WIDTH + FOX_HEADS

SSM_INNER = GROUP_WIDTH
SSM_HEAD_DIM = 64
SSM_HEADS = SSM_INNER // SSM_HEAD_DIM
SSM_GROUPS = 2
SSM_HEADS_PER_GROUP = SSM_HEADS // SSM_GROUPS
SSM_STATE = 64
SSM_CONV = 4
SSM_CONV_DIM = SSM_INNER + 2 * SSM_GROUPS * SSM_STATE
C_COLS = SSM_INNER + SSM_CONV_DIM + SSM_HEADS

MLA_HEADS = 4
MLA_NOPE = 64
MLA_ROPE = 32
MLA_V = GROUP_WIDTH // MLA_HEADS
MLA_Q_LORA = 256
MLA_KV_LORA = 128
ROPE_BASE = 10000.0
D_COLS = MLA_Q_LORA + MLA_KV_LORA + MLA_ROPE

IN_COLS = A_COLS + B_COLS + C_COLS + D_COLS
MIX_SPLITS = [A_COLS, A_COLS + B_COLS, A_COLS + B_COLS + C_COLS]

N_EXPERT_GROUPS = 4
EXPERTS_PER_GROUP = 8
N_EXPERTS = N_EXPERT_GROUPS * EXPERTS_PER_GROUP
TOP_K = 2
EXPERT_FF = 256
MOE_BLOCK = 128

kernel_name = "hybrid_chunk_causal_block"


def rms_norm(x, g):
    xf = x.astype(jnp.float32)
    y = xf * lax.rsqrt(jnp.mean(xf * xf, axis=-1, keepdims=True) + RMS_EPS)
    return (y * g.astype(jnp.float32)).astype(x.dtype)


def causal_depthwise_conv(x, w):
    k, c = w.shape
    return lax.conv_general_dilated(
        x, w.astype(x.dtype)[:, None, :], window_strides=(1,), padding=[(k - 1, 0)],
        dimension_numbers=('NWC', 'WIO', 'NWC'), feature_group_count=c)


def split_heads(t, n):
    b, s, _ = t.shape
    return t.reshape(b, s, n, -1).transpose(0, 2, 1, 3)


def merge_heads(t):
    b, h, s, d = t.shape
    return t.transpose(0, 2, 1, 3).reshape(b, s, h * d)


def frame_causal(tq, tk):
    return tk <= tq


def chunk_causal(tq, tk):
    return (tk // CHUNK) <= (tq // CHUNK)


def block_attention(q, k, v, allowed, log_decay=None):
    seq = q.shape[2]
    scale = q.shape[-1] ** -0.5
    outs = []
    for i in range(seq // Q_BLOCK):
        q0, q1 = i * Q_BLOCK, (i + 1) * Q_BLOCK
        s = jnp.einsum('bhqd,bhkd->bhqk', q[:, :, q0:q1], k[:, :, :q1]).astype(jnp.float32) * scale
        if log_decay is not None:
            s = s + (log_decay[:, :, q0:q1, None] - log_decay[:, :, None, :q1])
        tq = jnp.arange(q0, q1)[:, None]
        tk = jnp.arange(q1)[None, :]
        s = jnp.where(allowed(tq, tk), s, -jnp.inf)
        p = jax.nn.softmax(s, axis=-1).astype(v.dtype)
        outs.append(jnp.einsum('bhqk,bhkd->bhqd', p, v[:, :, :q1]))
    return jnp.concatenate(outs, axis=2)


def short_conv_mixer(p, conv_w):
    b_gate, c_gate, val = jnp.split(p, 3, axis=-1)
    return b_gate * causal_depthwise_conv(c_gate * val, conv_w)


def forgetting_attention(p, forget_bias):
    q, k, v, f_logit = jnp.split(p, [GROUP_WIDTH, 2 * GROUP_WIDTH, 3 * GROUP_WIDTH], axis=-1)
    log_f = jax.nn.log_sigmoid((f_logit + forget_bias).astype(jnp.float32))
    cum = jnp.cumsum(log_f, axis=1).transpose(0, 2, 1)
    out = block_attention(split_heads(q, FOX_HEADS), split_heads(k, FOX_HEADS),
                          split_heads(v, FOX_HEADS), frame_causal, cum)
    return merge_heads(out)


def segsum(a):
    t = a.shape[-1]
    ae = jnp.broadcast_to(a[..., None], a.shape + (t,))
    ae = jnp.where(jnp.tril(jnp.ones((t, t), bool), -1), ae, 0.0)
    ss = jnp.cumsum(ae, axis=-2)
    return jnp.where(jnp.tril(jnp.ones((t, t), bool), 0), ss, -jnp.inf)


def ssd_chunked(x, a, b, c):
    bsz, seq, h, pdim = x.shape
    n = b.shape[-1]
    nc = seq // CHUNK
    x = x.reshape(bsz, nc, CHUNK, h, pdim).astype(jnp.float32)
    b = b.reshape(bsz, nc, CHUNK, h, n).astype(jnp.float32)
    c = c.reshape(bsz, nc, CHUNK, h, n).astype(jnp.float32)
    a = a.reshape(bsz, nc, CHUNK, h).astype(jnp.float32).transpose(0, 3, 1, 2)
    a_cum = jnp.cumsum(a, axis=-1)
    decay_in = jnp.exp(segsum(a))
    y_diag = jnp.einsum('bclhn,bcshn,bhcls,bcshp->bclhp', c, b, decay_in, x)
    decay_states = jnp.exp(a_cum[..., -1:] - a_cum)
    states = jnp.einsum('bclhn,bhcl,bclhp->bchpn', b, decay_states, x)
    chunk_decay = jnp.exp(a_cum[..., -1])

    def step(carry, inp):
        st, dec = inp
        return carry * dec[..., None, None] + st, carry

    init = jnp.zeros((bsz, h, pdim, n), jnp.float32)
    _, prev = lax.scan(step, init, (states.transpose(1, 0, 2, 3, 4), chunk_decay.transpose(2, 0, 1)))
    prev = prev.transpose(1, 0, 2, 3, 4)
    y_off = jnp.einsum('bclhn,bchpn,bhcl->bclhp', c, prev, jnp.exp(a_cum))
    return (y_diag + y_off).reshape(bsz, seq, h, pdim)


def ssd_mixer(p, conv_w, conv_b, dt_bias, a_log, d_skip, norm_g):
    z, xbc, dt_raw = jnp.split(p, [SSM_INNER, SSM_INNER + SSM_CONV_DIM], axis=-1)
    xbc = jax.nn.silu(causal_depthwise_conv(xbc, conv_w) + conv_b)
    xs, bs, cs = jnp.split(xbc, [SSM_INNER, SSM_INNER + SSM_GROUPS * SSM_STATE], axis=-1)
    bsz, seq, _ = p.shape
    xs = xs.reshape(bsz, seq, SSM_HEADS, SSM_HEAD_DIM)
    bs = jnp.repeat(bs.reshape(bsz, seq, SSM_GROUPS, SSM_STATE), SSM_HEADS_PER_GROUP, axis=2)
    cs = jnp.repeat(cs.reshape(bsz, seq, SSM_GROUPS, SSM_STATE), SSM_HEADS_PER_GROUP, axis=2)
    dt = jax.nn.softplus((dt_raw + dt_bias).astype(jnp.float32))
    a = -jnp.exp(a_log.astype(jnp.float32))
    y = ssd_chunked(xs * dt[..., None], dt * a, bs, cs)
    y = y + d_skip.astype(jnp.float32)[:, None] * xs.astype(jnp.float32)
    y = y.reshape(bsz, seq, SSM_INNER).astype(p.dtype) * jax.nn.silu(z)
    return rms_norm(y, norm_g)


def rotary_cos_sin(positions, dim):
    inv_freq = ROPE_BASE ** (-jnp.arange(0, dim, 2, dtype=jnp.float32) / dim)
    ang = positions.astype(jnp.float32)[..., None] * inv_freq
    return jnp.cos(ang), jnp.sin(ang)


def apply_rotary(x, cos, sin):
    half = x.shape[-1] // 2
    xf = x.astype(jnp.float32)
    x1, x2 = xf[..., :half], xf[..., half:]
    return jnp.concatenate([x1 * cos - x2 * sin, x2 * cos + x1 * sin], axis=-1).astype(x.dtype)


def latent_attention(p, positions, q_norm, kv_norm, w_uq, w_ukv):
    bsz, seq, _ = p.shape
    c_q, c_kv, k_rope = jnp.split(p, [MLA_Q_LORA, MLA_Q_LORA + MLA_KV_LORA], axis=-1)
    q = (rms_norm(c_q, q_norm) @ w_uq).reshape(bsz, seq, MLA_HEADS, MLA_NOPE + MLA_ROPE)
    kv = (rms_norm(c_kv, kv_norm) @ w_ukv).reshape(bsz, seq, MLA_HEADS, MLA_NOPE + MLA_V)
    q_nope, q_rope = jnp.split(q, [MLA_NOPE], axis=-1)
    k_nope, v = jnp.split(kv, [MLA_NOPE], axis=-1)
    cos, sin = rotary_cos_sin(positions, MLA_ROPE)
    q_rope = apply_rotary(q_rope, cos[:, :, None, :], sin[:, :, None, :])
    k_rope = apply_rotary(k_rope, cos, sin)
    q = jnp.concatenate([q_nope, q_rope], axis=-1).transpose(0, 2, 1, 3)
    k = jnp.concatenate([k_nope, jnp.broadcast_to(k_rope[:, :, None, :], (bsz, seq, MLA_HEADS, MLA_ROPE))],
                        axis=-1).transpose(0, 2, 1, 3)
    out = block_attention(q, k, v.transpose(0, 2, 1, 3), chunk_causal)
    return merge_heads(out)


def grouped_expert_ffn(xf, expert_idx, weights, w_gate, w_up, w_down):
    t, d = xf.shape
    n_exp = w_gate.shape[0]
    n_slots = expert_idx.size
    n_blocks = -(-(n_slots + n_exp * (MOE_BLOCK - 1)) // MOE_BLOCK)
    n_rows = n_blocks * MOE_BLOCK
    flat_e = expert_idx.reshape(-1)
    flat_w = weights.reshape(-1)
    order = jnp.argsort(flat_e)
    sorted_e = flat_e[order]
    counts = jnp.zeros((n_exp,), jnp.int32).at[flat_e].add(1)
    padded = (counts + MOE_BLOCK - 1) // MOE_BLOCK * MOE_BLOCK
    start = jnp.cumsum(counts) - counts
    padded_end = jnp.cumsum(padded)
    padded_start = padded_end - padded
    dest = padded_start[sorted_e] + jnp.arange(n_slots, dtype=jnp.int32) - start[sorted_e]
    row_token = jnp.full((n_rows,), t, jnp.int32).at[dest].set((order // TOP_K).astype(jnp.int32))
    row_w = jnp.zeros((n_rows,), xf.dtype).at[dest].set(flat_w[order])
    block_expert = jnp.minimum(
        jnp.searchsorted(padded_end, jnp.arange(n_blocks, dtype=jnp.int32) * MOE_BLOCK, side='right'),
        n_exp - 1)
    x_rows = jnp.concatenate([xf, jnp.zeros((1, d), xf.dtype)], axis=0)[row_token]
    x_rows = x_rows.reshape(n_blocks, MOE_BLOCK, d)

    def expert_block(args):
        xb, e = args
        return (jax.nn.silu(xb @ w_gate[e]) * (xb @ w_up[e])) @ w_down[e]

    y_rows = lax.map(expert_block, (x_rows, block_expert)).reshape(n_rows, d)
    return jax.ops.segment_sum(y_rows * row_w[:, None], row_token, num_segments=t + 1)[:t]


def hierarchical_moe(h, rg_w, rg_b, re_w, re_b, w_gate, w_up, w_down):
    bsz, seq, d = h.shape
    t = bsz * seq
    xf = h.reshape(t, d)
    g_prob = jax.nn.softmax((xf @ rg_w + rg_b).astype(jnp.float32), axis=-1)
    g_w, g_idx = lax.top_k(g_prob, 1)
    e_logits = (xf @ re_w + re_b).astype(jnp.float32).reshape(t, N_EXPERT_GROUPS, EXPERTS_PER_GROUP)
    e_logits = jnp.take_along_axis(e_logits, g_idx[:, :, None], axis=1)[:, 0]
    e_prob = jax.nn.softmax(e_logits, axis=-1)
    e_w, e_local = lax.top_k(e_prob, TOP_K)
    e_w = e_w / jnp.sum(e_w, axis=-1, keepdims=True)
    weights = (g_w * e_w).astype(h.dtype)
    expert_idx = g_idx * EXPERTS_PER_GROUP + e_local
    y = grouped_expert_ffn(xf, expert_idx, weights, w_gate, w_up, w_down)
    return y.reshape(bsz, seq, d)


def setup_inputs(seed: int = 0) -> dict:
    key = jax.random.key(seed)
    ks = jax.random.split(key, 28)
    f32 = jnp.float32

    def nrm(k, shape, fan_in):
        return jax.random.normal(k, shape, f32) * fan_in ** -0.5

    def gain(k, shape):
        return 1.0 + 0.02 * jax.random.normal(k, shape, f32)

    x = jax.random.normal(ks[0], (BATCH, SEQ, D_MODEL), f32)
    offsets = jax.random.randint(ks[1], (BATCH, 1), 0, MAX_POS_OFFSET, jnp.int32)
    positions = offsets + jnp.arange(SEQ, dtype=jnp.int32)[None, :]
    dt_init = jnp.exp(jax.random.uniform(ks[9], (DEPTH, SSM_HEADS), f32, math.log(1e-3), math.log(1e-1)))
    return {
        'x': x,
        'positions': positions,
        'norm_mix': gain(ks[2], (DEPTH, D_MODEL)),
        'w_in': nrm(ks[3], (DEPTH, D_MODEL, IN_COLS), D_MODEL),
        'conv_a': nrm(ks[4], (DEPTH, CONV_A_WIDTH, GROUP_WIDTH), CONV_A_WIDTH),
        'fox_forget_bias': jax.random.uniform(ks[5], (DEPTH, FOX_HEADS), f32, 1.0, 4.0),
        'ssm_conv_w': nrm(ks[6], (DEPTH, SSM_CONV, SSM_CONV_DIM), SSM_CONV),
        'ssm_conv_b': 0.02 * jax.random.normal(ks[7], (DEPTH, SSM_CONV_DIM), f32),
        'ssm_dt_bias': dt_init + jnp.log(-jnp.expm1(-dt_init)),
        'ssm_a_log': jnp.log(jax.random.uniform(ks[10], (DEPTH, SSM_HEADS), f32, 1.0, 16.0)),
        'ssm_d': 1.0 + 0.1 * jax.random.normal(ks[11], (DEPTH, SSM_HEADS), f32),
        'ssm_norm': gain(ks[12], (DEPTH, SSM_INNER)),
        'mla_q_norm': gain(ks[13], (DEPTH, MLA_Q_LORA)),
        'mla_kv_norm': gain(ks[14], (DEPTH, MLA_KV_LORA)),
        'mla_w_uq': nrm(ks[15], (DEPTH, MLA_Q_LORA, MLA_HEADS * (MLA_NOPE + MLA_ROPE)), MLA_Q_LORA),
        'mla_w_ukv': nrm(ks[16], (DEPTH, MLA_KV_LORA, MLA_HEADS * (MLA_NOPE + MLA_V)), MLA_KV_LORA),
        'w_out': nrm(ks[17], (DEPTH, MIX_WIDTH, D_MODEL), MIX_WIDTH),
        'norm_ffn': gain(ks[18], (DEPTH, D_MODEL)),
        'router_group_w': nrm(ks[19], (DEPTH, D_MODEL, N_EXPERT_GROUPS), D_MODEL),
        'router_group_b': 0.01 * jax.random.normal(ks[20], (DEPTH, N_EXPERT_GROUPS), f32),
        'router_expert_w': nrm(ks[21], (DEPTH, D_MODEL, N_EXPERTS), D_MODEL),
        'router_expert_b': 0.01 * jax.random.normal(ks[22], (DEPTH, N_EXPERTS), f32),
        'expert_w_gate': nrm(ks[23], (DEPTH, N_EXPERTS, D_MODEL, EXPERT_FF), D_MODEL),
        'expert_w_up': nrm(ks[24], (DEPTH, N_EXPERTS, D_MODEL, EXPERT_FF), D_MODEL),
        'expert_w_down': nrm(ks[25], (DEPTH, N_EXPERTS, EXPERT_FF, D_MODEL), EXPERT_FF),
        'norm_final': gain(ks[26], (D_MODEL,)),
    }


def reference(x, positions, norm_mix, w_in, conv_a, fox_forget_bias, ssm_conv_w, ssm_conv_b,
              ssm_dt_bias, ssm_a_log, ssm_d, ssm_norm, mla_q_norm, mla_kv_norm, mla_w_uq, mla_w_ukv,
              w_out, norm_ffn, router_group_w, router_group_b, router_expert_w, router_expert_b,
              expert_w_gate, expert_w_up, expert_w_down, norm_final):
    for l in range(DEPTH):
        h = rms_norm(x, norm_mix[l])
        proj = h @ w_in[l]
        p_a, p_b, p_c, p_d = jnp.split(proj, MIX_SPLITS, axis=-1)
        y = jnp.concatenate([
            short_conv_mixer(p_a, conv_a[l]),
            forgetting_attention(p_b, fox_forget_bias[l]),
            ssd_mixer(p_c, ssm_conv_w[l], ssm_conv_b[l], ssm_dt_bias[l], ssm_a_log[l], ssm_d[l], ssm_norm[l]),
            latent_attention(p_d, positions, mla_q_norm[l], mla_kv_norm[l], mla_w_uq[l], mla_w_ukv[l]),
        ], axis=-1)
        x = x + y @ w_out[l]
        h = rms_norm(x, norm_ffn[l])
        x = x + hierarchical_moe(h, router_group_w[l], router_group_b[l], router_expert_w[l],
                                 router_expert_b[l], expert_w_gate[l], expert_w_up[l], expert_w_down[l])
    return rms_norm(x, norm_final)
```

```cpp
#include <hip/hip_runtime.h>
#include <cstdio>
#include <cstdint>
#include <cmath>
#define GAS __attribute__((address_space(1)))
#define LAS __attribute__((address_space(3)))
namespace pg8 {
#define PG8_LAS __attribute__((address_space(3)))
typedef unsigned short bf16_t;
typedef short bf16x8 __attribute__((ext_vector_type(8)));
typedef float f32x4 __attribute__((ext_vector_type(4)));
typedef unsigned u32x4 __attribute__((ext_vector_type(4)));
constexpr int BM = 256, BK = 64, HALF = 128, HTB = HALF * BK * 2  , STAGE_BYTES = 8 * HTB, NXCD = 8, WGM = 8;

__host__ __device__ __forceinline__ int lds_byte(int r, int c) { const int st = (r >> 4) * 2 + (c >> 5), rr = r & 15, cc = c & 31, ob = rr * 64 + cc * 2; return st * 1024 + (ob ^ (((ob >> 9) & 1) << 5)); }
__host__ __device__ __forceinline__ void stage_rc(int b, int& R, int& C) { const int st = b / 1024, sb = b % 1024, swz = sb ^ (((sb >> 9) & 1) << 5); R = (st >> 1) * 16 + swz / 64; C = (st & 1) * 32 + (swz % 64) / 2; }
__host__ __device__ __forceinline__ int perm32(int rho) { const int n = rho >> 4, i = rho & 15; return 8 * (i >> 2) + 4 * n + (i & 3); }

struct Unit { int pm, pn, e, r0, ne; };
struct Gemm { const bf16_t* A; const bf16_t* Bt; int M, N, K; };

struct StaticOrder {
    int nM, nN, nwg, G, c;
    __host__ __device__ void init(int M, int N, int G_, int c_) { nM = M / BM; nN = N / BM; nwg = nM * nN; G = G_; c = c_; }
    __host__ __device__ bool next(int i, Unit& u) const {
        const long L = (long)i * G + c; if (L >= nwg) return false;
        int wgid = (int)L; { const int q = nwg / NXCD, r = nwg % NXCD, xcd = wgid % NXCD, off = wgid / NXCD; wgid = (xcd < r ? xcd * (q + 1) : r * (q + 1) + (xcd - r) * q) + off; }
        const int nig = WGM * nN, gid = wgid / nig, fm = gid * WGM, gsz = (nM - fm) < WGM ? (nM - fm) : WGM;
        u.pm = fm + ((wgid % nig) % gsz); u.pn = (wgid % nig) / gsz; return true;
    }
    __device__ __forceinline__ void a_ready(const Unit&) const {}
    __device__ __forceinline__ void done(const Unit&) const {}
};

__device__ __forceinline__ unsigned cvt_pk_bf16(float lo, float hi) { unsigned r; asm volatile("v_cvt_pk_bf16_f32 %0, %1, %2" : "=v"(r) : "v"(lo), "v"(hi)); return r; }

struct EpiInProj {
    static constexpr bool PERM = true, AFTER_DRAIN = false;
    bf16_t* O; int ldc; const float* rstd; float* FD; int fd_pn;
    __device__ __forceinline__ void operator()(const f32x4 (&acc)[2][2][4][2], const Unit& u, int wr, int wc, int fr, int fq) const {
        const int row0 = u.pm * BM + wr * 64 + fr; const int col0 = u.pn * BM + wc * 32 + 8 * fq;
        const bool fdl = (u.pn == fd_pn) && (wc == 1) && (fq == 0);
#pragma unroll
        for (int ai = 0; ai < 2; ++ai)
#pragma unroll
            for (int m = 0; m < 4; ++m) { const int row = row0 + ai * HALF + m * 16; const float rs = rstd[row]; bf16_t* rowp = O + (size_t)row * ldc + col0;
#pragma unroll
                for (int bj = 0; bj < 2; ++bj) { const f32x4 v0 = acc[ai][bj][m][0] * rs, v1 = acc[ai][bj][m][1] * rs;
                    u32x4 w; w.x = cvt_pk_bf16(v0[0], v0[1]); w.y = cvt_pk_bf16(v0[2], v0[3]); w.z = cvt_pk_bf16(v1[0], v1[1]); w.w = cvt_pk_bf16(v1[2], v1[3]);
                    *(u32x4*)(rowp + bj * HALF) = w;
                    if (bj == 1 && fdl) { *(f32x4*)(FD + (size_t)row * 8) = v0; *(f32x4*)(FD + (size_t)row * 8 + 4) = v1; } } }
    }
};
struct EpiResid {
    static constexpr bool PERM = false, AFTER_DRAIN = false;
    const float* base; float* out; int ldc;
    __device__ __forceinline__ void operator()(const f32x4 (&acc)[2][2][4][2], const Unit& u, int wr, int wc, int fr, int fq) const {
        const int row0 = u.pm * BM + wr * 64 + fr; const int col0 = u.pn * BM + wc * 32 + 4 * fq;
#pragma unroll
        for (int ai = 0; ai < 2; ++ai)
#pragma unroll
            for (int m = 0; m < 4; ++m) { const size_t off = (size_t)(row0 + ai * HALF + m * 16) * ldc + col0;
#pragma unroll
                for (int bj = 0; bj < 2; ++bj)
#pragma unroll
                    for (int n = 0; n < 2; ++n) { const f32x4 b = *(const f32x4*)(base + off + bj * HALF + n * 16); *(f32x4*)(out + off + bj * HALF + n * 16) = b + acc[ai][bj][m][n]; } }
    }
};
struct EpiGateUp {
    static constexpr bool PERM = true, AFTER_DRAIN = false;
    bf16_t* O; int ldc;
    __device__ __forceinline__ void operator()(const f32x4 (&acc)[2][2][4][2], const Unit& u, int wr, int wc, int fr, int fq) const {
        const int row0 = u.pm * BM + wr * 64 + fr; const int col0 = (u.pn & 1) * HALF + wc * 32 + 8 * fq;
#pragma unroll
        for (int ai = 0; ai < 2; ++ai)
#pragma unroll
            for (int m = 0; m < 4; ++m) { bf16_t* rowp = O + (size_t)(row0 + ai * HALF + m * 16) * ldc + col0; float h[8];
#pragma unroll
                for (int n = 0; n < 2; ++n)
#pragma unroll
                    for (int j = 0; j < 4; ++j) { const float gt = acc[ai][0][m][n][j], up = acc[ai][1][m][n][j]; h[n * 4 + j] = gt * up / (1.0f + __expf(-gt)); }
                u32x4 w; w.x = cvt_pk_bf16(h[0], h[1]); w.y = cvt_pk_bf16(h[2], h[3]); w.z = cvt_pk_bf16(h[4], h[5]); w.w = cvt_pk_bf16(h[6], h[7]);
                *(u32x4*)rowp = w; }
    }
};
struct EpiSlotY {
    static constexpr bool PERM = true, AFTER_DRAIN = false;
    bf16_t* O; int ldc;
    __device__ __forceinline__ void operator()(const f32x4 (&acc)[2][2][4][2], const Unit& u, int wr, int wc, int fr, int fq) const {
        const int row0 = u.pm * BM + wr * 64 + fr; const int col0 = (u.pn & 3) * BM + wc * 32 + 8 * fq;
#pragma unroll
        for (int ai = 0; ai < 2; ++ai)
#pragma unroll
            for (int m = 0; m < 4; ++m) { bf16_t* rowp = O + (size_t)(row0 + ai * HALF + m * 16) * ldc + col0;
#pragma unroll
                for (int bj = 0; bj < 2; ++bj) { const f32x4 v0 = acc[ai][bj][m][0], v1 = acc[ai][bj][m][1];
                    u32x4 w; w.x = cvt_pk_bf16(v0[0], v0[1]); w.y = cvt_pk_bf16(v0[2], v0[3]); w.z = cvt_pk_bf16(v1[0], v1[1]); w.w = cvt_pk_bf16(v1[2], v1[3]);
                    *(u32x4*)(rowp + bj * HALF) = w; } }
    }
};

template <class Epi, class Sched, bool ALIGN_EPI = false, bool SP2 = false>
__device__ __forceinline__ void gemm_phase(PG8_LAS unsigned char* lds, const Gemm g, const Sched& S, const Epi& E) {
    int tid_ = threadIdx.x; asm volatile("" : "+v"(tid_));
    const int tid = tid_, wid = __builtin_amdgcn_readfirstlane(tid >> 6), lane = tid & 63, wr = wid >> 2, wc = wid & 3, fr = lane & 15, fq = lane >> 4;
    const int K = g.K, nt = K / BK;
    unsigned voffA[2], voffB[2];
#pragma unroll
    for (int i = 0; i < 2; ++i) { int R, C; stage_rc(tid * 16 + i * 8192, R, C); const int Rb = Epi::PERM ? ((R & ~31) + perm32(R & 31)) : R;
        voffA[i] = (unsigned)(R * K + C) * 2u; voffB[i] = (unsigned)(Rb * K + C) * 2u; }
    const size_t kstep = (size_t)(BK * 2);
    const size_t hstep = (size_t)HALF * K * 2;
    const size_t tstep = 2 * hstep;
    const unsigned ldsw = (unsigned)wid * 1024u;
    const int aoff = lds_byte(wr * 64 + fr, fq * 8), boff = lds_byte(wc * 32 + fr, fq * 8);
#define PG8_SA(b, h) (((b) * 2 + (h)) * HTB)
#define PG8_SB(b, h) ((4 + (b) * 2 + (h)) * HTB)
#define PG8_STAGE(bufoff, gbase, voff) do { _Pragma("unroll") for (int _i = 0; _i < 2; ++_i) \
        __builtin_amdgcn_global_load_lds((const unsigned*)((const char*)(gbase) + (voff)[_i]), (PG8_LAS unsigned*)(lds + (bufoff) + ldsw + _i * 8192), 16, 0, 0); } while (0)
#define PG8_LDA(dst, b, h) do { _Pragma("unroll") for (int m = 0; m < 4; ++m) _Pragma("unroll") for (int k = 0; k < 2; ++k) dst[m][k] = *(const PG8_LAS bf16x8*)(lds + PG8_SA(b, h) + aoff + m * 2048 + k * 1024); } while (0)
#define PG8_LDB(dst, b, h) do { _Pragma("unroll") for (int n = 0; n < 2; ++n) _Pragma("unroll") for (int k = 0; k < 2; ++k) dst[n][k] = *(const PG8_LAS bf16x8*)(lds + PG8_SB(b, h) + boff + n * 2048 + k * 1024); } while (0)
#define PG8_MMA(ai, bj, At, Bt) do { __builtin_amdgcn_s_setprio(1); _Pragma("unroll") for (int m = 0; m < 4; ++m) _Pragma("unroll") for (int n = 0; n < 2; ++n) _Pragma("unroll") for (int k = 0; k < 2; ++k) \
        acc[ai][bj][m][n] = __builtin_amdgcn_mfma_f32_16x16x32_bf16(Bt[n][k], At[m][k], acc[ai][bj][m][n], 0, 0, 0); __builtin_amdgcn_s_setprio(0); } while (0)
#define PG8_WAIT_V(n) asm volatile("s_waitcnt vmcnt(" #n ")" ::: "memory")
#define PG8_WAIT_L(n) asm volatile("s_waitcnt lgkmcnt(" #n ")" ::: "memory")
#define PG8_BAR __builtin_amdgcn_s_barrier()
#define PG8_SCHED __builtin_amdgcn_sched_barrier(0)
    Unit cur, nxt; int ui = 0;
    if (!S.next(0, cur)) return;
    f32x4 acc[2][2][4][2];
#pragma unroll
    for (int a = 0; a < 2; ++a)
#pragma unroll
        for (int b = 0; b < 2; ++b)
#pragma unroll
            for (int m = 0; m < 4; ++m)
#pragma unroll
                for (int n = 0; n < 2; ++n) acc[a][b][m][n] = (f32x4){0.f, 0.f, 0.f, 0.f};
    bf16x8 At[4][2], B0[2][2], B1[2][2];
    const char* cA = (const char*)g.A + (size_t)cur.pm * tstep; const char* cB = (const char*)g.Bt + (size_t)cur.pn * tstep;
    S.a_ready(cur);
    if constexpr (SP2) {
        PG8_STAGE(PG8_SB(0, 0), cB, voffB); PG8_STAGE(PG8_SB(0, 1), cB + hstep, voffB); PG8_STAGE(PG8_SA(0, 0), cA, voffA); PG8_STAGE(PG8_SA(0, 1), cA + hstep, voffA);
        if (wr == 1) PG8_BAR;
        PG8_WAIT_V(2); PG8_BAR;
        PG8_STAGE(PG8_SB(1, 0), cB + kstep, voffB); PG8_STAGE(PG8_SA(1, 0), cA + kstep, voffA); PG8_STAGE(PG8_SB(1, 1), cB + hstep + kstep, voffB);
        PG8_WAIT_V(6); PG8_BAR;
    } else {
        PG8_STAGE(PG8_SB(0, 0), cB, voffB); PG8_STAGE(PG8_SA(0, 0), cA, voffA); PG8_STAGE(PG8_SB(0, 1), cB + hstep, voffB); PG8_STAGE(PG8_SA(0, 1), cA + hstep, voffA);
        if (wr == 1) PG8_BAR;
        PG8_WAIT_V(4); PG8_BAR;
        PG8_STAGE(PG8_SB(1, 0), cB + kstep, voffB); PG8_STAGE(PG8_SA(1, 0), cA + kstep, voffA); PG8_STAGE(PG8_SB(1, 1), cB + hstep + kstep, voffB);
        PG8_WAIT_V(6); PG8_BAR;
    }
    for (;;) {
        const bool has_next = S.next(ui + 1, nxt);
        const char* nA = has_next ? (const char*)g.A + (size_t)nxt.pm * tstep : cA; const char* nB = has_next ? (const char*)g.Bt + (size_t)nxt.pn * tstep : cB;
        for (int t = 0; t < nt; t += 2) {
            const bool last = (t == nt - 2);
            const char* a1 = cA + (size_t)(t + 1) * kstep;
            const char* a2 = last ? nA : cA + (size_t)(t + 2) * kstep; const char* b2 = last ? nB : cB + (size_t)(t + 2) * kstep;
            const char* a3 = a2 + kstep; const char* b3 = b2 + kstep;
            if (last && has_next) S.a_ready(nxt);
            if constexpr (SP2) {
            PG8_LDB(B0, 0, 0); PG8_LDB(B1, 0, 1); PG8_SCHED; PG8_LDA(At, 0, 0); PG8_STAGE(PG8_SA(1, 1), a1 + hstep, voffA);
            PG8_WAIT_V(8); PG8_WAIT_L(0); PG8_BAR; PG8_MMA(0, 0, At, B0); PG8_MMA(0, 1, At, B1); PG8_BAR; PG8_SCHED;
            PG8_LDA(At, 0, 1); PG8_STAGE(PG8_SB(0, 0), b2, voffB); PG8_STAGE(PG8_SB(0, 1), b2 + hstep, voffB); PG8_STAGE(PG8_SA(0, 0), a2, voffA);
            PG8_WAIT_V(8); PG8_WAIT_L(0); PG8_BAR; PG8_MMA(1, 0, At, B0); PG8_MMA(1, 1, At, B1); PG8_BAR; PG8_SCHED;
            PG8_LDB(B0, 1, 0); PG8_LDB(B1, 1, 1); PG8_SCHED; PG8_LDA(At, 1, 0); PG8_STAGE(PG8_SA(0, 1), a2 + hstep, voffA);
            PG8_WAIT_V(8); PG8_WAIT_L(0); PG8_BAR; PG8_MMA(0, 0, At, B0); PG8_MMA(0, 1, At, B1); PG8_BAR; PG8_SCHED;
            PG8_LDA(At, 1, 1); PG8_STAGE(PG8_SB(1, 0), b3, voffB); PG8_STAGE(PG8_SB(1, 1), b3 + hstep, voffB); PG8_STAGE(PG8_SA(1, 0), a3, voffA);
            PG8_WAIT_V(8); PG8_WAIT_L(0); PG8_BAR; PG8_MMA(1, 0, At, B0); PG8_MMA(1, 1, At, B1); PG8_BAR; PG8_SCHED;
            } else {
            PG8_LDB(B0, 0, 0); PG8_SCHED; PG8_LDA(At, 0, 0); PG8_STAGE(PG8_SA(1, 1), a1 + hstep, voffA);
            PG8_WAIT_L(8); PG8_BAR; PG8_WAIT_L(0); PG8_MMA(0, 0, At, B0); PG8_BAR; PG8_SCHED;
            PG8_LDB(B1, 0, 1); PG8_STAGE(PG8_SB(0, 0), b2, voffB);
            PG8_BAR; PG8_WAIT_L(0); PG8_MMA(0, 1, At, B1); PG8_BAR;
            PG8_LDA(At, 0, 1); PG8_STAGE(PG8_SA(0, 0), a2, voffA);
            PG8_BAR; PG8_WAIT_L(0); PG8_MMA(1, 0, At, B0); PG8_BAR; PG8_SCHED;
            PG8_STAGE(PG8_SB(0, 1), b2 + hstep, voffB);
            PG8_WAIT_V(6); PG8_BAR; PG8_MMA(1, 1, At, B1); PG8_BAR;
            PG8_LDB(B0, 1, 0); PG8_SCHED; PG8_LDA(At, 1, 0); PG8_STAGE(PG8_SA(0, 1), a2 + hstep, voffA);
            PG8_WAIT_L(8); PG8_BAR; PG8_WAIT_L(0); PG8_MMA(0, 0, At, B0); PG8_BAR; PG8_SCHED;
            PG8_LDB(B1, 1, 1); PG8_STAGE(PG8_SB(1, 0), b3, voffB);
            PG8_BAR; PG8_WAIT_L(0); PG8_MMA(0, 1, At, B1); PG8_BAR;
            PG8_LDA(At, 1, 1); PG8_STAGE(PG8_SA(1, 0), a3, voffA);
            PG8_BAR; PG8_WAIT_L(0); PG8_MMA(1, 0, At, B0); PG8_BAR; PG8_SCHED;
            PG8_STAGE(PG8_SB(1, 1), b3 + hstep, voffB);
            PG8_WAIT_V(6); PG8_BAR; PG8_MMA(1, 1, At, B1); PG8_BAR;
            }
        }
        if constexpr (ALIGN_EPI) { if (wr == 0) PG8_BAR; }
        if constexpr (!Epi::AFTER_DRAIN) { E(acc, cur, wr, wc, fr, fq); S.done(cur); }
        if (!has_next) break;
#pragma unroll
        for (int a = 0; a < 2; ++a)
#pragma unroll
            for (int b = 0; b < 2; ++b)
#pragma unroll
                for (int m = 0; m < 4; ++m)
#pragma unroll
                    for (int n = 0; n < 2; ++n) acc[a][b][m][n] = (f32x4){0.f, 0.f, 0.f, 0.f};
        cur = nxt; cA = nA; cB = nB; ++ui;
        if constexpr (ALIGN_EPI) { if (wr == 1) PG8_BAR; }
    }
    PG8_WAIT_V(0);
    if constexpr (!ALIGN_EPI) { if (wr == 0) PG8_BAR; }
    PG8_BAR;
    if constexpr (Epi::AFTER_DRAIN) { E.fused(acc, cur, wr, wc, fr, fq, lds, wid, lane); S.done(cur); }
#undef PG8_SA
#undef PG8_SB
#undef PG8_STAGE
#undef PG8_LDA
#undef PG8_LDB
#undef PG8_MMA
#undef PG8_WAIT_V
#undef PG8_WAIT_L
#undef PG8_BAR
#undef PG8_SCHED
}
template <class Epi, class Sched, bool ALIGN_EPI = false>
__device__ __forceinline__ void gemm_phase_gather(PG8_LAS unsigned char* lds, const Gemm g, const Sched& S, const Epi& E) {
    int tid_ = threadIdx.x; asm volatile("" : "+v"(tid_));
    const int tid = tid_, wid = __builtin_amdgcn_readfirstlane(tid >> 6), lane = tid & 63, wr = wid >> 2, wc = wid & 3, fr = lane & 15, fq = lane >> 4;
    const int K = g.K, nt = K / BK;
    unsigned voffB[2]; int RA[2]; unsigned CA[2];
#pragma unroll
    for (int i = 0; i < 2; ++i) { int R, C; stage_rc(tid * 16 + i * 8192, R, C); const int Rb = Epi::PERM ? ((R & ~31) + perm32(R & 31)) : R;
        RA[i] = R; CA[i] = (unsigned)C * 2u; voffB[i] = (unsigned)(Rb * K + C) * 2u; }
    const size_t kstep = (size_t)(BK * 2);
    const size_t hstep = (size_t)HALF * K * 2;
    const size_t tstep = 2 * hstep;
    const unsigned ldsw = (unsigned)wid * 1024u;
    const int aoff = lds_byte(wr * 64 + fr, fq * 8), boff = lds_byte(wc * 32 + fr, fq * 8);
#define PG8_SA(b, h) (((b) * 2 + (h)) * HTB)
#define PG8_SB(b, h) ((4 + (b) * 2 + (h)) * HTB)
#define PG8_STAGE(bufoff, gbase, voff) do { _Pragma("unroll") for (int _i = 0; _i < 2; ++_i) \
        __builtin_amdgcn_global_load_lds((const unsigned*)((const char*)(gbase) + (voff)[_i]), (PG8_LAS unsigned*)(lds + (bufoff) + ldsw + _i * 8192), 16, 0, 0); } while (0)
#define PG8_LDA(dst, b, h) do { _Pragma("unroll") for (int m = 0; m < 4; ++m) _Pragma("unroll") for (int k = 0; k < 2; ++k) dst[m][k] = *(const PG8_LAS bf16x8*)(lds + PG8_SA(b, h) + aoff + m * 2048 + k * 1024); } while (0)
#define PG8_LDB(dst, b, h) do { _Pragma("unroll") for (int n = 0; n < 2; ++n) _Pragma("unroll") for (int k = 0; k < 2; ++k) dst[n][k] = *(const PG8_LAS bf16x8*)(lds + PG8_SB(b, h) + boff + n * 2048 + k * 1024); } while (0)
#define PG8_MMA(ai, bj, At, Bt) do { __builtin_amdgcn_s_setprio(1); _Pragma("unroll") for (int m = 0; m < 4; ++m) _Pragma("unroll") for (int n = 0; n < 2; ++n) _Pragma("unroll") for (int k = 0; k < 2; ++k) \
        acc[ai][bj][m][n] = __builtin_amdgcn_mfma_f32_16x16x32_bf16(Bt[n][k], At[m][k], acc[ai][bj][m][n], 0, 0, 0); __builtin_amdgcn_s_setprio(0); } while (0)
#define PG8_WAIT_V(n) asm volatile("s_waitcnt vmcnt(" #n ")" ::: "memory")
#define PG8_WAIT_L(n) asm volatile("s_waitcnt lgkmcnt(" #n ")" ::: "memory")
#define PG8_BAR __builtin_amdgcn_s_barrier()
#define PG8_SCHED __builtin_amdgcn_sched_barrier(0)
#define PG8_GOFFS(dst, u) do { _Pragma("unroll") for (int _h = 0; _h < 2; ++_h) _Pragma("unroll") for (int _i = 0; _i < 2; ++_i) \
        dst[_h][_i] = (unsigned)S.arow(u, _h * HALF + RA[_i]) * (unsigned)(K * 2) + CA[_i]; } while (0)
    Unit cur, nxt; int ui = 0;
    if (!S.next(0, cur)) return;
    unsigned vA[2][2], nvA[2][2];
    PG8_GOFFS(vA, cur);
    f32x4 acc[2][2][4][2];
#pragma unroll
    for (int a = 0; a < 2; ++a)
#pragma unroll
        for (int b = 0; b < 2; ++b)
#pragma unroll
            for (int m = 0; m < 4; ++m)
#pragma unroll
                for (int n = 0; n < 2; ++n) acc[a][b][m][n] = (f32x4){0.f, 0.f, 0.f, 0.f};
    bf16x8 At[4][2], B0[2][2], B1[2][2];
    const char* const cA = (const char*)g.A; const char* cB = (const char*)g.Bt + (size_t)cur.pn * tstep;
    asm volatile("s_waitcnt vmcnt(0)" ::: "memory");
    PG8_STAGE(PG8_SB(0, 0), cB, voffB); PG8_STAGE(PG8_SB(0, 1), cB + hstep, voffB); PG8_STAGE(PG8_SA(0, 0), cA, vA[0]); PG8_STAGE(PG8_SA(0, 1), cA, vA[1]);
    if (wr == 1) PG8_BAR;
    PG8_WAIT_V(2); PG8_BAR;
    PG8_STAGE(PG8_SB(1, 0), cB + kstep, voffB); PG8_STAGE(PG8_SA(1, 0), cA + kstep, vA[0]); PG8_STAGE(PG8_SB(1, 1), cB + hstep + kstep, voffB);
    PG8_WAIT_V(6); PG8_BAR;
    for (;;) {
        const bool has_next = S.next(ui + 1, nxt);
        const char* nB = has_next ? (const char*)g.Bt + (size_t)nxt.pn * tstep : cB;
        for (int t = 0; t < nt; t += 2) {
            const bool last = (t == nt - 2);
            if (last) {
                if (has_next) { PG8_GOFFS(nvA, nxt); }
                else {
#pragma unroll
                    for (int _h = 0; _h < 2; ++_h)
#pragma unroll
                        for (int _i = 0; _i < 2; ++_i) nvA[_h][_i] = vA[_h][_i]; }
            }
            unsigned s0[2], s1[2];
#pragma unroll
            for (int _i = 0; _i < 2; ++_i) { s0[_i] = last ? nvA[0][_i] : vA[0][_i]; s1[_i] = last ? nvA[1][_i] : vA[1][_i]; }
            const char* a1 = cA + (size_t)(t + 1) * kstep;
            const char* a2 = last ? cA : cA + (size_t)(t + 2) * kstep; const char* b2 = last ? nB : cB + (size_t)(t + 2) * kstep;
            const char* a3 = a2 + kstep; const char* b3 = b2 + kstep;
            PG8_LDB(B0, 0, 0); PG8_LDB(B1, 0, 1); PG8_SCHED; PG8_LDA(At, 0, 0); PG8_STAGE(PG8_SA(1, 1), a1, vA[1]);
            PG8_WAIT_V(8); PG8_WAIT_L(0); PG8_BAR; PG8_MMA(0, 0, At, B0); PG8_MMA(0, 1, At, B1); PG8_BAR; PG8_SCHED;
            PG8_LDA(At, 0, 1); PG8_STAGE(PG8_SB(0, 0), b2, voffB); PG8_STAGE(PG8_SB(0, 1), b2 + hstep, voffB); PG8_STAGE(PG8_SA(0, 0), a2, s0);
            PG8_WAIT_V(8); PG8_WAIT_L(0); PG8_BAR; PG8_MMA(1, 0, At, B0); PG8_MMA(1, 1, At, B1); PG8_BAR; PG8_SCHED;
            PG8_LDB(B0, 1, 0); PG8_LDB(B1, 1, 1); PG8_SCHED; PG8_LDA(At, 1, 0); PG8_STAGE(PG8_SA(0, 1), a2, s1);
            PG8_WAIT_V(8); PG8_WAIT_L(0); PG8_BAR; PG8_MMA(0, 0, At, B0); PG8_MMA(0, 1, At, B1); PG8_BAR; PG8_SCHED;
            PG8_LDA(At, 1, 1); PG8_STAGE(PG8_SB(1, 0), b3, voffB); PG8_STAGE(PG8_SB(1, 1), b3 + hstep, voffB); PG8_STAGE(PG8_SA(1, 0), a3, s0);
            PG8_WAIT_V(8); PG8_WAIT_L(0); PG8_BAR; PG8_MMA(1, 0, At, B0); PG8_MMA(1, 1, At, B1); PG8_BAR; PG8_SCHED;
        }
        if constexpr (ALIGN_EPI) { if (wr == 0) PG8_BAR; }
        E(acc, cur, wr, wc, fr, fq); S.done(cur);
        if (!has_next) break;
#pragma unroll
        for (int a = 0; a < 2; ++a)
#pragma unroll
            for (int b = 0; b < 2; ++b)
#pragma unroll
                for (int m = 0; m < 4; ++m)
#pragma unroll
                    for (int n = 0; n < 2; ++n) acc[a][b][m][n] = (f32x4){0.f, 0.f, 0.f, 0.f};
        cur = nxt; cB = nB; ++ui;
#pragma unroll
        for (int _h = 0; _h < 2; ++_h)
#pragma unroll
            for (int _i = 0; _i < 2; ++_i) vA[_h][_i] = nvA[_h][_i];
        if constexpr (ALIGN_EPI) { if (wr == 1) PG8_BAR; }
    }
    PG8_WAIT_V(0);
    if constexpr (!ALIGN_EPI) { if (wr == 0) PG8_BAR; }
    PG8_BAR;
#undef PG8_SA
#undef PG8_SB
#undef PG8_STAGE
#undef PG8_LDA
#undef PG8_LDB
#undef PG8_MMA
#undef PG8_WAIT_V
#undef PG8_WAIT_L
#undef PG8_BAR
#undef PG8_SCHED
#undef PG8_GOFFS
}
}

#define XB_TMO      128
#define XB_XCNT(j)  (256  + 64 * (j))
#define XB_XSUB(j)  (1280 + 64 * (j))
#define XB_XGEN(j)  (2304 + 64 * (j))
#define XB_TOP      3328
#define XB_TOPGEN   3392
#define XCD_BAR_WORDS 3456
#define XB_SPIN_CAP (1u << 18)

__device__ __forceinline__ unsigned xb_ld(unsigned* p)              { return __hip_atomic_load(p, __ATOMIC_RELAXED, __HIP_MEMORY_SCOPE_AGENT); }
__device__ __forceinline__ unsigned xb_add(unsigned* p, unsigned v) { return __hip_atomic_fetch_add(p, v, __ATOMIC_RELAXED, __HIP_MEMORY_SCOPE_AGENT); }
__device__ __forceinline__ unsigned xb_xcc_id() { return (unsigned)__builtin_amdgcn_s_getreg((3 << 11) | 20) & 0xFu; }
#define XB_SPIN(cond, bar) do { unsigned _sp = 0; while (cond) { __builtin_amdgcn_s_sleep(1); \
    if ((++_sp & 255u) == 0u) { if (xb_ld(&(bar)[XB_TMO])) break; if (_sp > XB_SPIN_CAP) { atomicAdd(&(bar)[XB_TMO], 1u); break; } } } } while (0)

struct XcdBarrier {
    unsigned* bar; unsigned x;
    volatile LAS unsigned* st;
};

__device__ __forceinline__ XcdBarrier xcd_barrier_post(unsigned* bar, volatile LAS unsigned* st) {
    XcdBarrier b; b.bar = bar; b.x = xb_xcc_id(); b.st = st;
    if (threadIdx.x == 0) (void)xb_add(&bar[XB_XCNT(b.x)], 1u);
    return b;
}
__device__ __forceinline__ void xcd_barrier_complete(unsigned* bar, unsigned x, unsigned& nloc, unsigned& nx) {
    const unsigned G = gridDim.x * gridDim.y * gridDim.z;
    unsigned sum, cnt, mine, sp = 0u;
    for (;;) {
        sum = 0u; cnt = 0u; mine = 0u;
#pragma unroll
        for (unsigned j = 0; j < 16; ++j) { const unsigned c = xb_ld(&bar[XB_XCNT(j)]); sum += c; cnt += (c > 0u) ? 1u : 0u; mine = (j == x) ? c : mine; }
        if (sum == G) break;
        __builtin_amdgcn_s_sleep(1);
        if ((++sp & 255u) == 0u) { if (xb_ld(&bar[XB_TMO])) break; if (sp > XB_SPIN_CAP) { atomicAdd(&bar[XB_TMO], 1u); break; } }
    }
    nloc = mine > 0u ? mine : 1u; nx = cnt > 0u ? cnt : 1u;
}

__device__ __forceinline__ void xcd_barrier(const XcdBarrier& b) {
    asm volatile("s_waitcnt vmcnt(0)" ::: "memory");
    __syncthreads();
    if (threadIdx.x == 0) {
        unsigned* bar = b.bar;
        __builtin_amdgcn_s_waitcnt(0);
        unsigned nloc = b.st[0], nx = b.st[1];
        if (nloc == 0u) { xcd_barrier_complete(bar, b.x, nloc, nx); b.st[0] = nloc; b.st[1] = nx; }
        const unsigned old = xb_add(&bar[XB_XSUB(b.x)], 1u);
        const unsigned gen = old / nloc;
        if (old + 1u == (gen + 1u) * nloc) {
            __builtin_amdgcn_fence(__ATOMIC_RELEASE, "agent");
            asm volatile("s_waitcnt vmcnt(0)" ::: "memory");
            const unsigned og = xb_add(&bar[XB_TOP], 1u);
            const unsigned tg = og / nx;
            if (og + 1u == (tg + 1u) * nx) xb_add(&bar[XB_TOPGEN], 1u);
            else XB_SPIN(xb_ld(&bar[XB_TOPGEN]) == tg, bar);
            __builtin_amdgcn_fence(__ATOMIC_ACQUIRE, "agent");
            xb_add(&bar[XB_XGEN(b.x)], 1u);
            asm volatile("s_waitcnt vmcnt(0)" ::: "memory");
        } else {
            XB_SPIN(xb_ld(&bar[XB_XGEN(b.x)]) == gen, bar);
            __builtin_amdgcn_fence(__ATOMIC_ACQUIRE, "agent");
            asm volatile("s_waitcnt vmcnt(0)" ::: "memory");
        }
    }
    __syncthreads();
}


constexpr int NWAVES = 8, NTHR = 512;
constexpr int T = 16384, DM = 1024, SEQ = 2048, NPROJ = 2816, NCHK = 256;
constexpr float RMS_EPS = 1e-6f, LOG2E = 1.4426950408889634f;
constexpr int C_AB = 0, C_AC = 256, C_AV = 512, C_FQ = 768, C_FK = 1024, C_FV = 1280, C_Z = 1536, C_XBC = 1792, C_CQ = 2304, C_CKV = 2560, C_KR = 2688, C_FD = 2720;
#ifndef EN0
#define EN0 31
#endif
#ifndef EN1
#define EN1 31
#endif
#ifndef EN_L1
#define EN_L1 1
#endif
#ifndef MK_SPLIT
#define MK_SPLIT 1
#endif
constexpr int NPHASE = 17;

constexpr size_t MiB = 1u << 20;
constexpr size_t WS_CTL = 0, CTL_ZERO_BYTES = 65536;
constexpr size_t WS_X1 = 1 * MiB;
constexpr size_t WS_PM = 65 * MiB;
constexpr size_t WS_S1 = 153 * MiB;
constexpr size_t WS_HACT = 185 * MiB;
constexpr size_t WS_E = 205 * MiB;
constexpr size_t WS_QM = WS_E, WS_KM = WS_E + 12 * MiB, WS_VM = WS_E + 24 * MiB, WS_ST = WS_E + 32 * MiB;
constexpr size_t WS_BGU = WS_E, WS_BD = WS_E + 32 * MiB;
constexpr size_t WS_WIN = 261 * MiB;
constexpr size_t WS_WOUT = 272 * MiB;
constexpr size_t WS_WUQ = 276 * MiB;
constexpr size_t WS_WUKV = WS_WUQ + 512 * 1024;
constexpr size_t WS_MISC = 277 * MiB;
constexpr size_t WS_FD = WS_MISC;
constexpr size_t WS_RSTD = WS_FD + 512 * 1024;
constexpr size_t WS_CUM = WS_RSTD + 64 * 1024;
constexpr size_t WS_COS = WS_CUM + 256 * 1024;
constexpr size_t WS_SIN = WS_COS + 1 * MiB;
constexpr size_t WS_CDEC = WS_SIN + 1 * MiB;
constexpr size_t WS_ROWL = WS_CDEC + 64 * 1024;
constexpr size_t WS_TOKE = WS_ROWL + 2 * MiB;
constexpr size_t WS_TOKP = WS_TOKE + 128 * 1024;
constexpr size_t WS_TOKW = WS_TOKP + 128 * 1024;
constexpr size_t WS_END = WS_TOKW + 128 * 1024;
static_assert(WS_END <= 284 * MiB, "workspace map");
constexpr size_t WS_NEED = 284 * MiB;
constexpr int CW_CNT = 64;
constexpr int CW_BAR = 4096;

constexpr int LDS_BYTES = 155648;
constexpr int LDS_SCR = 147456;
constexpr int LDS_CTL = 151552;
constexpr int SCR_RED = 0;
constexpr int SCR_RQ = 256, SCR_RKV = 512;
constexpr int SCR_CNT = 768;
constexpr int SCR_TBASE = 896;
constexpr int SCR_TILEE = 1040;
constexpr int SCR_NT = 1680;

typedef unsigned short bf16_t;
typedef short bf16x8 __attribute__((ext_vector_type(8)));
typedef short s16x4 __attribute__((ext_vector_type(4)));
typedef float f32x4 __attribute__((ext_vector_type(4)));
typedef unsigned u32x4 __attribute__((ext_vector_type(4)));
typedef unsigned u32x2 __attribute__((ext_vector_type(2)));
typedef LAS unsigned char* lptr;
#define LDS_WAIT() asm volatile("s_waitcnt lgkmcnt(0)" ::: "memory")

__device__ __forceinline__ unsigned f2bf(float f) { unsigned u = __builtin_bit_cast(unsigned, f); return (u + 0x7fffu + ((u >> 16) & 1u)) >> 16; }
__device__ __forceinline__ unsigned pk2(float lo, float hi) { return f2bf(lo) | (f2bf(hi) << 16); }
__device__ __forceinline__ float bf2f(unsigned short u) { return __uint_as_float((unsigned)u << 16); }
__device__ __forceinline__ float bflo(unsigned u) { return __uint_as_float(u << 16); }
__device__ __forceinline__ float bfhi(unsigned u) { return __uint_as_float(u & 0xffff0000u); }
__device__ __forceinline__ float wave_sum(float v) {
#pragma unroll
    for (int o = 1; o < 64; o <<= 1) v += __shfl_xor(v, o);
    return v;
}
__device__ __forceinline__ float silu_f(float x) { return x / (1.0f + __expf(-x)); }
__device__ __forceinline__ float softplus_f(float x) { return fmaxf(x, 0.f) + log1pf(__expf(-fabsf(x))); }
__device__ __forceinline__ f32x4 mfma16(bf16x8 a, bf16x8 b, f32x4 c) { return __builtin_amdgcn_mfma_f32_16x16x32_bf16(a, b, c, 0, 0, 0); }
__device__ __forceinline__ bf16x8 tr_frag(lptr base, int ld  , int row_a, int row_b, int col0, int lane) {
    typedef short v4i16_t __attribute__((ext_vector_type(4)));
    const int i = lane & 15, q = i >> 2, p = i & 3;
    const s16x4 lo = __builtin_bit_cast(s16x4, __builtin_amdgcn_ds_read_tr16_b64_v4i16((LAS v4i16_t*)(base + ((row_a + q) * ld + col0 + 4 * p) * 2)));
    const s16x4 hi = __builtin_bit_cast(s16x4, __builtin_amdgcn_ds_read_tr16_b64_v4i16((LAS v4i16_t*)(base + ((row_b + q) * ld + col0 + 4 * p) * 2)));
    return (bf16x8){lo[0], lo[1], lo[2], lo[3], hi[0], hi[1], hi[2], hi[3]};
}

struct Args { const float* in[26]; float* out; unsigned char* ws; int ph_lo, ph_hi; };
struct Ctx {
    lptr lds;
    int tid, lane, wave, G, bx;
    const __attribute__((address_space(4))) Args* a;
    float* out; unsigned char* ws;
};
#define WSP(type, off) ((type*)(C.ws + (off)))
#define LAUNDER() do { unsigned char* p_ = C.ws; int t_ = C.tid; unsigned l_ = (unsigned)(size_t)C.lds; const __attribute__((address_space(4))) Args* a_ = C.a; asm volatile("" : "+s"(p_), "+v"(t_), "+s"(l_), "+s"(a_)); C.a = a_; C.ws = p_; C.tid = t_; C.lane = t_ & 63; C.wave = __builtin_amdgcn_readfirstlane(t_ >> 6); C.lds = (lptr)(size_t)l_; } while (0)

__device__ __forceinline__ int refcol(int n) { return n < 1536 ? n : n < 2304 ? n + 4 : n < 2720 ? n + 8 : n < 2724 ? 1536 + (n - 2720) : n < 2728 ? 2308 + (n - 2724) : -1; }

__device__ __forceinline__ void transpose_item(const float* W, int ldw, int scol, int k0, const float* gk, bf16_t* dst, int K, LAS float* scr, int lane) {
#pragma unroll 8
    for (int i = 0; i < 32; ++i) { const int kk = 2 * i + (lane >> 5); float v = 0.f;
        if (scol >= 0) { v = W[(size_t)(k0 + kk) * ldw + scol]; if (gk) v *= gk[k0 + kk]; }
        scr[kk * 33 + (lane & 31)] = v; }
    LDS_WAIT(); asm volatile("" ::: "memory");
    const int c = lane & 7;
#pragma unroll
    for (int j = 0; j < 4; ++j) { const int n = (lane >> 3) + 8 * j; const LAS float* s = scr + (8 * c) * 33 + n;
        u32x4 o; o.x = pk2(s[0 * 33], s[1 * 33]); o.y = pk2(s[2 * 33], s[3 * 33]); o.z = pk2(s[4 * 33], s[5 * 33]); o.w = pk2(s[6 * 33], s[7 * 33]);
        *(u32x4*)(dst + (size_t)n * K + 8 * c) = o; }
    LDS_WAIT(); asm volatile("" ::: "memory");
}

__device__ __forceinline__ void row_to_bf16(const float* xrow, bf16_t* orow, float* rstd_out, int lane) {
    const f32x4* xr = (const f32x4*)xrow + lane; f32x4 v[4]; float s = 0.f;
#pragma unroll
    for (int j = 0; j < 4; ++j) { v[j] = xr[64 * j]; s += (v[j].x * v[j].x + v[j].y * v[j].y) + (v[j].z * v[j].z + v[j].w * v[j].w); }
    s = wave_sum(s);
    if (lane == 0) *rstd_out = 1.0f / sqrtf(s * (1.0f / DM) + RMS_EPS);
    u32x2* o8 = (u32x2*)orow + lane;
#pragma unroll
    for (int j = 0; j < 4; ++j) { u32x2 w; w.x = pk2(v[j].x, v[j].y); w.y = pk2(v[j].z, v[j].w); o8[64 * j] = w; }
}

__device__ __forceinline__ void p0_prologue(Ctx& C) {
    LAS float* scr = (LAS float*)(C.lds + C.wave * 8704);
    const int gw = C.bx * NWAVES + C.wave, NGW = C.G * NWAVES;
    constexpr int I_IN = 16 * 88, I_OUT = 16 * 32, I_UQ = 4 * 12, I_UKV = 2 * 16, I_L = I_IN + I_OUT + I_UQ + I_UKV;
    for (int it = gw; it < 2 * I_L; it += NGW) {
        const int l = it / I_L; int r = it % I_L; const int ln = C.lane & 31;
        if (r < I_IN) { const int kb = r / 88, nb = r % 88;
            transpose_item(C.a->in[3] + (size_t)l * 1024 * 2728, 2728, refcol(32 * nb + ln), 64 * kb, C.a->in[2] + l * 1024, WSP(bf16_t, WS_WIN) + (size_t)l * NPROJ * 1024 + (size_t)(32 * nb) * 1024 + 64 * kb, 1024, scr, C.lane); continue; }
        r -= I_IN;
        if (r < I_OUT) { const int kb = r / 32, nb = r % 32;
            transpose_item(C.a->in[16] + (size_t)l * 1024 * 1024, 1024, 32 * nb + ln, 64 * kb, nullptr, WSP(bf16_t, WS_WOUT) + (size_t)l * 1024 * 1024 + (size_t)(32 * nb) * 1024 + 64 * kb, 1024, scr, C.lane); continue; }
        r -= I_OUT;
        if (r < I_UQ) { const int kb = r / 12, nb = r % 12;
            transpose_item(C.a->in[14] + (size_t)l * 256 * 384, 384, 32 * nb + ln, 64 * kb, C.a->in[12] + l * 256, WSP(bf16_t, WS_WUQ) + (size_t)l * 384 * 256 + (size_t)(32 * nb) * 256 + 64 * kb, 256, scr, C.lane); continue; }
        r -= I_UQ;
        { const int kb = r / 16, nb = r % 16;
            transpose_item(C.a->in[15] + (size_t)l * 128 * 512, 512, 32 * nb + ln, 64 * kb, C.a->in[13] + l * 128, WSP(bf16_t, WS_WUKV) + (size_t)l * 512 * 128 + (size_t)(32 * nb) * 128 + 64 * kb, 128, scr, C.lane); }
    }
    { const int* pos = (const int*)C.a->in[1]; float* cs = WSP(float, WS_COS); float* sn = WSP(float, WS_SIN);
      for (int e = C.bx * NTHR + C.tid; e < T * 16; e += C.G * NTHR) { const int t = e >> 4, i = e & 15;
          const float inv = powf(10000.0f, -(float)(2 * i) / 32.0f); const float ang = (float)pos[t] * inv;
          const double rev = (double)ang * 0.15915494309189535; const double fr = rev - floor(rev); const float a = (float)(fr * 6.283185307179586);
          cs[e] = cosf(a); sn[e] = sinf(a); } }
    for (int m = gw; m < T; m += NGW) row_to_bf16(C.a->in[0] + (size_t)m * DM, WSP(bf16_t, WS_S1) + (size_t)m * DM, WSP(float, WS_RSTD) + m, C.lane);
}

constexpr int XS_LD = 264, BC_LD = 136, ML_LD = 72;
constexpr int XS_OFF = 0, BL_OFF = 33792, CL_OFF = 51200, ACUM_OFF = 68608, DT_OFF = 69632, SSQ_OFF = 70656, ML_OFF = 71680, PV_OFF = 108544;
static_assert(PV_OFF + 36864 <= LDS_SCR, "ssd lds");
__device__ __forceinline__ float log_sigmoid_f(float x) { return -(fmaxf(-x, 0.f) + log1pf(__expf(-fabsf(x)))); }

__device__ __forceinline__ void ssd_fill(Ctx& C, int l, int cu) {
    const int c = cu & 31, t0 = cu * 64; const bf16_t* PM = WSP(bf16_t, WS_PM);
    const float* cw = C.a->in[6] + l * 4 * 512; const float* cb = C.a->in[7] + l * 512;
#pragma unroll 1
    for (int it = 0; it < 8; ++it) { const int item = C.tid + NTHR * it, lt = item >> 6, ch = (item & 63) * 8;
        float acc[8];
#pragma unroll
        for (int j = 0; j < 8; ++j) acc[j] = cb[ch + j];
#pragma unroll
        for (int d = 0; d < 4; ++d) { const int sp = 64 * c + lt - 3 + d;
            if (sp >= 0) { const u32x4 raw = *(const u32x4*)(PM + (size_t)(t0 + lt - 3 + d) * NPROJ + C_XBC + ch); const float* w = cw + d * 512 + ch;
                acc[0] += w[0] * bflo(raw.x); acc[1] += w[1] * bfhi(raw.x); acc[2] += w[2] * bflo(raw.y); acc[3] += w[3] * bfhi(raw.y);
                acc[4] += w[4] * bflo(raw.z); acc[5] += w[5] * bfhi(raw.z); acc[6] += w[6] * bflo(raw.w); acc[7] += w[7] * bfhi(raw.w); } }
        u32x4 o; o.x = pk2(silu_f(acc[0]), silu_f(acc[1])); o.y = pk2(silu_f(acc[2]), silu_f(acc[3])); o.z = pk2(silu_f(acc[4]), silu_f(acc[5])); o.w = pk2(silu_f(acc[6]), silu_f(acc[7]));
        lptr dst = ch < 256 ? C.lds + XS_OFF + (lt * XS_LD + ch) * 2 : ch < 384 ? C.lds + BL_OFF + (lt * BC_LD + (ch - 256)) * 2 : C.lds + CL_OFF + (lt * BC_LD + (ch - 384)) * 2;
        *(LAS u32x4*)dst = o; }
    if (C.tid < 256) { const int lt = C.tid >> 2, h = C.tid & 3;
        const float dt = softplus_f(WSP(float, WS_FD)[(size_t)(t0 + lt) * 8 + 4 + h] + C.a->in[8][l * 4 + h]);
        ((LAS float*)(C.lds + DT_OFF))[lt * 4 + h] = dt; ((LAS float*)(C.lds + ACUM_OFF))[lt * 4 + h] = -__expf(C.a->in[9][l * 4 + h]) * dt; }
    __syncthreads();
    if (C.wave < 4) { LAS float* ac = (LAS float*)(C.lds + ACUM_OFF) + C.lane * 4 + C.wave; float v = *ac;
#pragma unroll
        for (int o = 1; o < 64; o <<= 1) { const float y = __shfl_up(v, o); if (C.lane >= o) v += y; }
        *ac = v; }
    __syncthreads();
}

__device__ __forceinline__ void p2_unit(Ctx& C, int l, int cu, int en) {
    const int b = cu >> 5, c = cu & 31, t0 = cu * 64; const int tid = C.tid, lane = C.lane, w = C.wave, g = lane >> 4, i = lane & 15;
    const bf16_t* PM = WSP(bf16_t, WS_PM); bf16_t* Y = WSP(bf16_t, WS_S1);
    { const float* cw = C.a->in[4] + l * 3 * 256;
#pragma unroll 1
      for (int it = 0; it < 4; ++it) { const int item = tid + NTHR * it, lt = item >> 5, ch = (item & 31) * 8; const size_t r = (size_t)(t0 + lt) * NPROJ;
          float acc[8] = {0.f, 0.f, 0.f, 0.f, 0.f, 0.f, 0.f, 0.f};
          if (en & 1) {
#pragma unroll
          for (int d = 0; d < 3; ++d) { const int sp = 64 * c + lt - 2 + d;
              if (sp >= 0) { const size_t rr = (size_t)(t0 + lt - 2 + d) * NPROJ; const u32x4 cg = *(const u32x4*)(PM + rr + C_AC + ch), vl = *(const u32x4*)(PM + rr + C_AV + ch); const float* wv = cw + d * 256 + ch;
                  acc[0] += wv[0] * bflo(cg.x) * bflo(vl.x); acc[1] += wv[1] * bfhi(cg.x) * bfhi(vl.x); acc[2] += wv[2] * bflo(cg.y) * bflo(vl.y); acc[3] += wv[3] * bfhi(cg.y) * bfhi(vl.y);
                  acc[4] += wv[4] * bflo(cg.z) * bflo(vl.z); acc[5] += wv[5] * bfhi(cg.z) * bfhi(vl.z); acc[6] += wv[6] * bflo(cg.w) * bflo(vl.w); acc[7] += wv[7] * bfhi(cg.w) * bfhi(vl.w); } }
          const u32x4 bg = *(const u32x4*)(PM + r + C_AB + ch);
          acc[0] *= bflo(bg.x); acc[1] *= bfhi(bg.x); acc[2] *= bflo(bg.y); acc[3] *= bfhi(bg.y); acc[4] *= bflo(bg.z); acc[5] *= bfhi(bg.z); acc[6] *= bflo(bg.w); acc[7] *= bfhi(bg.w); }
          u32x4 o; o.x = pk2(acc[0], acc[1]); o.y = pk2(acc[2], acc[3]); o.z = pk2(acc[4], acc[5]); o.w = pk2(acc[6], acc[7]);
          *(u32x4*)(Y + (size_t)(t0 + lt) * DM + ch) = o; } }
    for (int mx = 1; mx < 4; ++mx) if (!((en >> mx) & 1)) {
        for (int it = 0; it < 4; ++it) { const int item = tid + NTHR * it, lt = item >> 5, ch = (item & 31) * 8; *(u32x4*)(Y + (size_t)(t0 + lt) * DM + 256 * mx + ch) = (u32x4){0u, 0u, 0u, 0u}; } }
    LAUNDER();
    if (en & 2) {
        const float* FD = WSP(float, WS_FD); const float* fb = C.a->in[5] + l * 4; LAS float* red = (LAS float*)(C.lds + LDS_SCR + SCR_RED);
        float ps[4] = {0.f, 0.f, 0.f, 0.f};
        for (int tk = tid; tk < 64 * c; tk += NTHR) { const f32x4 f = *(const f32x4*)(FD + (size_t)(b * SEQ + tk) * 8);
            ps[0] += log_sigmoid_f(f.x + fb[0]); ps[1] += log_sigmoid_f(f.y + fb[1]); ps[2] += log_sigmoid_f(f.z + fb[2]); ps[3] += log_sigmoid_f(f.w + fb[3]); }
#pragma unroll
        for (int h = 0; h < 4; ++h) ps[h] = wave_sum(ps[h]);
        if (lane == 0) { red[w * 4 + 0] = ps[0]; red[w * 4 + 1] = ps[1]; red[w * 4 + 2] = ps[2]; red[w * 4 + 3] = ps[3]; }
        __syncthreads();
        if (w < 4) { float pre = 0.f;
#pragma unroll
            for (int k = 0; k < 8; ++k) pre += red[k * 4 + w];
            float v = log_sigmoid_f(FD[(size_t)(t0 + lane) * 8 + w] + fb[w]);
#pragma unroll
            for (int o = 1; o < 64; o <<= 1) { const float y = __shfl_up(v, o); if (lane >= o) v += y; }
            WSP(float, WS_CUM)[(size_t)(t0 + lane) * 4 + w] = (pre + v) * LOG2E; }
        __syncthreads();
    }
    LAUNDER();
    if (en & 4) {
        ssd_fill(C, l, cu);
        const LAS float* AC = (const LAS float*)(C.lds + ACUM_OFF); const LAS float* DT = (const LAS float*)(C.lds + DT_OFF);
#pragma unroll 1
        for (int it = 0; it < 4; ++it) { const int item = tid + NTHR * it, lt = item >> 5, col = (item & 31) * 8, h = col >> 6, n = col & 63;
            const u32x4 s = *(const LAS u32x4*)(C.lds + BL_OFF + (lt * BC_LD + 64 * (h >> 1) + n) * 2);
            const float sc = DT[lt * 4 + h] * __expf(AC[63 * 4 + h] - AC[lt * 4 + h]);
            u32x4 o; o.x = pk2(bflo(s.x) * sc, bfhi(s.x) * sc); o.y = pk2(bflo(s.y) * sc, bfhi(s.y) * sc); o.z = pk2(bflo(s.z) * sc, bfhi(s.z) * sc); o.w = pk2(bflo(s.w) * sc, bfhi(s.w) * sc);
            *(LAS u32x4*)(C.lds + PV_OFF + (lt * XS_LD + col) * 2) = o; }
        __syncthreads();
        { const int h = w >> 1, rh = w & 1; float* ST = WSP(float, WS_ST) + (size_t)(cu * 4 + h) * 4096;
#pragma unroll
          for (int mbl = 0; mbl < 2; ++mbl) { const int mb = 2 * rh + mbl;
#pragma unroll
              for (int nb = 0; nb < 4; ++nb) { f32x4 acc = {0.f, 0.f, 0.f, 0.f};
#pragma unroll
                  for (int kk = 0; kk < 2; ++kk) { const int rb = 32 * kk + 8 * g;
                      const bf16x8 a = tr_frag(C.lds + XS_OFF, XS_LD, rb, rb + 4, 64 * h + 16 * mb, lane);
                      const bf16x8 bq = tr_frag(C.lds + PV_OFF, XS_LD, rb, rb + 4, 64 * h + 16 * nb, lane);
                      acc = mfma16(a, bq, acc); }
#pragma unroll
                  for (int r = 0; r < 4; ++r) ST[(16 * mb + 4 * g + r) * 64 + 16 * nb + i] = acc[r]; } }
          if (tid < 4) WSP(float, WS_CDEC)[cu * 4 + tid] = __expf(AC[63 * 4 + tid]); }
        __syncthreads();
    }
    LAUNDER();
    if (en & 8) {
        LAS float* RQ = (LAS float*)(C.lds + LDS_SCR + SCR_RQ); LAS float* RKV = (LAS float*)(C.lds + LDS_SCR + SCR_RKV);
        { const int lt = tid >> 3, sub = tid & 7; const bf16_t* pr = PM + (size_t)(t0 + lt) * NPROJ; float s1 = 0.f, s2 = 0.f;
#pragma unroll
          for (int k = 0; k < 4; ++k) { const u32x4 v = *(const u32x4*)(pr + C_CQ + sub * 32 + 8 * k);
              s1 += bflo(v.x) * bflo(v.x) + bfhi(v.x) * bfhi(v.x) + bflo(v.y) * bflo(v.y) + bfhi(v.y) * bfhi(v.y) + bflo(v.z) * bflo(v.z) + bfhi(v.z) * bfhi(v.z) + bflo(v.w) * bflo(v.w) + bfhi(v.w) * bfhi(v.w); }
#pragma unroll
          for (int k = 0; k < 2; ++k) { const u32x4 v = *(const u32x4*)(pr + C_CKV + sub * 16 + 8 * k);
              s2 += bflo(v.x) * bflo(v.x) + bfhi(v.x) * bfhi(v.x) + bflo(v.y) * bflo(v.y) + bfhi(v.y) * bfhi(v.y) + bflo(v.z) * bflo(v.z) + bfhi(v.z) * bfhi(v.z) + bflo(v.w) * bflo(v.w) + bfhi(v.w) * bfhi(v.w); }
          s1 += __shfl_xor(s1, 1); s1 += __shfl_xor(s1, 2); s1 += __shfl_xor(s1, 4); s2 += __shfl_xor(s2, 1); s2 += __shfl_xor(s2, 2); s2 += __shfl_xor(s2, 4);
          if (sub == 0) { RQ[lt] = 1.0f / sqrtf(s1 * (1.0f / 256.0f) + RMS_EPS); RKV[lt] = 1.0f / sqrtf(s2 * (1.0f / 128.0f) + RMS_EPS); } }
        __syncthreads();
        const float* COS = WSP(float, WS_COS); const float* SIN = WSP(float, WS_SIN);
        bf16_t* QM = WSP(bf16_t, WS_QM); bf16_t* KM = WSP(bf16_t, WS_KM); bf16_t* VM = WSP(bf16_t, WS_VM);
        {
          const bf16_t* WU = WSP(bf16_t, WS_WUQ) + (size_t)l * 384 * 256; f32x4 acc[3][4];
#pragma unroll
          for (int a = 0; a < 3; ++a)
#pragma unroll
              for (int m = 0; m < 4; ++m) acc[a][m] = (f32x4){0.f, 0.f, 0.f, 0.f};
#pragma unroll 1
          for (int kk = 0; kk < 8; ++kk) { bf16x8 bq[4];
#pragma unroll
              for (int m = 0; m < 4; ++m) bq[m] = *(const bf16x8*)(PM + (size_t)(t0 + 16 * m + i) * NPROJ + C_CQ + 32 * kk + 8 * g);
#pragma unroll
              for (int a = 0; a < 3; ++a) { const bf16x8 af = *(const bf16x8*)(WU + (size_t)(16 * (3 * w + a) + i) * 256 + 32 * kk + 8 * g);
#pragma unroll
                  for (int m = 0; m < 4; ++m) acc[a][m] = mfma16(af, bq[m], acc[a][m]); } }
#pragma unroll
          for (int m = 0; m < 4; ++m) { const int tk = 16 * m + i; const float rq = RQ[tk];
#pragma unroll
              for (int a = 0; a < 3; ++a) acc[a][m] = acc[a][m] * rq;
              if (w & 1) { const f32x4 cs = *(const f32x4*)(COS + (size_t)(t0 + tk) * 16 + 4 * g), sn = *(const f32x4*)(SIN + (size_t)(t0 + tk) * 16 + 4 * g);
                  const f32x4 x1 = acc[1][m], x2 = acc[2][m]; acc[1][m] = x1 * cs - x2 * sn; acc[2][m] = x2 * cs + x1 * sn; }
#pragma unroll
              for (int a = 0; a < 3; ++a) { u32x2 o; o.x = pk2(acc[a][m][0], acc[a][m][1]); o.y = pk2(acc[a][m][2], acc[a][m][3]);
                  *(u32x2*)(QM + (size_t)(t0 + tk) * 384 + 16 * (3 * w + a) + 4 * g) = o; } } }
        LAUNDER();
        {
          const bf16_t* WU = WSP(bf16_t, WS_WUKV) + (size_t)l * 512 * 128; f32x4 acc[4][4];
#pragma unroll
          for (int a = 0; a < 4; ++a)
#pragma unroll
              for (int m = 0; m < 4; ++m) acc[a][m] = (f32x4){0.f, 0.f, 0.f, 0.f};
#pragma unroll 1
          for (int kk = 0; kk < 4; ++kk) { bf16x8 bq[4];
#pragma unroll
              for (int m = 0; m < 4; ++m) bq[m] = *(const bf16x8*)(PM + (size_t)(t0 + 16 * m + i) * NPROJ + C_CKV + 32 * kk + 8 * g);
#pragma unroll
              for (int a = 0; a < 4; ++a) { const bf16x8 af = *(const bf16x8*)(WU + (size_t)(16 * (4 * w + a) + i) * 128 + 32 * kk + 8 * g);
#pragma unroll
                  for (int m = 0; m < 4; ++m) acc[a][m] = mfma16(af, bq[m], acc[a][m]); } }
          const int hd = w >> 1;
#pragma unroll
          for (int m = 0; m < 4; ++m) { const int tk = 16 * m + i; const float rk = RKV[tk];
#pragma unroll
              for (int a = 0; a < 4; ++a) { const f32x4 v = acc[a][m] * rk; u32x2 o; o.x = pk2(v[0], v[1]); o.y = pk2(v[2], v[3]);
                  if (w & 1) *(u32x2*)(VM + (size_t)(t0 + tk) * 256 + 64 * hd + 16 * a + 4 * g) = o;
                  else       *(u32x2*)(KM + (size_t)(t0 + tk) * 384 + 96 * hd + 16 * a + 4 * g) = o; } } }
        {
          const int lt = tid >> 3, i0 = (tid & 7) * 2; const bf16_t* pr = PM + (size_t)(t0 + lt) * NPROJ + C_KR;
          const unsigned a = *(const unsigned*)(pr + i0), bb = *(const unsigned*)(pr + 16 + i0);
          const float c0 = COS[(size_t)(t0 + lt) * 16 + i0], c1 = COS[(size_t)(t0 + lt) * 16 + i0 + 1], s0 = SIN[(size_t)(t0 + lt) * 16 + i0], s1 = SIN[(size_t)(t0 + lt) * 16 + i0 + 1];
          const float x10 = bflo(a), x11 = bfhi(a), x20 = bflo(bb), x21 = bfhi(bb);
          const unsigned o1 = pk2(x10 * c0 - x20 * s0, x11 * c1 - x21 * s1), o2 = pk2(x20 * c0 + x10 * s0, x21 * c1 + x11 * s1);
#pragma unroll
          for (int hd = 0; hd < 4; ++hd) { *(unsigned*)(KM + (size_t)(t0 + lt) * 384 + 96 * hd + 64 + i0) = o1; *(unsigned*)(KM + (size_t)(t0 + lt) * 384 + 96 * hd + 80 + i0) = o2; } }
        __syncthreads();
    }
}

template <int DK, bool FOX>
__device__ __forceinline__ void attn_unit(Ctx& C, const bf16_t* Qg, int qp, const bf16_t* Kg, int kp, const bf16_t* Vg, int vp, bf16_t* Og, const float* cumg, int row0, int qb, float qscale) {
    constexpr int KLD = DK + 8, VLD = 72, KBUF = 64 * KLD * 2, VBUF = 64 * VLD * 2, BUFB = KBUF + VBUF + 256, NKK = DK / 32, CPR = DK / 8;
    const int tid = C.tid, lane = C.lane, w = C.wave, g = lane >> 4, i = lane & 15;
    const int q0w = qb * 128 + 16 * w, nt = 2 * (qb + 1);
    bf16x8 qf[NKK];
    { const bf16_t* qrow = Qg + (size_t)(row0 + q0w + i) * qp;
#pragma unroll
      for (int kk = 0; kk < NKK; ++kk) qf[kk] = *(const bf16x8*)(qrow + 32 * kk + 8 * g); }
    const float cq = FOX ? cumg[(size_t)(row0 + q0w + i) * 4] : 0.f;
    f32x4 o[4];
#pragma unroll
    for (int m = 0; m < 4; ++m) o[m] = (f32x4){0.f, 0.f, 0.f, 0.f};
    float mrun = -INFINITY, lsum = 0.f;
    const int kr0 = tid / CPR, kc0 = tid % CPR, kr1 = (tid + NTHR) / CPR, kc1 = (tid + NTHR) % CPR, vr = tid >> 3, vc = tid & 7;
    const bool k1 = (DK == 96) && (tid < 256);
    u32x4 kreg0, kreg1 = {0u, 0u, 0u, 0u}, vreg; float ckreg = 0.f;
#define AT_LOAD(kt) do { const size_t rb_ = (size_t)row0 + 64 * (kt); \
        kreg0 = *(const u32x4*)(Kg + (rb_ + kr0) * kp + 8 * kc0); if (k1) kreg1 = *(const u32x4*)(Kg + (rb_ + kr1) * kp + 8 * kc1); \
        vreg = *(const u32x4*)(Vg + (rb_ + vr) * vp + 8 * vc); if (FOX && tid < 64) ckreg = cumg[(rb_ + tid) * 4]; } while (0)
#define AT_STORE(buf) do { lptr b_ = C.lds + (buf) * BUFB; \
        *(LAS u32x4*)(b_ + (kr0 * KLD + 8 * kc0) * 2) = kreg0; if (k1) *(LAS u32x4*)(b_ + (kr1 * KLD + 8 * kc1) * 2) = kreg1; \
        *(LAS u32x4*)(b_ + KBUF + (vr * VLD + 8 * vc) * 2) = vreg; if (FOX && tid < 64) *(LAS float*)(b_ + KBUF + VBUF + tid * 4) = ckreg; } while (0)
    AT_LOAD(0); AT_STORE(0); __syncthreads();
#pragma unroll 1
    for (int kt = 0; kt < nt; ++kt) {
        const int cur = kt & 1;
        if (kt + 1 < nt) AT_LOAD(kt + 1);
        const bool active = FOX ? (64 * kt <= q0w + 15) : (kt <= (q0w >> 6));
        if (active) {
            lptr kb = C.lds + cur * BUFB; lptr vb = kb + KBUF; lptr ckb = vb + VBUF;
            f32x4 s[4];
#pragma unroll
            for (int n = 0; n < 4; ++n) { s[n] = (f32x4){0.f, 0.f, 0.f, 0.f};
#pragma unroll
                for (int kk = 0; kk < NKK; ++kk) { const bf16x8 a = *(const LAS bf16x8*)(kb + ((16 * n + i) * KLD + 32 * kk + 8 * g) * 2); s[n] = mfma16(a, qf[kk], s[n]); } }
            const bool needmask = FOX && (64 * kt + 63 > q0w);
            float mx = -INFINITY;
#pragma unroll
            for (int n = 0; n < 4; ++n) { f32x4 ck4 = {0.f, 0.f, 0.f, 0.f}; if (FOX) ck4 = *(const LAS f32x4*)(ckb + (16 * n + 4 * g) * 4);
#pragma unroll
                for (int r = 0; r < 4; ++r) { float v = s[n][r] * qscale; if (FOX) v += cq - ck4[r];
                    if (needmask && (64 * kt + 16 * n + 4 * g + r > q0w + i)) v = -INFINITY;
                    s[n][r] = v; mx = fmaxf(mx, v); } }
            mx = fmaxf(mx, __shfl_xor(mx, 16)); mx = fmaxf(mx, __shfl_xor(mx, 32));
            const float mnew = fmaxf(mrun, mx), alpha = __builtin_amdgcn_exp2f(mrun - mnew); mrun = mnew;
            float psum = 0.f;
#pragma unroll
            for (int n = 0; n < 4; ++n)
#pragma unroll
                for (int r = 0; r < 4; ++r) { const float p = __builtin_amdgcn_exp2f(s[n][r] - mnew); s[n][r] = p; psum += p; }
            lsum = lsum * alpha + psum;
#pragma unroll
            for (int m = 0; m < 4; ++m) o[m] = o[m] * alpha;
            bf16x8 pf[2];
#pragma unroll
            for (int kk = 0; kk < 2; ++kk) { const unsigned a0 = pk2(s[2 * kk][0], s[2 * kk][1]), a1 = pk2(s[2 * kk][2], s[2 * kk][3]), a2 = pk2(s[2 * kk + 1][0], s[2 * kk + 1][1]), a3 = pk2(s[2 * kk + 1][2], s[2 * kk + 1][3]);
                pf[kk] = __builtin_bit_cast(bf16x8, (u32x4){a0, a1, a2, a3}); }
#pragma unroll
            for (int m = 0; m < 4; ++m)
#pragma unroll
                for (int kk = 0; kk < 2; ++kk) { const bf16x8 a = tr_frag(vb, VLD, 32 * kk + 4 * g, 32 * kk + 16 + 4 * g, 16 * m, lane); o[m] = mfma16(a, pf[kk], o[m]); }
        }
        if (kt + 1 < nt) AT_STORE(cur ^ 1);
        __syncthreads();
    }
#undef AT_LOAD
#undef AT_STORE
    lsum += __shfl_xor(lsum, 16); lsum += __shfl_xor(lsum, 32);
    const float inv = 1.0f / lsum; bf16_t* orow = Og + (size_t)(row0 + q0w + i) * DM;
#pragma unroll
    for (int m = 0; m < 4; ++m) { u32x2 ov; ov.x = pk2(o[m][0] * inv, o[m][1] * inv); ov.y = pk2(o[m][2] * inv, o[m][3] * inv); *(u32x2*)(orow + 16 * m + 4 * g) = ov; }
}

__device__ __forceinline__ void p3_ssd_unit(Ctx& C, int l, int cu) {
    const int b = cu >> 5, c = cu & 31, t0 = cu * 64; const int tid = C.tid, lane = C.lane, w = C.wave, g = lane >> 4, i = lane & 15;
    const bf16_t* PM = WSP(bf16_t, WS_PM); bf16_t* Y = WSP(bf16_t, WS_S1);
    ssd_fill(C, l, cu);
    const LAS float* AC = (const LAS float*)(C.lds + ACUM_OFF); const LAS float* DT = (const LAS float*)(C.lds + DT_OFF);
    { f32x4 st[8];
#pragma unroll
      for (int k = 0; k < 8; ++k) st[k] = (f32x4){0.f, 0.f, 0.f, 0.f};
      const float* STG = WSP(float, WS_ST); const float* CD = WSP(float, WS_CDEC);
#pragma unroll 1
      for (int cp = 0; cp < c; ++cp) { const int cuu = b * 32 + cp; const f32x4 dec4 = *(const f32x4*)(CD + cuu * 4);
#pragma unroll
          for (int k = 0; k < 8; ++k) { const int f = tid + NTHR * k; const f32x4 v = *(const f32x4*)(STG + (size_t)cuu * 16384 + (size_t)f * 4); const float dec = dec4[k >> 1]; st[k] = st[k] * dec + v; } }
#pragma unroll
      for (int k = 0; k < 8; ++k) { const int f = tid + NTHR * k, h = f >> 10, rem = f & 1023, p = rem >> 4, n = (rem & 15) * 4;
          u32x2 o; o.x = pk2(st[k][0], st[k][1]); o.y = pk2(st[k][2], st[k][3]); *(LAS u32x2*)(C.lds + PV_OFF + ((h * 64 + p) * ML_LD + n) * 2) = o; } }
    __syncthreads();
    const int h = w >> 1, rh = w & 1, grp = h >> 1; lptr MLw = C.lds + ML_OFF + w * (32 * ML_LD * 2);
    const float Dh = C.a->in[10][l * 4 + h];
#pragma unroll 1
    for (int mbl = 0; mbl < 2; ++mbl) { const int mb = 2 * rh + mbl;
#pragma unroll
        for (int nb = 0; nb < 4; ++nb) { f32x4 acc = {0.f, 0.f, 0.f, 0.f};
#pragma unroll
            for (int kk = 0; kk < 2; ++kk) { const bf16x8 a = *(const LAS bf16x8*)(C.lds + CL_OFF + ((16 * mb + i) * BC_LD + 64 * grp + 32 * kk + 8 * g) * 2);
                const bf16x8 bq = *(const LAS bf16x8*)(C.lds + BL_OFF + ((16 * nb + i) * BC_LD + 64 * grp + 32 * kk + 8 * g) * 2); acc = mfma16(a, bq, acc); }
            const int s = 16 * nb + i; const float as = AC[s * 4 + h], ds = DT[s * 4 + h];
#pragma unroll
            for (int r = 0; r < 4; ++r) { const int lr = 16 * mb + 4 * g + r; const float v = (s <= lr) ? acc[r] * __expf(AC[lr * 4 + h] - as) * ds : 0.f;
                *(LAS unsigned short*)(MLw + ((16 * mbl + 4 * g + r) * ML_LD + s) * 2) = (unsigned short)f2bf(v); } }
        LDS_WAIT(); asm volatile("" ::: "memory");
        f32x4 ad[4], ao[4];
#pragma unroll
        for (int nb = 0; nb < 4; ++nb) { ad[nb] = (f32x4){0.f, 0.f, 0.f, 0.f}; ao[nb] = (f32x4){0.f, 0.f, 0.f, 0.f};
#pragma unroll
            for (int kk = 0; kk < 2; ++kk) {
                const bf16x8 a = *(const LAS bf16x8*)(MLw + ((16 * mbl + i) * ML_LD + 32 * kk + 8 * g) * 2);
                const bf16x8 bx = tr_frag(C.lds + XS_OFF, XS_LD, 32 * kk + 8 * g, 32 * kk + 8 * g + 4, 64 * h + 16 * nb, lane);
                ad[nb] = mfma16(a, bx, ad[nb]);
                const bf16x8 a2 = *(const LAS bf16x8*)(C.lds + CL_OFF + ((16 * mb + i) * BC_LD + 64 * grp + 32 * kk + 8 * g) * 2);
                const bf16x8 b2 = *(const LAS bf16x8*)(C.lds + PV_OFF + ((h * 64 + 16 * nb + i) * ML_LD + 32 * kk + 8 * g) * 2);
                ao[nb] = mfma16(a2, b2, ao[nb]); } }
        LDS_WAIT(); asm volatile("" ::: "memory");
        float ssq[4] = {0.f, 0.f, 0.f, 0.f};
#pragma unroll
        for (int nb = 0; nb < 4; ++nb)
#pragma unroll
            for (int r = 0; r < 4; ++r) { const int lr = 16 * mb + 4 * g + r; const int ch = 64 * h + 16 * nb + i;
                const float xs = bf2f(*(const LAS unsigned short*)(C.lds + XS_OFF + (lr * XS_LD + ch) * 2));
                float y = ad[nb][r] + __expf(AC[lr * 4 + h]) * ao[nb][r] + Dh * xs;
                const float z = bf2f(PM[(size_t)(t0 + lr) * NPROJ + C_Z + ch]); y *= silu_f(z);
                ssq[r] += y * y;
                *(LAS unsigned short*)(MLw + ((16 * mbl + 4 * g + r) * ML_LD + 16 * nb + i) * 2) = (unsigned short)f2bf(y); }
#pragma unroll
        for (int r = 0; r < 4; ++r) { float q = ssq[r]; q += __shfl_xor(q, 1); q += __shfl_xor(q, 2); q += __shfl_xor(q, 4); q += __shfl_xor(q, 8);
            if (i == 0) ((LAS float*)(C.lds + SSQ_OFF))[(16 * mb + 4 * g + r) * 4 + h] = q; } }
    __syncthreads();
    { const float* gn = C.a->in[11] + l * 256;
      const int lr_l = lane >> 1, hf = lane & 1, lr = 32 * rh + lr_l; const f32x4 q4 = *(const LAS f32x4*)(C.lds + SSQ_OFF + lr * 16);
      const float rs = 1.0f / sqrtf(((q4.x + q4.y) + (q4.z + q4.w)) * (1.0f / 256.0f) + RMS_EPS);
#pragma unroll
      for (int k = 0; k < 4; ++k) { const int ch = 64 * h + 32 * hf + 8 * k; const u32x4 yv = *(const LAS u32x4*)(MLw + (lr_l * ML_LD + 32 * hf + 8 * k) * 2);
          u32x4 o; o.x = pk2(bflo(yv.x) * rs * gn[ch + 0], bfhi(yv.x) * rs * gn[ch + 1]); o.y = pk2(bflo(yv.y) * rs * gn[ch + 2], bfhi(yv.y) * rs * gn[ch + 3]);
          o.z = pk2(bflo(yv.z) * rs * gn[ch + 4], bfhi(yv.z) * rs * gn[ch + 5]); o.w = pk2(bflo(yv.w) * rs * gn[ch + 6], bfhi(yv.w) * rs * gn[ch + 7]);
          *(u32x4*)(Y + (size_t)(t0 + lr) * DM + 512 + ch) = o; } }
    __syncthreads();
}

__device__ __forceinline__ void moe_tables(Ctx& C, int l) {
    LAS int* cnt = (LAS int*)(C.lds + LDS_SCR + SCR_CNT); LAS int* tb = (LAS int*)(C.lds + LDS_SCR + SCR_TBASE); LAS int* te = (LAS int*)(C.lds + LDS_SCR + SCR_TILEE); LAS int* ntp = (LAS int*)(C.lds + LDS_SCR + SCR_NT);
    if (C.tid < 32) cnt[C.tid] = (int)__hip_atomic_load(WSP(unsigned, WS_CTL) + CW_CNT + l * 32 + C.tid, __ATOMIC_RELAXED, __HIP_MEMORY_SCOPE_AGENT);
    __syncthreads();
    if (C.tid == 0) { int a = 0; for (int e = 0; e < 32; ++e) { tb[e] = a; a += (cnt[e] + 255) >> 8; } tb[32] = a; *ntp = a; }
    __syncthreads();
    if (C.tid < 160) { int e = 0; for (int k = 1; k < 32; ++k) if (tb[k] <= C.tid) e = k; te[C.tid] = e; }
    __syncthreads();
}
template <int NPN> struct MoeOrder {
    static constexpr int npn = NPN; int G, c; const LAS int* cnt; const LAS int* tb; const LAS int* te; int ntile; const int* rowl;
    __device__ __forceinline__ bool next(int i, pg8::Unit& u) const {
        const int L = i * G + c; if (L >= ntile * npn) return false;
        const int ti = L / npn, pnl = L % npn; const int e = __builtin_amdgcn_readfirstlane(te[ti]);
        u.pm = ti; u.pn = e * npn + pnl; u.e = e; u.r0 = (ti - __builtin_amdgcn_readfirstlane(tb[e])) * 256; u.ne = __builtin_amdgcn_readfirstlane(cnt[e]); return true;
    }
    __device__ __forceinline__ int arow(const pg8::Unit& u, int r) const { const int rr = u.r0 + r; return rr < u.ne ? rowl[(size_t)u.e * T + rr] : 0; }
    __device__ __forceinline__ void a_ready(const pg8::Unit&) const {}
    __device__ __forceinline__ void done(const pg8::Unit&) const {}
};

__device__ __forceinline__ void p5_router(Ctx& C, int l, int en) {
    const int gw = C.bx * NWAVES + C.wave, NGW = C.G * NWAVES, lane = C.lane;
    if (en & 16) {
        LAS float* scr = (LAS float*)(C.lds + C.wave * 8704);
        for (int it = gw; it < 32 * 384; it += NGW) { const int e = it / 384, r = it % 384, ln = lane & 31;
            if (r < 256) { const int kb = r >> 4, nb = r & 15, n = 32 * nb + ln, pn = n >> 8, bj = (n >> 7) & 1, ff = n & 127;
                transpose_item((bj ? C.a->in[23] : C.a->in[22]) + (size_t)(l * 32 + e) * 1024 * 256, 256, 128 * pn + ff, 64 * kb, C.a->in[17] + l * 1024, WSP(bf16_t, WS_BGU) + (size_t)e * 512 * 1024 + (size_t)(32 * nb) * 1024 + 64 * kb, 1024, scr, lane); }
            else { const int r2 = r - 256, kb = r2 >> 5, nb = r2 & 31;
                transpose_item(C.a->in[24] + (size_t)(l * 32 + e) * 256 * 1024, 1024, 32 * nb + ln, 64 * kb, nullptr, WSP(bf16_t, WS_BD) + (size_t)e * 1024 * 256 + (size_t)(32 * nb) * 256 + 64 * kb, 256, scr, lane); } }
        __syncthreads();
    }
    LAS float* WR = (LAS float*)C.lds; const float* gain = C.a->in[17] + l * 1024;
    if (en & 16) {
        for (int idx = C.tid; idx < 36 * 1024; idx += NTHR) { const int cc = idx >> 10, k = idx & 1023;
            WR[idx] = gain[k] * (cc < 4 ? C.a->in[18][(size_t)l * 4096 + k * 4 + cc] : C.a->in[20][(size_t)l * 32768 + k * 32 + (cc - 4)]); }
        __syncthreads();
    }
    const float* X1 = WSP(float, WS_X1); bf16_t* HB = WSP(bf16_t, WS_S1);
    unsigned* CNT = WSP(unsigned, WS_CTL) + CW_CNT + l * 32; int* ROWL = WSP(int, WS_ROWL); int* TE = WSP(int, WS_TOKE); int* TP = WSP(int, WS_TOKP); float* TW = WSP(float, WS_TOKW);
    if (en & 16)
    for (int t = gw; t < T; t += NGW) {
        const f32x4* xr = (const f32x4*)(X1 + (size_t)t * DM) + lane; f32x4 xv[4]; float s = 0.f;
#pragma unroll
        for (int j = 0; j < 4; ++j) { xv[j] = xr[64 * j]; s += (xv[j].x * xv[j].x + xv[j].y * xv[j].y) + (xv[j].z * xv[j].z + xv[j].w * xv[j].w); }
        const float rstd = 1.0f / sqrtf(wave_sum(s) * (1.0f / DM) + RMS_EPS);
        { u32x2* o8 = (u32x2*)(HB + (size_t)t * DM) + lane;
#pragma unroll
          for (int j = 0; j < 4; ++j) { u32x2 wv; wv.x = pk2(xv[j].x * rstd, xv[j].y * rstd); wv.y = pk2(xv[j].z * rstd, xv[j].w * rstd); o8[64 * j] = wv; } }
        float lg[4];
#pragma unroll
        for (int cc = 0; cc < 4; ++cc) { float p = 0.f;
#pragma unroll
            for (int j = 0; j < 4; ++j) { const f32x4 wv = *(const LAS f32x4*)(WR + cc * 1024 + 256 * j + 4 * lane); p += (xv[j].x * wv.x + xv[j].y * wv.y) + (xv[j].z * wv.z + xv[j].w * wv.w); }
            lg[cc] = wave_sum(p) * rstd + C.a->in[19][l * 4 + cc]; }
        int gi = 0; float gm = lg[0];
#pragma unroll
        for (int cc = 1; cc < 4; ++cc) if (lg[cc] > gm) { gm = lg[cc]; gi = cc; }
        float gs = 0.f;
#pragma unroll
        for (int cc = 0; cc < 4; ++cc) gs += __expf(lg[cc] - gm);
        const float gwt = 1.0f / gs;
        gi = __builtin_amdgcn_readfirstlane(gi);
        float le[8];
#pragma unroll
        for (int e = 0; e < 8; ++e) { float p = 0.f; const LAS float* wrow = WR + (4 + 8 * gi + e) * 1024;
#pragma unroll
            for (int j = 0; j < 4; ++j) { const f32x4 wv = *(const LAS f32x4*)(wrow + 256 * j + 4 * lane); p += (xv[j].x * wv.x + xv[j].y * wv.y) + (xv[j].z * wv.z + xv[j].w * wv.w); }
            le[e] = wave_sum(p) * rstd + C.a->in[21][l * 32 + 8 * gi + e]; }
        int e0 = 0; float m0 = le[0];
#pragma unroll
        for (int e = 1; e < 8; ++e) if (le[e] > m0) { m0 = le[e]; e0 = e; }
        int e1 = -1; float m1 = -INFINITY;
#pragma unroll
        for (int e = 0; e < 8; ++e) if (e != e0 && le[e] > m1) { m1 = le[e]; e1 = e; }
        const float w0 = 1.0f / (1.0f + __expf(m1 - m0)), w1 = 1.0f - w0;
        if (lane == 0) { const int E0 = 8 * gi + e0, E1 = 8 * gi + e1;
            const int p0 = (int)__hip_atomic_fetch_add(CNT + E0, 1u, __ATOMIC_RELAXED, __HIP_MEMORY_SCOPE_AGENT), p1 = (int)__hip_atomic_fetch_add(CNT + E1, 1u, __ATOMIC_RELAXED, __HIP_MEMORY_SCOPE_AGENT);
            ROWL[(size_t)E0 * T + p0] = t; ROWL[(size_t)E1 * T + p1] = t;
            TE[t * 2] = E0; TE[t * 2 + 1] = E1; TP[t * 2] = p0; TP[t * 2 + 1] = p1; TW[t * 2] = gwt * w0; TW[t * 2 + 1] = gwt * w1; }
    }
}

__device__ __forceinline__ void p7_combine(Ctx& C, int l, int en, bool last_layer) {
    const int gw = C.bx * NWAVES + C.wave, NGW = C.G * NWAVES, lane = C.lane;
    const LAS int* tb = (const LAS int*)(C.lds + LDS_SCR + SCR_TBASE);
    if (en & 16) moe_tables(C, l);
    float* X1 = WSP(float, WS_X1); const bf16_t* YS = WSP(bf16_t, WS_PM); const int* TE = WSP(int, WS_TOKE); const int* TP = WSP(int, WS_TOKP); const float* TW = WSP(float, WS_TOKW);
    for (int t = gw; t < T; t += NGW) {
        f32x4* xr = (f32x4*)(X1 + (size_t)t * DM) + lane; f32x4 xv[4];
#pragma unroll
        for (int j = 0; j < 4; ++j) xv[j] = xr[64 * j];
        if (en & 16) {
#pragma unroll
            for (int k = 0; k < 2; ++k) { const int e = __builtin_amdgcn_readfirstlane(TE[t * 2 + k]), pos = __builtin_amdgcn_readfirstlane(TP[t * 2 + k]); const float wt = TW[t * 2 + k];
                const u32x2* yr = (const u32x2*)(YS + (size_t)(tb[e] * 256 + pos) * DM) + lane;
#pragma unroll
                for (int j = 0; j < 4; ++j) { const u32x2 y = yr[64 * j]; xv[j].x += wt * bflo(y.x); xv[j].y += wt * bfhi(y.x); xv[j].z += wt * bflo(y.y); xv[j].w += wt * bfhi(y.y); } } }
        float s = 0.f;
#pragma unroll
        for (int j = 0; j < 4; ++j) s += (xv[j].x * xv[j].x + xv[j].y * xv[j].y) + (xv[j].z * xv[j].z + xv[j].w * xv[j].w);
        const float rstd = 1.0f / sqrtf(wave_sum(s) * (1.0f / DM) + RMS_EPS);
        if (last_layer) { f32x4* orow = (f32x4*)(C.out + (size_t)t * DM) + lane; const f32x4* gn = (const f32x4*)C.a->in[25] + lane;
#pragma unroll
            for (int j = 0; j < 4; ++j) orow[64 * j] = xv[j] * rstd * gn[64 * j]; }
        else {
#pragma unroll
            for (int j = 0; j < 4; ++j) xr[64 * j] = xv[j];
            if (lane == 0) WSP(float, WS_RSTD)[t] = rstd;
            u32x2* o8 = (u32x2*)(WSP(bf16_t, WS_S1) + (size_t)t * DM) + lane;
#pragma unroll
            for (int j = 0; j < 4; ++j) { u32x2 wv; wv.x = pk2(xv[j].x, xv[j].y); wv.y = pk2(xv[j].z, xv[j].w); o8[64 * j] = wv; } }
    }
}

#ifndef PHMASK
#define PHMASK 0x1ff
#endif
#define IN(k) (((PHMASK >> ((k) == 0 ? 0 : (((k) - 1) % 8) + 1)) & 1) && lo <= (k) && (k) < hi)
#define SEAM(k) do { if (IN(k) && IN((k) + 1)) xcd_barrier(bar); } while (0)
template <int l>
__device__ __forceinline__ void layer_phases(Ctx& C, const XcdBarrier& bar, int lo_, int hi_) {
#if MK_SPLIT
    const int lo = lo_, hi = hi_;
#else
    constexpr int lo = 0, hi = NPHASE;
#endif
        const int en = l ? EN1 : EN0; const int pb = 8 * l; const bool lastl = (l == (EN_L1 ? 1 : 0));
        LAUNDER();
        if (IN(pb + 1)) {
            pg8::Gemm gm{WSP(bf16_t, WS_S1), WSP(bf16_t, WS_WIN) + (size_t)l * NPROJ * 1024, T, NPROJ, DM}; pg8::StaticOrder S; S.init(T, NPROJ, C.G, C.bx);
            pg8::EpiInProj E{WSP(bf16_t, WS_PM), NPROJ, WSP(float, WS_RSTD), WSP(float, WS_FD), 10};
            pg8::gemm_phase<pg8::EpiInProj, pg8::StaticOrder, true, true>(C.lds, gm, S, E);
        }
        SEAM(pb + 1);
        LAUNDER();
        if (IN(pb + 2)) { for (int cu = C.bx; cu < NCHK; cu += C.G) p2_unit(C, l, cu, en); }
        SEAM(pb + 2);
        LAUNDER();
        if (IN(pb + 3)) {
            bf16_t* Y = WSP(bf16_t, WS_S1); const bf16_t* PM = WSP(bf16_t, WS_PM);
            for (int pu = C.bx; pu < 256; pu += C.G) { const int bh = pu >> 3, s = pu & 7, b = bh >> 2, h = bh & 3, row0 = b * SEQ;
                if (en & 2) {
                    attn_unit<64, true>(C, PM + C_FQ + 64 * h, NPROJ, PM + C_FK + 64 * h, NPROJ, PM + C_FV + 64 * h, NPROJ, Y + 256 + 64 * h, WSP(float, WS_CUM) + h, row0, 15 - s, 0.125f * LOG2E);
                    attn_unit<64, true>(C, PM + C_FQ + 64 * h, NPROJ, PM + C_FK + 64 * h, NPROJ, PM + C_FV + 64 * h, NPROJ, Y + 256 + 64 * h, WSP(float, WS_CUM) + h, row0, s, 0.125f * LOG2E); }
                if (en & 8) {
                    attn_unit<96, false>(C, WSP(bf16_t, WS_QM) + 96 * h, 384, WSP(bf16_t, WS_KM) + 96 * h, 384, WSP(bf16_t, WS_VM) + 64 * h, 256, Y + 768 + 64 * h, nullptr, row0, 15 - s, 0.10206207261596575f * LOG2E);
                    attn_unit<96, false>(C, WSP(bf16_t, WS_QM) + 96 * h, 384, WSP(bf16_t, WS_KM) + 96 * h, 384, WSP(bf16_t, WS_VM) + 64 * h, 256, Y + 768 + 64 * h, nullptr, row0, s, 0.10206207261596575f * LOG2E); } }
            if (en & 4) { for (int cu = C.bx; cu < NCHK; cu += C.G) p3_ssd_unit(C, l, cu); }
        }
        SEAM(pb + 3);
        LAUNDER();
        if (IN(pb + 4)) {
            pg8::Gemm gm{WSP(bf16_t, WS_S1), WSP(bf16_t, WS_WOUT) + (size_t)l * 1024 * 1024, T, DM, DM}; pg8::StaticOrder S; S.init(T, DM, C.G, C.bx);
            pg8::EpiResid E{l == 0 ? C.a->in[0] : WSP(float, WS_X1), WSP(float, WS_X1), DM};
            pg8::gemm_phase<pg8::EpiResid, pg8::StaticOrder, true, true>(C.lds, gm, S, E);
        }
        SEAM(pb + 4);
        LAUNDER();
        if (IN(pb + 5)) { p5_router(C, l, en); }
        SEAM(pb + 5);
        LAUNDER();
        if (IN(pb + 6)) { if (en & 16) {
            moe_tables(C, l);
            MoeOrder<2> S{C.G, C.bx, (const LAS int*)(C.lds + LDS_SCR + SCR_CNT), (const LAS int*)(C.lds + LDS_SCR + SCR_TBASE), (const LAS int*)(C.lds + LDS_SCR + SCR_TILEE),
                       __builtin_amdgcn_readfirstlane(*(const LAS int*)(C.lds + LDS_SCR + SCR_NT)), WSP(int, WS_ROWL)};
            pg8::Gemm gm{WSP(bf16_t, WS_S1), WSP(bf16_t, WS_BGU), T, 512, DM};
            pg8::EpiGateUp E{WSP(bf16_t, WS_HACT), 256};
            pg8::gemm_phase_gather<pg8::EpiGateUp, MoeOrder<2>, true>(C.lds, gm, S, E); } }
        SEAM(pb + 6);
        LAUNDER();
        if (IN(pb + 7)) { if (en & 16) {
            moe_tables(C, l);
            MoeOrder<4> S{C.G, C.bx, (const LAS int*)(C.lds + LDS_SCR + SCR_CNT), (const LAS int*)(C.lds + LDS_SCR + SCR_TBASE), (const LAS int*)(C.lds + LDS_SCR + SCR_TILEE),
                       __builtin_amdgcn_readfirstlane(*(const LAS int*)(C.lds + LDS_SCR + SCR_NT)), WSP(int, WS_ROWL)};
            int kdim = 256; asm volatile("" : "+s"(kdim));
            pg8::Gemm gm{WSP(bf16_t, WS_HACT), WSP(bf16_t, WS_BD), 160 * 256, 1024, kdim};
            pg8::EpiSlotY E{WSP(bf16_t, WS_PM), DM};
            pg8::gemm_phase<pg8::EpiSlotY, MoeOrder<4>, true, true>(C.lds, gm, S, E); } }
        SEAM(pb + 7);
        LAUNDER();
        if (IN(pb + 8)) { p7_combine(C, l, en, lastl); }
        if (!lastl) SEAM(pb + 8);
    }
__global__ void __launch_bounds__(NTHR, 2) hcc_fwd(Args args) {
    extern __shared__ __attribute__((aligned(16))) unsigned char lds_raw[];
    Ctx C; C.lds = (lptr)lds_raw; C.tid = threadIdx.x; C.lane = C.tid & 63; C.wave = __builtin_amdgcn_readfirstlane(C.tid >> 6); C.G = gridDim.x; C.bx = blockIdx.x;
    C.a = (const __attribute__((address_space(4))) Args*)__builtin_amdgcn_kernarg_segment_ptr(); C.out = C.a->out; C.ws = C.a->ws;
    volatile LAS unsigned* MISC = (volatile LAS unsigned*)(C.lds + LDS_CTL);
    if (C.tid < 64) MISC[C.tid] = 0u;
    __syncthreads();
    XcdBarrier bar; bar.bar = WSP(unsigned, WS_CTL) + CW_BAR; bar.x = 0; bar.st = nullptr;
    if (!MK_SPLIT) bar = xcd_barrier_post(WSP(unsigned, WS_CTL) + CW_BAR, MISC + 8);
#if MK_SPLIT
    const int lo = C.a->ph_lo, hi = C.a->ph_hi;
#else
    constexpr int lo = 0, hi = NPHASE;
#endif

    if (IN(0)) { p0_prologue(C); }
    SEAM(0);
    layer_phases<0>(C, bar, lo, hi);
    if (EN_L1) layer_phases<1>(C, bar, lo, hi);
#undef IN
#undef SEAM
}

extern "C" void kernel_launch(void* const* d_in, const int* in_sizes, int n_in, void* d_out, int out_size, void* d_ws, size_t ws_size, hipStream_t stream) {
    static int grid = 0;
    if (grid == 0) {
        if (n_in != 26 || in_sizes[0] != T * DM || out_size != T * DM || ws_size < WS_NEED) { fprintf(stderr, "kernel_launch: unexpected shapes (n_in %d, in0 %d, out %d, ws %zu)\n", n_in, n_in > 0 ? in_sizes[0] : -1, out_size, ws_size); grid = -1; return; }
        int dev = 0, cus = 0, per_cu = 0;
        if (hipGetDevice(&dev) != hipSuccess || hipDeviceGetAttribute(&cus, hipDeviceAttributeMultiprocessorCount, dev) != hipSuccess) { grid = -1; return; }
        if (hipFuncSetAttribute((const void*)hcc_fwd, hipFuncAttributeMaxDynamicSharedMemorySize, LDS_BYTES) != hipSuccess) { fprintf(stderr, "kernel_launch: hipFuncSetAttribute failed\n"); grid = -1; return; }
        if (hipOccupancyMaxActiveBlocksPerMultiprocessor(&per_cu, (const void*)hcc_fwd, NTHR, LDS_BYTES) != hipSuccess || per_cu < 1) { fprintf(stderr, "kernel_launch: occupancy query says %d\n", per_cu); }
        (void)hipGetLastError();
        grid = cus;
    }
    if (grid < 0) return;
    if (hipMemsetAsync((char*)d_ws + WS_CTL, 0, CTL_ZERO_BYTES, stream) != hipSuccess) return;
    Args a{};
    for (int i = 0; i < 26; ++i) a.in[i] = (const float*)d_in[i];
    a.out = (float*)d_out; a.ws = (unsigned char*)d_ws;
#if MK_SPLIT
    for (int p = 0; p < NPHASE; ++p) { a.ph_lo = p; a.ph_hi = p + 1; hipLaunchKernelGGL(hcc_fwd, dim3(grid), dim3(NTHR), LDS_BYTES, stream, a); }
#else
    a.ph_lo = 0; a.ph_hi = NPHASE; hipLaunchKernelGGL(hcc_fwd, dim3(grid), dim3(NTHR), LDS_BYTES, stream, a);
#endif
}
```

```cpp
#include <hip/hip_runtime.h>
#include <cstdio>
#include <cstdint>
#include <cmath>
#define GAS __attribute__((address_space(1)))
#define LAS __attribute__((address_space(3)))
namespace pg8 {
#define PG8_LAS __attribute__((address_space(3)))
typedef unsigned short bf16_t;
typedef short bf16x8 __attribute__((ext_vector_type(8)));
typedef float f32x4 __attribute__((ext_vector_type(4)));
typedef unsigned u32x4 __attribute__((ext_vector_type(4)));
constexpr int BM = 256, BK = 64, HALF = 128, HTB = HALF * BK * 2  , STAGE_BYTES = 8 * HTB, NXCD = 8, WGM = 8;

__host__ __device__ __forceinline__ int lds_byte(int r, int c) { const int st = (r >> 4) * 2 + (c >> 5), rr = r & 15, cc = c & 31, ob = rr * 64 + cc * 2; return st * 1024 + (ob ^ (((ob >> 9) & 1) << 5)); }
__host__ __device__ __forceinline__ void stage_rc(int b, int& R, int& C) { const int st = b / 1024, sb = b % 1024, swz = sb ^ (((sb >> 9) & 1) << 5); R = (st >> 1) * 16 + swz / 64; C = (st & 1) * 32 + (swz % 64) / 2; }
__host__ __device__ __forceinline__ int perm32(int rho) { const int n = rho >> 4, i = rho & 15; return 8 * (i >> 2) + 4 * n + (i & 3); }

struct Unit { int pm, pn, e, r0, ne; };
struct Gemm { const bf16_t* A; const bf16_t* Bt; int M, N, K; };

struct StaticOrder {
    int nM, nN, nwg, G, c;
    __host__ __device__ void init(int M, int N, int G_, int c_) { nM = M / BM; nN = N / BM; nwg = nM * nN; G = G_; c = c_; }
    __host__ __device__ bool next(int i, Unit& u) const {
        const long L = (long)i * G + c; if (L >= nwg) return false;
        int wgid = (int)L; { const int q = nwg / NXCD, r = nwg % NXCD, xcd = wgid % NXCD, off = wgid / NXCD; wgid = (xcd < r ? xcd * (q + 1) : r * (q + 1) + (xcd - r) * q) + off; }
        const int nig = WGM * nN, gid = wgid / nig, fm = gid * WGM, gsz = (nM - fm) < WGM ? (nM - fm) : WGM;
        u.pm = fm + ((wgid % nig) % gsz); u.pn = (wgid % nig) / gsz; return true;
    }
    __device__ __forceinline__ void a_ready(const Unit&) const {}
    __device__ __forceinline__ void done(const Unit&) const {}
};

__device__ __forceinline__ unsigned cvt_pk_bf16(float lo, float hi) { unsigned r; asm volatile("v_cvt_pk_bf16_f32 %0, %1, %2" : "=v"(r) : "v"(lo), "v"(hi)); return r; }

struct EpiInProj {
    static constexpr bool PERM = true, AFTER_DRAIN = false;
    bf16_t* O; int ldc; const float* rstd; float* FD; int fd_pn;
    __device__ __forceinline__ void operator()(const f32x4 (&acc)[2][2][4][2], const Unit& u, int wr, int wc, int fr, int fq) const {
        const int row0 = u.pm * BM + wr * 64 + fr; const int col0 = u.pn * BM + wc * 32 + 8 * fq;
        const bool fdl = (u.pn == fd_pn) && (wc == 1) && (fq == 0);
#pragma unroll
        for (int ai = 0; ai < 2; ++ai)
#pragma unroll
            for (int m = 0; m < 4; ++m) { const int row = row0 + ai * HALF + m * 16; const float rs = rstd[row]; bf16_t* rowp = O + (size_t)row * ldc + col0;
#pragma unroll
                for (int bj = 0; bj < 2; ++bj) { const f32x4 v0 = acc[ai][bj][m][0] * rs, v1 = acc[ai][bj][m][1] * rs;
                    u32x4 w; w.x = cvt_pk_bf16(v0[0], v0[1]); w.y = cvt_pk_bf16(v0[2], v0[3]); w.z = cvt_pk_bf16(v1[0], v1[1]); w.w = cvt_pk_bf16(v1[2], v1[3]);
                    *(u32x4*)(rowp + bj * HALF) = w;
                    if (bj == 1 && fdl) { *(f32x4*)(FD + (size_t)row * 8) = v0; *(f32x4*)(FD + (size_t)row * 8 + 4) = v1; } } }
    }
};
struct EpiResid {
    static constexpr bool PERM = false, AFTER_DRAIN = false;
    const float* base; float* out; int ldc;
    __device__ __forceinline__ void operator()(const f32x4 (&acc)[2][2][4][2], const Unit& u, int wr, int wc, int fr, int fq) const {
        const int row0 = u.pm * BM + wr * 64 + fr; const int col0 = u.pn * BM + wc * 32 + 4 * fq;
#pragma unroll
        for (int ai = 0; ai < 2; ++ai)
#pragma unroll
            for (int m = 0; m < 4; ++m) { const size_t off = (size_t)(row0 + ai * HALF + m * 16) * ldc + col0;
#pragma unroll
                for (int bj = 0; bj < 2; ++bj)
#pragma unroll
                    for (int n = 0; n < 2; ++n) { const f32x4 b = *(const f32x4*)(base + off + bj * HALF + n * 16); *(f32x4*)(out + off + bj * HALF + n * 16) = b + acc[ai][bj][m][n]; } }
    }
};
struct EpiGateUp {
    static constexpr bool PERM = true, AFTER_DRAIN = false;
    bf16_t* O; int ldc;
    __device__ __forceinline__ void operator()(const f32x4 (&acc)[2][2][4][2], const Unit& u, int wr, int wc, int fr, int fq) const {
        const int row0 = u.pm * BM + wr * 64 + fr; const int col0 = (u.pn & 1) * HALF + wc * 32 + 8 * fq;
#pragma unroll
        for (int ai = 0; ai < 2; ++ai)
#pragma unroll
            for (int m = 0; m < 4; ++m) { bf16_t* rowp = O + (size_t)(row0 + ai * HALF + m * 16) * ldc + col0; float h[8];
#pragma unroll
                for (int n = 0; n < 2; ++n)
#pragma unroll
                    for (int j = 0; j < 4; ++j) { const float gt = acc[ai][0][m][n][j], up = acc[ai][1][m][n][j]; h[n * 4 + j] = gt * up / (1.0f + __expf(-gt)); }
                u32x4 w; w.x = cvt_pk_bf16(h[0], h[1]); w.y = cvt_pk_bf16(h[2], h[3]); w.z = cvt_pk_bf16(h[4], h[5]); w.w = cvt_pk_bf16(h[6], h[7]);
                *(u32x4*)rowp = w; }
    }
};
struct EpiSlotY {
    static constexpr bool PERM = true, AFTER_DRAIN = false;
    bf16_t* O; int ldc;
    __device__ __forceinline__ void operator()(const f32x4 (&acc)[2][2][4][2], const Unit& u, int wr, int wc, int fr, int fq) const {
        const int row0 = u.pm * BM + wr * 64 + fr; const int col0 = (u.pn & 3) * BM + wc * 32 + 8 * fq;
#pragma unroll
        for (int ai = 0; ai < 2; ++ai)
#pragma unroll
            for (int m = 0; m < 4; ++m) { bf16_t* rowp = O + (size_t)(row0 + ai * HALF + m * 16) * ldc + col0;
#pragma unroll
                for (int bj = 0; bj < 2; ++bj) { const f32x4 v0 = acc[ai][bj][m][0], v1 = acc[ai][bj][m][1];
                    u32x4 w; w.x = cvt_pk_bf16(v0[0], v0[1]); w.y = cvt_pk_bf16(v0[2], v0[3]); w.z = cvt_pk_bf16(v1[0], v1[1]); w.w = cvt_pk_bf16(v1[2], v1[3]);
                    *(u32x4*)(rowp + bj * HALF) = w; } }
    }
};

template <class Epi, class Sched, bool ALIGN_EPI = false, bool SP2 = false>
__device__ __forceinline__ void gemm_phase(PG8_LAS unsigned char* lds, const Gemm g, const Sched& S, const Epi& E) {
    int tid_ = threadIdx.x; asm volatile("" : "+v"(tid_));
    const int tid = tid_, wid = __builtin_amdgcn_readfirstlane(tid >> 6), lane = tid & 63, wr = wid >> 2, wc = wid & 3, fr = lane & 15, fq = lane >> 4;
    const int K = g.K, nt = K / BK;
    unsigned voffA[2], voffB[2];
#pragma unroll
    for (int i = 0; i < 2; ++i) { int R, C; stage_rc(tid * 16 + i * 8192, R, C); const int Rb = Epi::PERM ? ((R & ~31) + perm32(R & 31)) : R;
        voffA[i] = (unsigned)(R * K + C) * 2u; voffB[i] = (unsigned)(Rb * K + C) * 2u; }
    const size_t kstep = (size_t)(BK * 2);
    const size_t hstep = (size_t)HALF * K * 2;
    const size_t tstep = 2 * hstep;
    const unsigned ldsw = (unsigned)wid * 1024u;
    const int aoff = lds_byte(wr * 64 + fr, fq * 8), boff = lds_byte(wc * 32 + fr, fq * 8);
#define PG8_SA(b, h) (((b) * 2 + (h)) * HTB)
#define PG8_SB(b, h) ((4 + (b) * 2 + (h)) * HTB)
#define PG8_STAGE(bufoff, gbase, voff) do { _Pragma("unroll") for (int _i = 0; _i < 2; ++_i) \
        __builtin_amdgcn_global_load_lds((const unsigned*)((const char*)(gbase) + (voff)[_i]), (PG8_LAS unsigned*)(lds + (bufoff) + ldsw + _i * 8192), 16, 0, 0); } while (0)
#define PG8_LDA(dst, b, h) do { _Pragma("unroll") for (int m = 0; m < 4; ++m) _Pragma("unroll") for (int k = 0; k < 2; ++k) dst[m][k] = *(const PG8_LAS bf16x8*)(lds + PG8_SA(b, h) + aoff + m * 2048 + k * 1024); } while (0)
#define PG8_LDB(dst, b, h) do { _Pragma("unroll") for (int n = 0; n < 2; ++n) _Pragma("unroll") for (int k = 0; k < 2; ++k) dst[n][k] = *(const PG8_LAS bf16x8*)(lds + PG8_SB(b, h) + boff + n * 2048 + k * 1024); } while (0)
#define PG8_MMA(ai, bj, At, Bt) do { __builtin_amdgcn_s_setprio(1); _Pragma("unroll") for (int m = 0; m < 4; ++m) _Pragma("unroll") for (int n = 0; n < 2; ++n) _Pragma("unroll") for (int k = 0; k < 2; ++k) \
        acc[ai][bj][m][n] = __builtin_amdgcn_mfma_f32_16x16x32_bf16(Bt[n][k], At[m][k], acc[ai][bj][m][n], 0, 0, 0); __builtin_amdgcn_s_setprio(0); } while (0)
#define PG8_WAIT_V(n) asm volatile("s_waitcnt vmcnt(" #n ")" ::: "memory")
#define PG8_WAIT_L(n) asm volatile("s_waitcnt lgkmcnt(" #n ")" ::: "memory")
#define PG8_BAR __builtin_amdgcn_s_barrier()
#define PG8_SCHED __builtin_amdgcn_sched_barrier(0)
    Unit cur, nxt; int ui = 0;
    if (!S.next(0, cur)) return;
    f32x4 acc[2][2][4][2];
#pragma unroll
    for (int a = 0; a < 2; ++a)
#pragma unroll
        for (int b = 0; b < 2; ++b)
#pragma unroll
            for (int m = 0; m < 4; ++m)
#pragma unroll
                for (int n = 0; n < 2; ++n) acc[a][b][m][n] = (f32x4){0.f, 0.f, 0.f, 0.f};
    bf16x8 At[4][2], B0[2][2], B1[2][2];
    const char* cA = (const char*)g.A + (size_t)cur.pm * tstep; const char* cB = (const char*)g.Bt + (size_t)cur.pn * tstep;
    S.a_ready(cur);
    if constexpr (SP2) {
        PG8_STAGE(PG8_SB(0, 0), cB, voffB); PG8_STAGE(PG8_SB(0, 1), cB + hstep, voffB); PG8_STAGE(PG8_SA(0, 0), cA, voffA); PG8_STAGE(PG8_SA(0, 1), cA + hstep, voffA);
        if (wr == 1) PG8_BAR;
        PG8_WAIT_V(2); PG8_BAR;
        PG8_STAGE(PG8_SB(1, 0), cB + kstep, voffB); PG8_STAGE(PG8_SA(1, 0), cA + kstep, voffA); PG8_STAGE(PG8_SB(1, 1), cB + hstep + kstep, voffB);
        PG8_WAIT_V(6); PG8_BAR;
    } else {
        PG8_STAGE(PG8_SB(0, 0), cB, voffB); PG8_STAGE(PG8_SA(0, 0), cA, voffA); PG8_STAGE(PG8_SB(0, 1), cB + hstep, voffB); PG8_STAGE(PG8_SA(0, 1), cA + hstep, voffA);
        if (wr == 1) PG8_BAR;
        PG8_WAIT_V(4); PG8_BAR;
        PG8_STAGE(PG8_SB(1, 0), cB + kstep, voffB); PG8_STAGE(PG8_SA(1, 0), cA + kstep, voffA); PG8_STAGE(PG8_SB(1, 1), cB + hstep + kstep, voffB);
        PG8_WAIT_V(6); PG8_BAR;
    }
    for (;;) {
        const bool has_next = S.next(ui + 1, nxt);
        const char* nA = has_next ? (const char*)g.A + (size_t)nxt.pm * tstep : cA; const char* nB = has_next ? (const char*)g.Bt + (size_t)nxt.pn * tstep : cB;
        for (int t = 0; t < nt; t += 2) {
            const bool last = (t == nt - 2);
            const char* a1 = cA + (size_t)(t + 1) * kstep;
            const char* a2 = last ? nA : cA + (size_t)(t + 2) * kstep; const char* b2 = last ? nB : cB + (size_t)(t + 2) * kstep;
            const char* a3 = a2 + kstep; const char* b3 = b2 + kstep;
            if (last && has_next) S.a_ready(nxt);
            if constexpr (SP2) {
            PG8_LDB(B0, 0, 0); PG8_LDB(B1, 0, 1); PG8_SCHED; PG8_LDA(At, 0, 0); PG8_STAGE(PG8_SA(1, 1), a1 + hstep, voffA);
            PG8_WAIT_V(8); PG8_WAIT_L(0); PG8_BAR; PG8_MMA(0, 0, At, B0); PG8_MMA(0, 1, At, B1); PG8_BAR; PG8_SCHED;
            PG8_LDA(At, 0, 1); PG8_STAGE(PG8_SB(0, 0), b2, voffB); PG8_STAGE(PG8_SB(0, 1), b2 + hstep, voffB); PG8_STAGE(PG8_SA(0, 0), a2, voffA);
            PG8_WAIT_V(8); PG8_WAIT_L(0); PG8_BAR; PG8_MMA(1, 0, At, B0); PG8_MMA(1, 1, At, B1); PG8_BAR; PG8_SCHED;
            PG8_LDB(B0, 1, 0); PG8_LDB(B1, 1, 1); PG8_SCHED; PG8_LDA(At, 1, 0); PG8_STAGE(PG8_SA(0, 1), a2 + hstep, voffA);
            PG8_WAIT_V(8); PG8_WAIT_L(0); PG8_BAR; PG8_MMA(0, 0, At, B0); PG8_MMA(0, 1, At, B1); PG8_BAR; PG8_SCHED;
            PG8_LDA(At, 1, 1); PG8_STAGE(PG8_SB(1, 0), b3, voffB); PG8_STAGE(PG8_SB(1, 1), b3 + hstep, voffB); PG8_STAGE(PG8_SA(1, 0), a3, voffA);
            PG8_WAIT_V(8); PG8_WAIT_L(0); PG8_BAR; PG8_MMA(1, 0, At, B0); PG8_MMA(1, 1, At, B1); PG8_BAR; PG8_SCHED;
            } else {
            PG8_LDB(B0, 0, 0); PG8_SCHED; PG8_LDA(At, 0, 0); PG8_STAGE(PG8_SA(1, 1), a1 + hstep, voffA);
            PG8_WAIT_L(8); PG8_BAR; PG8_WAIT_L(0); PG8_MMA(0, 0, At, B0); PG8_BAR; PG8_SCHED;
            PG8_LDB(B1, 0, 1); PG8_STAGE(PG8_SB(0, 0), b2, voffB);
            PG8_BAR; PG8_WAIT_L(0); PG8_MMA(0, 1, At, B1); PG8_BAR;
            PG8_LDA(At, 0, 1); PG8_STAGE(PG8_SA(0, 0), a2, voffA);
            PG8_BAR; PG8_WAIT_L(0); PG8_MMA(1, 0, At, B0); PG8_BAR; PG8_SCHED;
            PG8_STAGE(PG8_SB(0, 1), b2 + hstep, voffB);
            PG8_WAIT_V(6); PG8_BAR; PG8_MMA(1, 1, At, B1); PG8_BAR;
            PG8_LDB(B0, 1, 0); PG8_SCHED; PG8_LDA(At, 1, 0); PG8_STAGE(PG8_SA(0, 1), a2 + hstep, voffA);
            PG8_WAIT_L(8); PG8_BAR; PG8_WAIT_L(0); PG8_MMA(0, 0, At, B0); PG8_BAR; PG8_SCHED;
            PG8_LDB(B1, 1, 1); PG8_STAGE(PG8_SB(1, 0), b3, voffB);
            PG8_BAR; PG8_WAIT_L(0); PG8_MMA(0, 1, At, B1); PG8_BAR;
            PG8_LDA(At, 1, 1); PG8_STAGE(PG8_SA(1, 0), a3, voffA);
            PG8_BAR; PG8_WAIT_L(0); PG8_MMA(1, 0, At, B0); PG8_BAR; PG8_SCHED;
            PG8_STAGE(PG8_SB(1, 1), b3 + hstep, voffB);
            PG8_WAIT_V(6); PG8_BAR; PG8_MMA(1, 1, At, B1); PG8_BAR;
            }
        }
        if constexpr (ALIGN_EPI) { if (wr == 0) PG8_BAR; }
        if constexpr (!Epi::AFTER_DRAIN) { E(acc, cur, wr, wc, fr, fq); S.done(cur); }
        if (!has_next) break;
#pragma unroll
        for (int a = 0; a < 2; ++a)
#pragma unroll
            for (int b = 0; b < 2; ++b)
#pragma unroll
                for (int m = 0; m < 4; ++m)
#pragma unroll
                    for (int n = 0; n < 2; ++n) acc[a][b][m][n] = (f32x4){0.f, 0.f, 0.f, 0.f};
        cur = nxt; cA = nA; cB = nB; ++ui;
        if constexpr (ALIGN_EPI) { if (wr == 1) PG8_BAR; }
    }
    PG8_WAIT_V(0);
    if constexpr (!ALIGN_EPI) { if (wr == 0) PG8_BAR; }
    PG8_BAR;
    if constexpr (Epi::AFTER_DRAIN) { E.fused(acc, cur, wr, wc, fr, fq, lds, wid, lane); S.done(cur); }
#undef PG8_SA
#undef PG8_SB
#undef PG8_STAGE
#undef PG8_LDA
#undef PG8_LDB
#undef PG8_MMA
#undef PG8_WAIT_V
#undef PG8_WAIT_L
#undef PG8_BAR
#undef PG8_SCHED
}
template <class Epi, class Sched, bool ALIGN_EPI = false>
__device__ __forceinline__ void gemm_phase_gather(PG8_LAS unsigned char* lds, const Gemm g, const Sched& S, const Epi& E) {
    int tid_ = threadIdx.x; asm volatile("" : "+v"(tid_));
    const int tid = tid_, wid = __builtin_amdgcn_readfirstlane(tid >> 6), lane = tid & 63, wr = wid >> 2, wc = wid & 3, fr = lane & 15, fq = lane >> 4;
    const int K = g.K, nt = K / BK;
    unsigned voffB[2]; int RA[2]; unsigned CA[2];
#pragma unroll
    for (int i = 0; i < 2; ++i) { int R, C; stage_rc(tid * 16 + i * 8192, R, C); const int Rb = Epi::PERM ? ((R & ~31) + perm32(R & 31)) : R;
        RA[i] = R; CA[i] = (unsigned)C * 2u; voffB[i] = (unsigned)(Rb * K + C) * 2u; }
    const size_t kstep = (size_t)(BK * 2);
    const size_t hstep = (size_t)HALF * K * 2;
    const size_t tstep = 2 * hstep;
    const unsigned ldsw = (unsigned)wid * 1024u;
    const int aoff = lds_byte(wr * 64 + fr, fq * 8), boff = lds_byte(wc * 32 + fr, fq * 8);
#define PG8_SA(b, h) (((b) * 2 + (h)) * HTB)
#define PG8_SB(b, h) ((4 + (b) * 2 + (h)) * HTB)
#define PG8_STAGE(bufoff, gbase, voff) do { _Pragma("unroll") for (int _i = 0; _i < 2; ++_i) \
        __builtin_amdgcn_global_load_lds((const unsigned*)((const char*)(gbase) + (voff)[_i]), (PG8_LAS unsigned*)(lds + (bufoff) + ldsw + _i * 8192), 16, 0, 0); } while (0)
#define PG8_LDA(dst, b, h) do { _Pragma("unroll") for (int m = 0; m < 4; ++m) _Pragma("unroll") for (int k = 0; k < 2; ++k) dst[m][k] = *(const PG8_LAS bf16x8*)(lds + PG8_SA(b, h) + aoff + m * 2048 + k * 1024); } while (0)
#define PG8_LDB(dst, b, h) do { _Pragma("unroll") for (int n = 0; n < 2; ++n) _Pragma("unroll") for (int k = 0; k < 2; ++k) dst[n][k] = *(const PG8_LAS bf16x8*)(lds + PG8_SB(b, h) + boff + n * 2048 + k * 1024); } while (0)
#define PG8_MMA(ai, bj, At, Bt) do { __builtin_amdgcn_s_setprio(1); _Pragma("unroll") for (int m = 0; m < 4; ++m) _Pragma("unroll") for (int n = 0; n < 2; ++n) _Pragma("unroll") for (int k = 0; k < 2; ++k) \
        acc[ai][bj][m][n] = __builtin_amdgcn_mfma_f32_16x16x32_bf16(Bt[n][k], At[m][k], acc[ai][bj][m][n], 0, 0, 0); __builtin_amdgcn_s_setprio(0); } while (0)
#define PG8_WAIT_V(n) asm volatile("s_waitcnt vmcnt(" #n ")" ::: "memory")
#define PG8_WAIT_L(n) asm volatile("s_waitcnt lgkmcnt(" #n ")" ::: "memory")
#define PG8_BAR __builtin_amdgcn_s_barrier()
#define PG8_SCHED __builtin_amdgcn_sched_barrier(0)
#define PG8_GOFFS(dst, u) do { _Pragma("unroll") for (int _h = 0; _h < 2; ++_h) _Pragma("unroll") for (int _i = 0; _i < 2; ++_i) \
        dst[_h][_i] = (unsigned)S.arow(u, _h * HALF + RA[_i]) * (unsigned)(K * 2) + CA[_i]; } while (0)
    Unit cur, nxt; int ui = 0;
    if (!S.next(0, cur)) return;
    unsigned vA[2][2], nvA[2][2];
    PG8_GOFFS(vA, cur);
    f32x4 acc[2][2][4][2];
#pragma unroll
    for (int a = 0; a < 2; ++a)
#pragma unroll
        for (int b = 0; b < 2; ++b)
#pragma unroll
            for (int m = 0; m < 4; ++m)
#pragma unroll
                for (int n = 0; n < 2; ++n) acc[a][b][m][n] = (f32x4){0.f, 0.f, 0.f, 0.f};
    bf16x8 At[4][2], B0[2][2], B1[2][2];
    const char* const cA = (const char*)g.A; const char* cB = (const char*)g.Bt + (size_t)cur.pn * tstep;
    asm volatile("s_waitcnt vmcnt(0)" ::: "memory");
    PG8_STAGE(PG8_SB(0, 0), cB, voffB); PG8_STAGE(PG8_SB(0, 1), cB + hstep, voffB); PG8_STAGE(PG8_SA(0, 0), cA, vA[0]); PG8_STAGE(PG8_SA(0, 1), cA, vA[1]);
    if (wr == 1) PG8_BAR;
    PG8_WAIT_V(2); PG8_BAR;
    PG8_STAGE(PG8_SB(1, 0), cB + kstep, voffB); PG8_STAGE(PG8_SA(1, 0), cA + kstep, vA[0]); PG8_STAGE(PG8_SB(1, 1), cB + hstep + kstep, voffB);
    PG8_WAIT_V(6); PG8_BAR;
    for (;;) {
        const bool has_next = S.next(ui + 1, nxt);
        const char* nB = has_next ? (const char*)g.Bt + (size_t)nxt.pn * tstep : cB;
        for (int t = 0; t < nt; t += 2) {
            const bool last = (t == nt - 2);
            if (last) {
                if (has_next) { PG8_GOFFS(nvA, nxt); }
                else {
#pragma unroll
                    for (int _h = 0; _h < 2; ++_h)
#pragma unroll
                        for (int _i = 0; _i < 2; ++_i) nvA[_h][_i] = vA[_h][_i]; }
            }
            unsigned s0[2], s1[2];
#pragma unroll
            for (int _i = 0; _i < 2; ++_i) { s0[_i] = last ? nvA[0][_i] : vA[0][_i]; s1[_i] = last ? nvA[1][_i] : vA[1][_i]; }
            const char* a1 = cA + (size_t)(t + 1) * kstep;
            const char* a2 = last ? cA : cA + (size_t)(t + 2) * kstep; const char* b2 = last ? nB : cB + (size_t)(t + 2) * kstep;
            const char* a3 = a2 + kstep; const char* b3 = b2 + kstep;
            PG8_LDB(B0, 0, 0); PG8_LDB(B1, 0, 1); PG8_SCHED; PG8_LDA(At, 0, 0); PG8_STAGE(PG8_SA(1, 1), a1, vA[1]);
            PG8_WAIT_V(8); PG8_WAIT_L(0); PG8_BAR; PG8_MMA(0, 0, At, B0); PG8_MMA(0, 1, At, B1); PG8_BAR; PG8_SCHED;
            PG8_LDA(At, 0, 1); PG8_STAGE(PG8_SB(0, 0), b2, voffB); PG8_STAGE(PG8_SB(0, 1), b2 + hstep, voffB); PG8_STAGE(PG8_SA(0, 0), a2, s0);
            PG8_WAIT_V(8); PG8_WAIT_L(0); PG8_BAR; PG8_MMA(1, 0, At, B0); PG8_MMA(1, 1, At, B1); PG8_BAR; PG8_SCHED;
            PG8_LDB(B0, 1, 0); PG8_LDB(B1, 1, 1); PG8_SCHED; PG8_LDA(At, 1, 0); PG8_STAGE(PG8_SA(0, 1), a2, s1);
            PG8_WAIT_V(8); PG8_WAIT_L(0); PG8_BAR; PG8_MMA(0, 0, At, B0); PG8_MMA(0, 1, At, B1); PG8_BAR; PG8_SCHED;
            PG8_LDA(At, 1, 1); PG8_STAGE(PG8_SB(1, 0), b3, voffB); PG8_STAGE(PG8_SB(1, 1), b3 + hstep, voffB); PG8_STAGE(PG8_SA(1, 0), a3, s0);
            PG8_WAIT_V(8); PG8_WAIT_L(0); PG8_BAR; PG8_MMA(1, 0, At, B0); PG8_MMA(1, 1, At, B1); PG8_BAR; PG8_SCHED;
        }
        if constexpr (ALIGN_EPI) { if (wr == 0) PG8_BAR; }
        E(acc, cur, wr, wc, fr, fq); S.done(cur);
        if (!has_next) break;
#pragma unroll
        for (int a = 0; a < 2; ++a)
#pragma unroll
            for (int b = 0; b < 2; ++b)
#pragma unroll
                for (int m = 0; m < 4; ++m)
#pragma unroll
                    for (int n = 0; n < 2; ++n) acc[a][b][m][n] = (f32x4){0.f, 0.f, 0.f, 0.f};
        cur = nxt; cB = nB; ++ui;
#pragma unroll
        for (int _h = 0; _h < 2; ++_h)
#pragma unroll
            for (int _i = 0; _i < 2; ++_i) vA[_h][_i] = nvA[_h][_i];
        if constexpr (ALIGN_EPI) { if (wr == 1) PG8_BAR; }
    }
    PG8_WAIT_V(0);
    if constexpr (!ALIGN_EPI) { if (wr == 0) PG8_BAR; }
    PG8_BAR;
#undef PG8_SA
#undef PG8_SB
#undef PG8_STAGE
#undef PG8_LDA
#undef PG8_LDB
#undef PG8_MMA
#undef PG8_WAIT_V
#undef PG8_WAIT_L
#undef PG8_BAR
#undef PG8_SCHED
#undef PG8_GOFFS
}
}

#define XB_TMO      128
#define XB_XCNT(j)  (256  + 64 * (j))
#define XB_XSUB(j)  (1280 + 64 * (j))
#define XB_XGEN(j)  (2304 + 64 * (j))
#define XB_TOP      3328
#define XB_TOPGEN   3392
#define XCD_BAR_WORDS 3456
#define XB_SPIN_CAP (1u << 18)

__device__ __forceinline__ unsigned xb_ld(unsigned* p)              { return __hip_atomic_load(p, __ATOMIC_RELAXED, __HIP_MEMORY_SCOPE_AGENT); }
__device__ __forceinline__ unsigned xb_add(unsigned* p, unsigned v) { return __hip_atomic_fetch_add(p, v, __ATOMIC_RELAXED, __HIP_MEMORY_SCOPE_AGENT); }
__device__ __forceinline__ unsigned xb_xcc_id() { return (unsigned)__builtin_amdgcn_s_getreg((3 << 11) | 20) & 0xFu; }
#define XB_SPIN(cond, bar) do { unsigned _sp = 0; while (cond) { __builtin_amdgcn_s_sleep(1); \
    if ((++_sp & 255u) == 0u) { if (xb_ld(&(bar)[XB_TMO])) break; if (_sp > XB_SPIN_CAP) { atomicAdd(&(bar)[XB_TMO], 1u); break; } } } } while (0)

struct XcdBarrier {
    unsigned* bar; unsigned x;
    volatile LAS unsigned* st;
};

__device__ __forceinline__ XcdBarrier xcd_barrier_post(unsigned* bar, volatile LAS unsigned* st) {
    XcdBarrier b; b.bar = bar; b.x = xb_xcc_id(); b.st = st;
    if (threadIdx.x == 0) (void)xb_add(&bar[XB_XCNT(b.x)], 1u);
    return b;
}
__device__ __forceinline__ void xcd_barrier_complete(unsigned* bar, unsigned x, unsigned& nloc, unsigned& nx) {
    const unsigned G = gridDim.x * gridDim.y * gridDim.z;
    unsigned sum, cnt, mine, sp = 0u;
    for (;;) {
        sum = 0u; cnt = 0u; mine = 0u;
#pragma unroll
        for (unsigned j = 0; j < 16; ++j) { const unsigned c = xb_ld(&bar[XB_XCNT(j)]); sum += c; cnt += (c > 0u) ? 1u : 0u; mine = (j == x) ? c : mine; }
        if (sum == G) break;
        __builtin_amdgcn_s_sleep(1);
        if ((++sp & 255u) == 0u) { if (xb_ld(&bar[XB_TMO])) break; if (sp > XB_SPIN_CAP) { atomicAdd(&bar[XB_TMO], 1u); break; } }
    }
    nloc = mine > 0u ? mine : 1u; nx = cnt > 0u ? cnt : 1u;
}

__device__ __forceinline__ void xcd_barrier(const XcdBarrier& b) {
    asm volatile("s_waitcnt vmcnt(0)" ::: "memory");
    __syncthreads();
    if (threadIdx.x == 0) {
        unsigned* bar = b.bar;
        __builtin_amdgcn_s_waitcnt(0);
        unsigned nloc = b.st[0], nx = b.st[1];
        if (nloc == 0u) { xcd_barrier_complete(bar, b.x, nloc, nx); b.st[0] = nloc; b.st[1] = nx; }
        const unsigned old = xb_add(&bar[XB_XSUB(b.x)], 1u);
        const unsigned gen = old / nloc;
        if (old + 1u == (gen + 1u) * nloc) {
            __builtin_amdgcn_fence(__ATOMIC_RELEASE, "agent");
            asm volatile("s_waitcnt vmcnt(0)" ::: "memory");
            const unsigned og = xb_add(&bar[XB_TOP], 1u);
            const unsigned tg = og / nx;
            if (og + 1u == (tg + 1u) * nx) xb_add(&bar[XB_TOPGEN], 1u);
            else XB_SPIN(xb_ld(&bar[XB_TOPGEN]) == tg, bar);
            __builtin_amdgcn_fence(__ATOMIC_ACQUIRE, "agent");
            xb_add(&bar[XB_XGEN(b.x)], 1u);
            asm volatile("s_waitcnt vmcnt(0)" ::: "memory");
        } else {
            XB_SPIN(xb_ld(&bar[XB_XGEN(b.x)]) == gen, bar);
            __builtin_amdgcn_fence(__ATOMIC_ACQUIRE, "agent");
            asm volatile("s_waitcnt vmcnt(0)" ::: "memory");
        }
    }
    __syncthreads();
}


constexpr int NWAVES = 8, NTHR = 512;
constexpr int T = 16384, DM = 1024, SEQ = 2048, NPROJ = 2816, NCHK = 256;
constexpr float RMS_EPS = 1e-6f, LOG2E = 1.4426950408889634f;
constexpr int C_AB = 0, C_AC = 256, C_AV = 512, C_FQ = 768, C_FK = 1024, C_FV = 1280, C_Z = 1536, C_XBC = 1792, C_CQ = 2304, C_CKV = 2560, C_KR = 2688, C_FD = 2720;
#ifndef EN0
#define EN0 31
#endif
#ifndef EN1
#define EN1 31
#endif
#ifndef EN_L1
#define EN_L1 1
#endif
#ifndef MK_SPLIT
#define MK_SPLIT 0
#endif
constexpr int NPHASE = 17;

constexpr size_t MiB = 1u << 20;
constexpr size_t WS_CTL = 0, CTL_ZERO_BYTES = 65536;
constexpr size_t WS_X1 = 1 * MiB;
constexpr size_t WS_PM = 65 * MiB;
constexpr size_t WS_S1 = 153 * MiB;
constexpr size_t WS_HACT = 185 * MiB;
constexpr size_t WS_E = 205 * MiB;
constexpr size_t WS_QM = WS_E, WS_KM = WS_E + 12 * MiB, WS_VM = WS_E + 24 * MiB, WS_ST = WS_E + 32 * MiB;
constexpr size_t WS_BGU = WS_E, WS_BD = WS_E + 32 * MiB;
constexpr size_t WS_WIN = 261 * MiB;
constexpr size_t WS_WOUT = 272 * MiB;
constexpr size_t WS_WUQ = 276 * MiB;
constexpr size_t WS_WUKV = WS_WUQ + 512 * 1024;
constexpr size_t WS_MISC = 277 * MiB;
constexpr size_t WS_FD = WS_MISC;
constexpr size_t WS_RSTD = WS_FD + 512 * 1024;
constexpr size_t WS_CUM = WS_RSTD + 64 * 1024;
constexpr size_t WS_COS = WS_CUM + 256 * 1024;
constexpr size_t WS_SIN = WS_COS + 1 * MiB;
constexpr size_t WS_CDEC = WS_SIN + 1 * MiB;
constexpr size_t WS_ROWL = WS_CDEC + 64 * 1024;
constexpr size_t WS_TOKE = WS_ROWL + 2 * MiB;
constexpr size_t WS_TOKP = WS_TOKE + 128 * 1024;
constexpr size_t WS_TOKW = WS_TOKP + 128 * 1024;
constexpr size_t WS_END = WS_TOKW + 128 * 1024;
static_assert(WS_END <= 284 * MiB, "workspace map");
constexpr size_t WS_NEED = 284 * MiB;
constexpr int CW_CNT = 64;
constexpr int CW_BAR = 4096;

constexpr int LDS_BYTES = 155648;
constexpr int LDS_SCR = 147456;
constexpr int LDS_CTL = 151552;
constexpr int SCR_RED = 0;
constexpr int SCR_RQ = 256, SCR_RKV = 512;
constexpr int SCR_CNT = 768;
constexpr int SCR_TBASE = 896;
constexpr int SCR_TILEE = 1040;
constexpr int SCR_NT = 1680;

typedef unsigned short bf16_t;
typedef short bf16x8 __attribute__((ext_vector_type(8)));
typedef short s16x4 __attribute__((ext_vector_type(4)));
typedef float f32x4 __attribute__((ext_vector_type(4)));
typedef unsigned u32x4 __attribute__((ext_vector_type(4)));
typedef unsigned u32x2 __attribute__((ext_vector_type(2)));
typedef LAS unsigned char* lptr;
#define LDS_WAIT() asm volatile("s_waitcnt lgkmcnt(0)" ::: "memory")

__device__ __forceinline__ unsigned f2bf(float f) { unsigned u = __builtin_bit_cast(unsigned, f); return (u + 0x7fffu + ((u >> 16) & 1u)) >> 16; }
__device__ __forceinline__ unsigned pk2(float lo, float hi) { return f2bf(lo) | (f2bf(hi) << 16); }
__device__ __forceinline__ float bf2f(unsigned short u) { return __uint_as_float((unsigned)u << 16); }
__device__ __forceinline__ float bflo(unsigned u) { return __uint_as_float(u << 16); }
__device__ __forceinline__ float bfhi(unsigned u) { return __uint_as_float(u & 0xffff0000u); }
__device__ __forceinline__ float wave_sum(float v) {
#pragma unroll
    for (int o = 1; o < 64; o <<= 1) v += __shfl_xor(v, o);
    return v;
}
__device__ __forceinline__ float silu_f(float x) { return x / (1.0f + __expf(-x)); }
__device__ __forceinline__ float softplus_f(float x) { return fmaxf(x, 0.f) + log1pf(__expf(-fabsf(x))); }
__device__ __forceinline__ f32x4 mfma16(bf16x8 a, bf16x8 b, f32x4 c) { return __builtin_amdgcn_mfma_f32_16x16x32_bf16(a, b, c, 0, 0, 0); }
__device__ __forceinline__ bf16x8 tr_frag(lptr base, int ld  , int row_a, int row_b, int col0, int lane) {
    typedef short v4i16_t __attribute__((ext_vector_type(4)));
    const int i = lane & 15, q = i >> 2, p = i & 3;
    const s16x4 lo = __builtin_bit_cast(s16x4, __builtin_amdgcn_ds_read_tr16_b64_v4i16((LAS v4i16_t*)(base + ((row_a + q) * ld + col0 + 4 * p) * 2)));
    const s16x4 hi = __builtin_bit_cast(s16x4, __builtin_amdgcn_ds_read_tr16_b64_v4i16((LAS v4i16_t*)(base + ((row_b + q) * ld + col0 + 4 * p) * 2)));
    return (bf16x8){lo[0], lo[1], lo[2], lo[3], hi[0], hi[1], hi[2], hi[3]};
}

struct Args { const float* in[26]; float* out; unsigned char* ws; int ph_lo, ph_hi; };
struct Ctx {
    lptr lds;
    int tid, lane, wave, G, bx;
    const __attribute__((address_space(4))) Args* a;
    float* out; unsigned char* ws;
};
#define WSP(type, off) ((type*)(C.ws + (off)))
#define LAUNDER() do { unsigned char* p_ = C.ws; int t_ = C.tid; unsigned l_ = (unsigned)(size_t)C.lds; const __attribute__((address_space(4))) Args* a_ = C.a; asm volatile("" : "+s"(p_), "+v"(t_), "+s"(l_), "+s"(a_)); C.a = a_; C.ws = p_; C.tid = t_; C.lane = t_ & 63; C.wave = __builtin_amdgcn_readfirstlane(t_ >> 6); C.lds = (lptr)(size_t)l_; } while (0)

__device__ __forceinline__ int refcol(int n) { return n < 1536 ? n : n < 2304 ? n + 4 : n < 2720 ? n + 8 : n < 2724 ? 1536 + (n - 2720) : n < 2728 ? 2308 + (n - 2724) : -1; }

__device__ __forceinline__ void transpose_item(const float* W, int ldw, int scol, int k0, const float* gk, bf16_t* dst, int K, LAS float* scr, int lane) {
#pragma unroll 8
    for (int i = 0; i < 32; ++i) { const int kk = 2 * i + (lane >> 5); float v = 0.f;
        if (scol >= 0) { v = W[(size_t)(k0 + kk) * ldw + scol]; if (gk) v *= gk[k0 + kk]; }
        scr[kk * 33 + (lane & 31)] = v; }
    LDS_WAIT(); asm volatile("" ::: "memory");
    const int c = lane & 7;
#pragma unroll
    for (int j = 0; j < 4; ++j) { const int n = (lane >> 3) + 8 * j; const LAS float* s = scr + (8 * c) * 33 + n;
        u32x4 o; o.x = pk2(s[0 * 33], s[1 * 33]); o.y = pk2(s[2 * 33], s[3 * 33]); o.z = pk2(s[4 * 33], s[5 * 33]); o.w = pk2(s[6 * 33], s[7 * 33]);
        *(u32x4*)(dst + (size_t)n * K + 8 * c) = o; }
    LDS_WAIT(); asm volatile("" ::: "memory");
}

__device__ __forceinline__ void row_to_bf16(const float* xrow, bf16_t* orow, float* rstd_out, int lane) {
    const f32x4* xr = (const f32x4*)xrow + lane; f32x4 v[4]; float s = 0.f;
#pragma unroll
    for (int j = 0; j < 4; ++j) { v[j] = xr[64 * j]; s += (v[j].x * v[j].x + v[j].y * v[j].y) + (v[j].z * v[j].z + v[j].w * v[j].w); }
    s = wave_sum(s);
    if (lane == 0) *rstd_out = 1.0f / sqrtf(s * (1.0f / DM) + RMS_EPS);
    u32x2* o8 = (u32x2*)orow + lane;
#pragma unroll
    for (int j = 0; j < 4; ++j) { u32x2 w; w.x = pk2(v[j].x, v[j].y); w.y = pk2(v[j].z, v[j].w); o8[64 * j] = w; }
}

__device__ __forceinline__ void p0_prologue(Ctx& C) {
    LAS float* scr = (LAS float*)(C.lds + C.wave * 8704);
    const int gw = C.bx * NWAVES + C.wave, NGW = C.G * NWAVES;
    constexpr int I_IN = 16 * 88, I_OUT = 16 * 32, I_UQ = 4 * 12, I_UKV = 2 * 16, I_L = I_IN + I_OUT + I_UQ + I_UKV;
    for (int it = gw; it < 2 * I_L; it += NGW) {
        const int l = it / I_L; int r = it % I_L; const int ln = C.lane & 31;
        if (r < I_IN) { const int kb = r / 88, nb = r % 88;
            transpose_item(C.a->in[3] + (size_t)l * 1024 * 2728, 2728, refcol(32 * nb + ln), 64 * kb, C.a->in[2] + l * 1024, WSP(bf16_t, WS_WIN) + (size_t)l * NPROJ * 1024 + (size_t)(32 * nb) * 1024 + 64 * kb, 1024, scr, C.lane); continue; }
        r -= I_IN;
        if (r < I_OUT) { const int kb = r / 32, nb = r % 32;
            transpose_item(C.a->in[16] + (size_t)l * 1024 * 1024, 1024, 32 * nb + ln, 64 * kb, nullptr, WSP(bf16_t, WS_WOUT) + (size_t)l * 1024 * 1024 + (size_t)(32 * nb) * 1024 + 64 * kb, 1024, scr, C.lane); continue; }
        r -= I_OUT;
        if (r < I_UQ) { const int kb = r / 12, nb = r % 12;
            transpose_item(C.a->in[14] + (size_t)l * 256 * 384, 384, 32 * nb + ln, 64 * kb, C.a->in[12] + l * 256, WSP(bf16_t, WS_WUQ) + (size_t)l * 384 * 256 + (size_t)(32 * nb) * 256 + 64 * kb, 256, scr, C.lane); continue; }
        r -= I_UQ;
        { const int kb = r / 16, nb = r % 16;
            transpose_item(C.a->in[15] + (size_t)l * 128 * 512, 512, 32 * nb + ln, 64 * kb, C.a->in[13] + l * 128, WSP(bf16_t, WS_WUKV) + (size_t)l * 512 * 128 + (size_t)(32 * nb) * 128 + 64 * kb, 128, scr, C.lane); }
    }
    { const int* pos = (const int*)C.a->in[1]; float* cs = WSP(float, WS_COS); float* sn = WSP(float, WS_SIN);
      for (int e = C.bx * NTHR + C.tid; e < T * 16; e += C.G * NTHR) { const int t = e >> 4, i = e & 15;
          const float inv = powf(10000.0f, -(float)(2 * i) / 32.0f); const float ang = (float)pos[t] * inv;
          const double rev = (double)ang * 0.15915494309189535; const double fr = rev - floor(rev); const float a = (float)(fr * 6.283185307179586);
          cs[e] = cosf(a); sn[e] = sinf(a); } }
    for (int m = gw; m < T; m += NGW) row_to_bf16(C.a->in[0] + (size_t)m * DM, WSP(bf16_t, WS_S1) + (size_t)m * DM, WSP(float, WS_RSTD) + m, C.lane);
}

constexpr int XS_LD = 264, BC_LD = 136, ML_LD = 72;
constexpr int XS_OFF = 0, BL_OFF = 33792, CL_OFF = 51200, ACUM_OFF = 68608, DT_OFF = 69632, SSQ_OFF = 70656, ML_OFF = 71680, PV_OFF = 108544;
static_assert(PV_OFF + 36864 <= LDS_SCR, "ssd lds");
__device__ __forceinline__ float log_sigmoid_f(float x) { return -(fmaxf(-x, 0.f) + log1pf(__expf(-fabsf(x)))); }

__device__ __forceinline__ void ssd_fill(Ctx& C, int l, int cu) {
    const int c = cu & 31, t0 = cu * 64; const bf16_t* PM = WSP(bf16_t, WS_PM);
    const float* cw = C.a->in[6] + l * 4 * 512; const float* cb = C.a->in[7] + l * 512;
#pragma unroll 1
    for (int it = 0; it < 8; ++it) { const int item = C.tid + NTHR * it, lt = item >> 6, ch = (item & 63) * 8;
        float acc[8];
#pragma unroll
        for (int j = 0; j < 8; ++j) acc[j] = cb[ch + j];
#pragma unroll
        for (int d = 0; d < 4; ++d) { const int sp = 64 * c + lt - 3 + d;
            if (sp >= 0) { const u32x4 raw = *(const u32x4*)(PM + (size_t)(t0 + lt - 3 + d) * NPROJ + C_XBC + ch); const float* w = cw + d * 512 + ch;
                acc[0] += w[0] * bflo(raw.x); acc[1] += w[1] * bfhi(raw.x); acc[2] += w[2] * bflo(raw.y); acc[3] += w[3] * bfhi(raw.y);
                acc[4] += w[4] * bflo(raw.z); acc[5] += w[5] * bfhi(raw.z); acc[6] += w[6] * bflo(raw.w); acc[7] += w[7] * bfhi(raw.w); } }
        u32x4 o; o.x = pk2(silu_f(acc[0]), silu_f(acc[1])); o.y = pk2(silu_f(acc[2]), silu_f(acc[3])); o.z = pk2(silu_f(acc[4]), silu_f(acc[5])); o.w = pk2(silu_f(acc[6]), silu_f(acc[7]));
        lptr dst = ch < 256 ? C.lds + XS_OFF + (lt * XS_LD + ch) * 2 : ch < 384 ? C.lds + BL_OFF + (lt * BC_LD + (ch - 256)) * 2 : C.lds + CL_OFF + (lt * BC_LD + (ch - 384)) * 2;
        *(LAS u32x4*)dst = o; }
    if (C.tid < 256) { const int lt = C.tid >> 2, h = C.tid & 3;
        const float dt = softplus_f(WSP(float, WS_FD)[(size_t)(t0 + lt) * 8 + 4 + h] + C.a->in[8][l * 4 + h]);
        ((LAS float*)(C.lds + DT_OFF))[lt * 4 + h] = dt; ((LAS float*)(C.lds + ACUM_OFF))[lt * 4 + h] = -__expf(C.a->in[9][l * 4 + h]) * dt; }
    __syncthreads();
    if (C.wave < 4) { LAS float* ac = (LAS float*)(C.lds + ACUM_OFF) + C.lane * 4 + C.wave; float v = *ac;
#pragma unroll
        for (int o = 1; o < 64; o <<= 1) { const float y = __shfl_up(v, o); if (C.lane >= o) v += y; }
        *ac = v; }
    __syncthreads();
}

__device__ __forceinline__ void p2_unit(Ctx& C, int l, int cu, int en) {
    const int b = cu >> 5, c = cu & 31, t0 = cu * 64; const int tid = C.tid, lane = C.lane, w = C.wave, g = lane >> 4, i = lane & 15;
    const bf16_t* PM = WSP(bf16_t, WS_PM); bf16_t* Y = WSP(bf16_t, WS_S1);
    { const float* cw = C.a->in[4] + l * 3 * 256;
#pragma unroll 1
      for (int it = 0; it < 4; ++it) { const int item = tid + NTHR * it, lt = item >> 5, ch = (item & 31) * 8; const size_t r = (size_t)(t0 + lt) * NPROJ;
          float acc[8] = {0.f, 0.f, 0.f, 0.f, 0.f, 0.f, 0.f, 0.f};
          if (en & 1) {
#pragma unroll
          for (int d = 0; d < 3; ++d) { const int sp = 64 * c + lt - 2 + d;
              if (sp >= 0) { const size_t rr = (size_t)(t0 + lt - 2 + d) * NPROJ; const u32x4 cg = *(const u32x4*)(PM + rr + C_AC + ch), vl = *(const u32x4*)(PM + rr + C_AV + ch); const float* wv = cw + d * 256 + ch;
                  acc[0] += wv[0] * bflo(cg.x) * bflo(vl.x); acc[1] += wv[1] * bfhi(cg.x) * bfhi(vl.x); acc[2] += wv[2] * bflo(cg.y) * bflo(vl.y); acc[3] += wv[3] * bfhi(cg.y) * bfhi(vl.y);
                  acc[4] += wv[4] * bflo(cg.z) * bflo(vl.z); acc[5] += wv[5] * bfhi(cg.z) * bfhi(vl.z); acc[6] += wv[6] * bflo(cg.w) * bflo(vl.w); acc[7] += wv[7] * bfhi(cg.w) * bfhi(vl.w); } }
          const u32x4 bg = *(const u32x4*)(PM + r + C_AB + ch);
          acc[0] *= bflo(bg.x); acc[1] *= bfhi(bg.x); acc[2] *= bflo(bg.y); acc[3] *= bfhi(bg.y); acc[4] *= bflo(bg.z); acc[5] *= bfhi(bg.z); acc[6] *= bflo(bg.w); acc[7] *= bfhi(bg.w); }
          u32x4 o; o.x = pk2(acc[0], acc[1]); o.y = pk2(acc[2], acc[3]); o.z = pk2(acc[4], acc[5]); o.w = pk2(acc[6], acc[7]);
          *(u32x4*)(Y + (size_t)(t0 + lt) * DM + ch) = o; } }
    for (int mx = 1; mx < 4; ++mx) if (!((en >> mx) & 1)) {
        for (int it = 0; it < 4; ++it) { const int item = tid + NTHR * it, lt = item >> 5, ch = (item & 31) * 8; *(u32x4*)(Y + (size_t)(t0 + lt) * DM + 256 * mx + ch) = (u32x4){0u, 0u, 0u, 0u}; } }
    LAUNDER();
    if (en & 2) {
        const float* FD = WSP(float, WS_FD); const float* fb = C.a->in[5] + l * 4; LAS float* red = (LAS float*)(C.lds + LDS_SCR + SCR_RED);
        float ps[4] = {0.f, 0.f, 0.f, 0.f};
        for (int tk = tid; tk < 64 * c; tk += NTHR) { const f32x4 f = *(const f32x4*)(FD + (size_t)(b * SEQ + tk) * 8);
            ps[0] += log_sigmoid_f(f.x + fb[0]); ps[1] += log_sigmoid_f(f.y + fb[1]); ps[2] += log_sigmoid_f(f.z + fb[2]); ps[3] += log_sigmoid_f(f.w + fb[3]); }
#pragma unroll
        for (int h = 0; h < 4; ++h) ps[h] = wave_sum(ps[h]);
        if (lane == 0) { red[w * 4 + 0] = ps[0]; red[w * 4 + 1] = ps[1]; red[w * 4 + 2] = ps[2]; red[w * 4 + 3] = ps[3]; }
        __syncthreads();
        if (w < 4) { float pre = 0.f;
#pragma unroll
            for (int k = 0; k < 8; ++k) pre += red[k * 4 + w];
            float v = log_sigmoid_f(FD[(size_t)(t0 + lane) * 8 + w] + fb[w]);
#pragma unroll
            for (int o = 1; o < 64; o <<= 1) { const float y = __shfl_up(v, o); if (lane >= o) v += y; }
            WSP(float, WS_CUM)[(size_t)(t0 + lane) * 4 + w] = (pre + v) * LOG2E; }
        __syncthreads();
    }
    LAUNDER();
    if (en & 4) {
        ssd_fill(C, l, cu);
        const LAS float* AC = (const LAS float*)(C.lds + ACUM_OFF); const LAS float* DT = (const LAS float*)(C.lds + DT_OFF);
#pragma unroll 1
        for (int it = 0; it < 4; ++it) { const int item = tid + NTHR * it, lt = item >> 5, col = (item & 31) * 8, h = col >> 6, n = col & 63;
            const u32x4 s = *(const LAS u32x4*)(C.lds + BL_OFF + (lt * BC_LD + 64 * (h >> 1) + n) * 2);
            const float sc = DT[lt * 4 + h] * __expf(AC[63 * 4 + h] - AC[lt * 4 + h]);
            u32x4 o; o.x = pk2(bflo(s.x) * sc, bfhi(s.x) * sc); o.y = pk2(bflo(s.y) * sc, bfhi(s.y) * sc); o.z = pk2(bflo(s.z) * sc, bfhi(s.z) * sc); o.w = pk2(bflo(s.w) * sc, bfhi(s.w) * sc);
            *(LAS u32x4*)(C.lds + PV_OFF + (lt * XS_LD + col) * 2) = o; }
        __syncthreads();
        { const int h = w >> 1, rh = w & 1; float* ST = WSP(float, WS_ST) + (size_t)(cu * 4 + h) * 4096;
#pragma unroll
          for (int mbl = 0; mbl < 2; ++mbl) { const int mb = 2 * rh + mbl;
#pragma unroll
              for (int nb = 0; nb < 4; ++nb) { f32x4 acc = {0.f, 0.f, 0.f, 0.f};
#pragma unroll
                  for (int kk = 0; kk < 2; ++kk) { const int rb = 32 * kk + 8 * g;
                      const bf16x8 a = tr_frag(C.lds + XS_OFF, XS_LD, rb, rb + 4, 64 * h + 16 * mb, lane);
                      const bf16x8 bq = tr_frag(C.lds + PV_OFF, XS_LD, rb, rb + 4, 64 * h + 16 * nb, lane);
                      acc = mfma16(a, bq, acc); }
#pragma unroll
                  for (int r = 0; r < 4; ++r) ST[(16 * mb + 4 * g + r) * 64 + 16 * nb + i] = acc[r]; } }
          if (tid < 4) WSP(float, WS_CDEC)[cu * 4 + tid] = __expf(AC[63 * 4 + tid]); }
        __syncthreads();
    }
    LAUNDER();
    if (en & 8) {
        LAS float* RQ = (LAS float*)(C.lds + LDS_SCR + SCR_RQ); LAS float* RKV = (LAS float*)(C.lds + LDS_SCR + SCR_RKV);
        { const int lt = tid >> 3, sub = tid & 7; const bf16_t* pr = PM + (size_t)(t0 + lt) * NPROJ; float s1 = 0.f, s2 = 0.f;
#pragma unroll
          for (int k = 0; k < 4; ++k) { const u32x4 v = *(const u32x4*)(pr + C_CQ + sub * 32 + 8 * k);
              s1 += bflo(v.x) * bflo(v.x) + bfhi(v.x) * bfhi(v.x) + bflo(v.y) * bflo(v.y) + bfhi(v.y) * bfhi(v.y) + bflo(v.z) * bflo(v.z) + bfhi(v.z) * bfhi(v.z) + bflo(v.w) * bflo(v.w) + bfhi(v.w) * bfhi(v.w); }
#pragma unroll
          for (int k = 0; k < 2; ++k) { const u32x4 v = *(const u32x4*)(pr + C_CKV + sub * 16 + 8 * k);
              s2 += bflo(v.x) * bflo(v.x) + bfhi(v.x) * bfhi(v.x) + bflo(v.y) * bflo(v.y) + bfhi(v.y) * bfhi(v.y) + bflo(v.z) * bflo(v.z) + bfhi(v.z) * bfhi(v.z) + bflo(v.w) * bflo(v.w) + bfhi(v.w) * bfhi(v.w); }
          s1 += __shfl_xor(s1, 1); s1 += __shfl_xor(s1, 2); s1 += __shfl_xor(s1, 4); s2 += __shfl_xor(s2, 1); s2 += __shfl_xor(s2, 2); s2 += __shfl_xor(s2, 4);
          if (sub == 0) { RQ[lt] = 1.0f / sqrtf(s1 * (1.0f / 256.0f) + RMS_EPS); RKV[lt] = 1.0f / sqrtf(s2 * (1.0f / 128.0f) + RMS_EPS); } }
        __syncthreads();
        const float* COS = WSP(float, WS_COS); const float* SIN = WSP(float, WS_SIN);
        bf16_t* QM = WSP(bf16_t, WS_QM); bf16_t* KM = WSP(bf16_t, WS_KM); bf16_t* VM = WSP(bf16_t, WS_VM);
        {
          const bf16_t* WU = WSP(bf16_t, WS_WUQ) + (size_t)l * 384 * 256; f32x4 acc[3][4];
#pragma unroll
          for (int a = 0; a < 3; ++a)
#pragma unroll
              for (int m = 0; m < 4; ++m) acc[a][m] = (f32x4){0.f, 0.f, 0.f, 0.f};
#pragma unroll 1
          for (int kk = 0; kk < 8; ++kk) { bf16x8 bq[4];
#pragma unroll
              for (int m = 0; m < 4; ++m) bq[m] = *(const bf16x8*)(PM + (size_t)(t0 + 16 * m + i) * NPROJ + C_CQ + 32 * kk + 8 * g);
#pragma unroll
              for (int a = 0; a < 3; ++a) { const bf16x8 af = *(const bf16x8*)(WU + (size_t)(16 * (3 * w + a) + i) * 256 + 32 * kk + 8 * g);
#pragma unroll
                  for (int m = 0; m < 4; ++m) acc[a][m] = mfma16(af, bq[m], acc[a][m]); } }
#pragma unroll
          for (int m = 0; m < 4; ++m) { const int tk = 16 * m + i; const float rq = RQ[tk];
#pragma unroll
              for (int a = 0; a < 3; ++a) acc[a][m] = acc[a][m] * rq;
              if (w & 1) { const f32x4 cs = *(const f32x4*)(COS + (size_t)(t0 + tk) * 16 + 4 * g), sn = *(const f32x4*)(SIN + (size_t)(t0 + tk) * 16 + 4 * g);
                  const f32x4 x1 = acc[1][m], x2 = acc[2][m]; acc[1][m] = x1 * cs - x2 * sn; acc[2][m] = x2 * cs + x1 * sn; }
#pragma unroll
              for (int a = 0; a < 3; ++a) { u32x2 o; o.x = pk2(acc[a][m][0], acc[a][m][1]); o.y = pk2(acc[a][m][2], acc[a][m][3]);
                  *(u32x2*)(QM + (size_t)(t0 + tk) * 384 + 16 * (3 * w + a) + 4 * g) = o; } } }
        LAUNDER();
        {
          const bf16_t* WU = WSP(bf16_t, WS_WUKV) + (size_t)l * 512 * 128; f32x4 acc[4][4];
#pragma unroll
          for (int a = 0; a < 4; ++a)
#pragma unroll
              for (int m = 0; m < 4; ++m) acc[a][m] = (f32x4){0.f, 0.f, 0.f, 0.f};
#pragma unroll 1
          for (int kk = 0; kk < 4; ++kk) { bf16x8 bq[4];
#pragma unroll
              for (int m = 0; m < 4; ++m) bq[m] = *(const bf16x8*)(PM + (size_t)(t0 + 16 * m + i) * NPROJ + C_CKV + 32 * kk + 8 * g);
#pragma unroll
              for (int a = 0; a < 4; ++a) { const bf16x8 af = *(const bf16x8*)(WU + (size_t)(16 * (4 * w + a) + i) * 128 + 32 * kk + 8 * g);
#pragma unroll
                  for (int m = 0; m < 4; ++m) acc[a][m] = mfma16(af, bq[m], acc[a][m]); } }
          const int hd = w >> 1;
#pragma unroll
          for (int m = 0; m < 4; ++m) { const int tk = 16 * m + i; const float rk = RKV[tk];
#pragma unroll
              for (int a = 0; a < 4; ++a) { const f32x4 v = acc[a][m] * rk; u32x2 o; o.x = pk2(v[0], v[1]); o.y = pk2(v[2], v[3]);
                  if (w & 1) *(u32x2*)(VM + (size_t)(t0 + tk) * 256 + 64 * hd + 16 * a + 4 * g) = o;
                  else       *(u32x2*)(KM + (size_t)(t0 + tk) * 384 + 96 * hd + 16 * a + 4 * g) = o; } } }
        {
          const int lt = tid >> 3, i0 = (tid & 7) * 2; const bf16_t* pr = PM + (size_t)(t0 + lt) * NPROJ + C_KR;
          const unsigned a = *(const unsigned*)(pr + i0), bb = *(const unsigned*)(pr + 16 + i0);
          const float c0 = COS[(size_t)(t0 + lt) * 16 + i0], c1 = COS[(size_t)(t0 + lt) * 16 + i0 + 1], s0 = SIN[(size_t)(t0 + lt) * 16 + i0], s1 = SIN[(size_t)(t0 + lt) * 16 + i0 + 1];
          const float x10 = bflo(a), x11 = bfhi(a), x20 = bflo(bb), x21 = bfhi(bb);
          const unsigned o1 = pk2(x10 * c0 - x20 * s0, x11 * c1 - x21 * s1), o2 = pk2(x20 * c0 + x10 * s0, x21 * c1 + x11 * s1);
#pragma unroll
          for (int hd = 0; hd < 4; ++hd) { *(unsigned*)(KM + (size_t)(t0 + lt) * 384 + 96 * hd + 64 + i0) = o1; *(unsigned*)(KM + (size_t)(t0 + lt) * 384 + 96 * hd + 80 + i0) = o2; } }
        __syncthreads();
    }
}

template <int DK, bool FOX>
__device__ __forceinline__ void attn_unit(Ctx& C, const bf16_t* Qg, int qp, const bf16_t* Kg, int kp, const bf16_t* Vg, int vp, bf16_t* Og, const float* cumg, int row0, int qb, float qscale) {
    constexpr int KLD = DK + 8, VLD = 72, KBUF = 64 * KLD * 2, VBUF = 64 * VLD * 2, BUFB = KBUF + VBUF + 256, NKK = DK / 32, CPR = DK / 8;
    const int tid = C.tid, lane = C.lane, w = C.wave, g = lane >> 4, i = lane & 15;
    const int q0w = qb * 128 + 16 * w, nt = 2 * (qb + 1);
    bf16x8 qf[NKK];
    { const bf16_t* qrow = Qg + (size_t)(row0 + q0w + i) * qp;
#pragma unroll
      for (int kk = 0; kk < NKK; ++kk) qf[kk] = *(const bf16x8*)(qrow + 32 * kk + 8 * g); }
    const float cq = FOX ? cumg[(size_t)(row0 + q0w + i) * 4] : 0.f;
    f32x4 o[4];
#pragma unroll
    for (int m = 0; m < 4; ++m) o[m] = (f32x4){0.f, 0.f, 0.f, 0.f};
    float mrun = -INFINITY, lsum = 0.f;
    const int kr0 = tid / CPR, kc0 = tid % CPR, kr1 = (tid + NTHR) / CPR, kc1 = (tid + NTHR) % CPR, vr = tid >> 3, vc = tid & 7;
    const bool k1 = (DK == 96) && (tid < 256);
    u32x4 kreg0, kreg1 = {0u, 0u, 0u, 0u}, vreg; float ckreg = 0.f;
#define AT_LOAD(kt) do { const size_t rb_ = (size_t)row0 + 64 * (kt); \
        kreg0 = *(const u32x4*)(Kg + (rb_ + kr0) * kp + 8 * kc0); if (k1) kreg1 = *(const u32x4*)(Kg + (rb_ + kr1) * kp + 8 * kc1); \
        vreg = *(const u32x4*)(Vg + (rb_ + vr) * vp + 8 * vc); if (FOX && tid < 64) ckreg = cumg[(rb_ + tid) * 4]; } while (0)
#define AT_STORE(buf) do { lptr b_ = C.lds + (buf) * BUFB; \
        *(LAS u32x4*)(b_ + (kr0 * KLD + 8 * kc0) * 2) = kreg0; if (k1) *(LAS u32x4*)(b_ + (kr1 * KLD + 8 * kc1) * 2) = kreg1; \
        *(LAS u32x4*)(b_ + KBUF + (vr * VLD + 8 * vc) * 2) = vreg; if (FOX && tid < 64) *(LAS float*)(b_ + KBUF + VBUF + tid * 4) = ckreg; } while (0)
    AT_LOAD(0); AT_STORE(0); __syncthreads();
#pragma unroll 1
    for (int kt = 0; kt < nt; ++kt) {
        const int cur = kt & 1;
        if (kt + 1 < nt) AT_LOAD(kt + 1);
        const bool active = FOX ? (64 * kt <= q0w + 15) : (kt <= (q0w >> 6));
        if (active) {
            lptr kb = C.lds + cur * BUFB; lptr vb = kb + KBUF; lptr ckb = vb + VBUF;
            f32x4 s[4];
#pragma unroll
            for (int n = 0; n < 4; ++n) { s[n] = (f32x4){0.f, 0.f, 0.f, 0.f};
#pragma unroll
                for (int kk = 0; kk < NKK; ++kk) { const bf16x8 a = *(const LAS bf16x8*)(kb + ((16 * n + i) * KLD + 32 * kk + 8 * g) * 2); s[n] = mfma16(a, qf[kk], s[n]); } }
            const bool needmask = FOX && (64 * kt + 63 > q0w);
            float mx = -INFINITY;
#pragma unroll
            for (int n = 0; n < 4; ++n) { f32x4 ck4 = {0.f, 0.f, 0.f, 0.f}; if (FOX) ck4 = *(const LAS f32x4*)(ckb + (16 * n + 4 * g) * 4);
#pragma unroll
                for (int r = 0; r < 4; ++r) { float v = s[n][r] * qscale; if (FOX) v += cq - ck4[r];
                    if (needmask && (64 * kt + 16 * n + 4 * g + r > q0w + i)) v = -INFINITY;
                    s[n][r] = v; mx = fmaxf(mx, v); } }
            mx = fmaxf(mx, __shfl_xor(mx, 16)); mx = fmaxf(mx, __shfl_xor(mx, 32));
            const float mnew = fmaxf(mrun, mx), alpha = __builtin_amdgcn_exp2f(mrun - mnew); mrun = mnew;
            float psum = 0.f;
#pragma unroll
            for (int n = 0; n < 4; ++n)
#pragma unroll
                for (int r = 0; r < 4; ++r) { const float p = __builtin_amdgcn_exp2f(s[n][r] - mnew); s[n][r] = p; psum += p; }
            lsum = lsum * alpha + psum;
#pragma unroll
            for (int m = 0; m < 4; ++m) o[m] = o[m] * alpha;
            bf16x8 pf[2];
#pragma unroll
            for (int kk = 0; kk < 2; ++kk) { const unsigned a0 = pk2(s[2 * kk][0], s[2 * kk][1]), a1 = pk2(s[2 * kk][2], s[2 * kk][3]), a2 = pk2(s[2 * kk + 1][0], s[2 * kk + 1][1]), a3 = pk2(s[2 * kk + 1][2], s[2 * kk + 1][3]);
                pf[kk] = __builtin_bit_cast(bf16x8, (u32x4){a0, a1, a2, a3}); }
#pragma unroll
            for (int m = 0; m < 4; ++m)
#pragma unroll
                for (int kk = 0; kk < 2; ++kk) { const bf16x8 a = tr_frag(vb, VLD, 32 * kk + 4 * g, 32 * kk + 16 + 4 * g, 16 * m, lane); o[m] = mfma16(a, pf[kk], o[m]); }
        }
        if (kt + 1 < nt) AT_STORE(cur ^ 1);
        __syncthreads();
    }
#undef AT_LOAD
#undef AT_STORE
    lsum += __shfl_xor(lsum, 16); lsum += __shfl_xor(lsum, 32);
    const float inv = 1.0f / lsum; bf16_t* orow = Og + (size_t)(row0 + q0w + i) * DM;
#pragma unroll
    for (int m = 0; m < 4; ++m) { u32x2 ov; ov.x = pk2(o[m][0] * inv, o[m][1] * inv); ov.y = pk2(o[m][2] * inv, o[m][3] * inv); *(u32x2*)(orow + 16 * m + 4 * g) = ov; }
}

__device__ __forceinline__ void p3_ssd_unit(Ctx& C, int l, int cu) {
    const int b = cu >> 5, c = cu & 31, t0 = cu * 64; const int tid = C.tid, lane = C.lane, w = C.wave, g = lane >> 4, i = lane & 15;
    const bf16_t* PM = WSP(bf16_t, WS_PM); bf16_t* Y = WSP(bf16_t, WS_S1);
    ssd_fill(C, l, cu);
    const LAS float* AC = (const LAS float*)(C.lds + ACUM_OFF); const LAS float* DT = (const LAS float*)(C.lds + DT_OFF);
    { f32x4 st[8];
#pragma unroll
      for (int k = 0; k < 8; ++k) st[k] = (f32x4){0.f, 0.f, 0.f, 0.f};
      const float* STG = WSP(float, WS_ST); const float* CD = WSP(float, WS_CDEC);
#pragma unroll 1
      for (int cp = 0; cp < c; ++cp) { const int cuu = b * 32 + cp; const f32x4 dec4 = *(const f32x4*)(CD + cuu * 4);
#pragma unroll
          for (int k = 0; k < 8; ++k) { const int f = tid + NTHR * k; const f32x4 v = *(const f32x4*)(STG + (size_t)cuu * 16384 + (size_t)f * 4); const float dec = dec4[k >> 1]; st[k] = st[k] * dec + v; } }
#pragma unroll
      for (int k = 0; k < 8; ++k) { const int f = tid + NTHR * k, h = f >> 10, rem = f & 1023, p = rem >> 4, n = (rem & 15) * 4;
          u32x2 o; o.x = pk2(st[k][0], st[k][1]); o.y = pk2(st[k][2], st[k][3]); *(LAS u32x2*)(C.lds + PV_OFF + ((h * 64 + p) * ML_LD + n) * 2) = o; } }
    __syncthreads();
    const int h = w >> 1, rh = w & 1, grp = h >> 1; lptr MLw = C.lds + ML_OFF + w * (32 * ML_LD * 2);
    const float Dh = C.a->in[10][l * 4 + h];
#pragma unroll 1
    for (int mbl = 0; mbl < 2; ++mbl) { const int mb = 2 * rh + mbl;
#pragma unroll
        for (int nb = 0; nb < 4; ++nb) { f32x4 acc = {0.f, 0.f, 0.f, 0.f};
#pragma unroll
            for (int kk = 0; kk < 2; ++kk) { const bf16x8 a = *(const LAS bf16x8*)(C.lds + CL_OFF + ((16 * mb + i) * BC_LD + 64 * grp + 32 * kk + 8 * g) * 2);
                const bf16x8 bq = *(const LAS bf16x8*)(C.lds + BL_OFF + ((16 * nb + i) * BC_LD + 64 * grp + 32 * kk + 8 * g) * 2); acc = mfma16(a, bq, acc); }
            const int s = 16 * nb + i; const float as = AC[s * 4 + h], ds = DT[s * 4 + h];
#pragma unroll
            for (int r = 0; r < 4; ++r) { const int lr = 16 * mb + 4 * g + r; const float v = (s <= lr) ? acc[r] * __expf(AC[lr * 4 + h] - as) * ds : 0.f;
                *(LAS unsigned short*)(MLw + ((16 * mbl + 4 * g + r) * ML_LD + s) * 2) = (unsigned short)f2bf(v); } }
        LDS_WAIT(); asm volatile("" ::: "memory");
        f32x4 ad[4], ao[4];
#pragma unroll
        for (int nb = 0; nb < 4; ++nb) { ad[nb] = (f32x4){0.f, 0.f, 0.f, 0.f}; ao[nb] = (f32x4){0.f, 0.f, 0.f, 0.f};
#pragma unroll
            for (int kk = 0; kk < 2; ++kk) {
                const bf16x8 a = *(const LAS bf16x8*)(MLw + ((16 * mbl + i) * ML_LD + 32 * kk + 8 * g) * 2);
                const bf16x8 bx = tr_frag(C.lds + XS_OFF, XS_LD, 32 * kk + 8 * g, 32 * kk + 8 * g + 4, 64 * h + 16 * nb, lane);
                ad[nb] = mfma16(a, bx, ad[nb]);
                const bf16x8 a2 = *(const LAS bf16x8*)(C.lds + CL_OFF + ((16 * mb + i) * BC_LD + 64 * grp + 32 * kk + 8 * g) * 2);
                const bf16x8 b2 = *(const LAS bf16x8*)(C.lds + PV_OFF + ((h * 64 + 16 * nb + i) * ML_LD + 32 * kk + 8 * g) * 2);
                ao[nb] = mfma16(a2, b2, ao[nb]); } }
        LDS_WAIT(); asm volatile("" ::: "memory");
        float ssq[4] = {0.f, 0.f, 0.f, 0.f};
#pragma unroll
        for (int nb = 0; nb < 4; ++nb)
#pragma unroll
            for (int r = 0; r < 4; ++r) { const int lr = 16 * mb + 4 * g + r; const int ch = 64 * h + 16 * nb + i;
                const float xs = bf2f(*(const LAS unsigned short*)(C.lds + XS_OFF + (lr * XS_LD + ch) * 2));
                float y = ad[nb][r] + __expf(AC[lr * 4 + h]) * ao[nb][r] + Dh * xs;
                const float z = bf2f(PM[(size_t)(t0 + lr) * NPROJ + C_Z + ch]); y *= silu_f(z);
                ssq[r] += y * y;
                *(LAS unsigned short*)(MLw + ((16 * mbl + 4 * g + r) * ML_LD + 16 * nb + i) * 2) = (unsigned short)f2bf(y); }
#pragma unroll
        for (int r = 0; r < 4; ++r) { float q = ssq[r]; q += __shfl_xor(q, 1); q += __shfl_xor(q, 2); q += __shfl_xor(q, 4); q += __shfl_xor(q, 8);
            if (i == 0) ((LAS float*)(C.lds + SSQ_OFF))[(16 * mb + 4 * g + r) * 4 + h] = q; } }
    __syncthreads();
    { const float* gn = C.a->in[11] + l * 256;
      const int lr_l = lane >> 1, hf = lane & 1, lr = 32 * rh + lr_l; const f32x4 q4 = *(const LAS f32x4*)(C.lds + SSQ_OFF + lr * 16);
      const float rs = 1.0f / sqrtf(((q4.x + q4.y) + (q4.z + q4.w)) * (1.0f / 256.0f) + RMS_EPS);
#pragma unroll
      for (int k = 0; k < 4; ++k) { const int ch = 64 * h + 32 * hf + 8 * k; const u32x4 yv = *(const LAS u32x4*)(MLw + (lr_l * ML_LD + 32 * hf + 8 * k) * 2);
          u32x4 o; o.x = pk2(bflo(yv.x) * rs * gn[ch + 0], bfhi(yv.x) * rs * gn[ch + 1]); o.y = pk2(bflo(yv.y) * rs * gn[ch + 2], bfhi(yv.y) * rs * gn[ch + 3]);
          o.z = pk2(bflo(yv.z) * rs * gn[ch + 4], bfhi(yv.z) * rs * gn[ch + 5]); o.w = pk2(bflo(yv.w) * rs * gn[ch + 6], bfhi(yv.w) * rs * gn[ch + 7]);
          *(u32x4*)(Y + (size_t)(t0 + lr) * DM + 512 + ch) = o; } }
    __syncthreads();
}

__device__ __forceinline__ void moe_tables(Ctx& C, int l) {
    LAS int* cnt = (LAS int*)(C.lds + LDS_SCR + SCR_CNT); LAS int* tb = (LAS int*)(C.lds + LDS_SCR + SCR_TBASE); LAS int* te = (LAS int*)(C.lds + LDS_SCR + SCR_TILEE); LAS int* ntp = (LAS int*)(C.lds + LDS_SCR + SCR_NT);
    if (C.tid < 32) cnt[C.tid] = (int)__hip_atomic_load(WSP(unsigned, WS_CTL) + CW_CNT + l * 32 + C.tid, __ATOMIC_RELAXED, __HIP_MEMORY_SCOPE_AGENT);
    __syncthreads();
    if (C.tid == 0) { int a = 0; for (int e = 0; e < 32; ++e) { tb[e] = a; a += (cnt[e] + 255) >> 8; } tb[32] = a; *ntp = a; }
    __syncthreads();
    if (C.tid < 160) { int e = 0; for (int k = 1; k < 32; ++k) if (tb[k] <= C.tid) e = k; te[C.tid] = e; }
    __syncthreads();
}
template <int NPN> struct MoeOrder {
    static constexpr int npn = NPN; int G, c; const LAS int* cnt; const LAS int* tb; const LAS int* te; int ntile; const int* rowl;
    __device__ __forceinline__ bool next(int i, pg8::Unit& u) const {
        const int L = i * G + c; if (L >= ntile * npn) return false;
        const int ti = L / npn, pnl = L % npn; const int e = __builtin_amdgcn_readfirstlane(te[ti]);
        u.pm = ti; u.pn = e * npn + pnl; u.e = e; u.r0 = (ti - __builtin_amdgcn_readfirstlane(tb[e])) * 256; u.ne = __builtin_amdgcn_readfirstlane(cnt[e]); return true;
    }
    __device__ __forceinline__ int arow(const pg8::Unit& u, int r) const { const int rr = u.r0 + r; return rr < u.ne ? rowl[(size_t)u.e * T + rr] : 0; }
    __device__ __forceinline__ void a_ready(const pg8::Unit&) const {}
    __device__ __forceinline__ void done(const pg8::Unit&) const {}
};

__device__ __forceinline__ void p5_router(Ctx& C, int l, int en) {
    const int gw = C.bx * NWAVES + C.wave, NGW = C.G * NWAVES, lane = C.lane;
    if (en & 16) {
        LAS float* scr = (LAS float*)(C.lds + C.wave * 8704);
        for (int it = gw; it < 32 * 384; it += NGW) { const int e = it / 384, r = it % 384, ln = lane & 31;
            if (r < 256) { const int kb = r >> 4, nb = r & 15, n = 32 * nb + ln, pn = n >> 8, bj = (n >> 7) & 1, ff = n & 127;
                transpose_item((bj ? C.a->in[23] : C.a->in[22]) + (size_t)(l * 32 + e) * 1024 * 256, 256, 128 * pn + ff, 64 * kb, C.a->in[17] + l * 1024, WSP(bf16_t, WS_BGU) + (size_t)e * 512 * 1024 + (size_t)(32 * nb) * 1024 + 64 * kb, 1024, scr, lane); }
            else { const int r2 = r - 256, kb = r2 >> 5, nb = r2 & 31;
                transpose_item(C.a->in[24] + (size_t)(l * 32 + e) * 256 * 1024, 1024, 32 * nb + ln, 64 * kb, nullptr, WSP(bf16_t, WS_BD) + (size_t)e * 1024 * 256 + (size_t)(32 * nb) * 256 + 64 * kb, 256, scr, lane); } }
        __syncthreads();
    }
    LAS float* WR = (LAS float*)C.lds; const float* gain = C.a->in[17] + l * 1024;
    if (en & 16) {
        for (int idx = C.tid; idx < 36 * 1024; idx += NTHR) { const int cc = idx >> 10, k = idx & 1023;
            WR[idx] = gain[k] * (cc < 4 ? C.a->in[18][(size_t)l * 4096 + k * 4 + cc] : C.a->in[20][(size_t)l * 32768 + k * 32 + (cc - 4)]); }
        __syncthreads();
    }
    const float* X1 = WSP(float, WS_X1); bf16_t* HB = WSP(bf16_t, WS_S1);
    unsigned* CNT = WSP(unsigned, WS_CTL) + CW_CNT + l * 32; int* ROWL = WSP(int, WS_ROWL); int* TE = WSP(int, WS_TOKE); int* TP = WSP(int, WS_TOKP); float* TW = WSP(float, WS_TOKW);
    if (en & 16)
    for (int t = gw; t < T; t += NGW) {
        const f32x4* xr = (const f32x4*)(X1 + (size_t)t * DM) + lane; f32x4 xv[4]; float s = 0.f;
#pragma unroll
        for (int j = 0; j < 4; ++j) { xv[j] = xr[64 * j]; s += (xv[j].x * xv[j].x + xv[j].y * xv[j].y) + (xv[j].z * xv[j].z + xv[j].w * xv[j].w); }
        const float rstd = 1.0f / sqrtf(wave_sum(s) * (1.0f / DM) + RMS_EPS);
        { u32x2* o8 = (u32x2*)(HB + (size_t)t * DM) + lane;
#pragma unroll
          for (int j = 0; j < 4; ++j) { u32x2 wv; wv.x = pk2(xv[j].x * rstd, xv[j].y * rstd); wv.y = pk2(xv[j].z * rstd, xv[j].w * rstd); o8[64 * j] = wv; } }
        float lg[4];
#pragma unroll
        for (int cc = 0; cc < 4; ++cc) { float p = 0.f;
#pragma unroll
            for (int j = 0; j < 4; ++j) { const f32x4 wv = *(const LAS f32x4*)(WR + cc * 1024 + 256 * j + 4 * lane); p += (xv[j].x * wv.x + xv[j].y * wv.y) + (xv[j].z * wv.z + xv[j].w * wv.w); }
            lg[cc] = wave_sum(p) * rstd + C.a->in[19][l * 4 + cc]; }
        int gi = 0; float gm = lg[0];
#pragma unroll
        for (int cc = 1; cc < 4; ++cc) if (lg[cc] > gm) { gm = lg[cc]; gi = cc; }
        float gs = 0.f;
#pragma unroll
        for (int cc = 0; cc < 4; ++cc) gs += __expf(lg[cc] - gm);
        const float gwt = 1.0f / gs;
        gi = __builtin_amdgcn_readfirstlane(gi);
        float le[8];
#pragma unroll
        for (int e = 0; e < 8; ++e) { float p = 0.f; const LAS float* wrow = WR + (4 + 8 * gi + e) * 1024;
#pragma unroll
            for (int j = 0; j < 4; ++j) { const f32x4 wv = *(const LAS f32x4*)(wrow + 256 * j + 4 * lane); p += (xv[j].x * wv.x + xv[j].y * wv.y) + (xv[j].z * wv.z + xv[j].w * wv.w); }
            le[e] = wave_sum(p) * rstd + C.a->in[21][l * 32 + 8 * gi + e]; }
        int e0 = 0; float m0 = le[0];
#pragma unroll
        for (int e = 1; e < 8; ++e) if (le[e] > m0) { m0 = le[e]; e0 = e; }
        int e1 = -1; float m1 = -INFINITY;
#pragma unroll
        for (int e = 0; e < 8; ++e) if (e != e0 && le[e] > m1) { m1 = le[e]; e1 = e; }
        const float w0 = 1.0f / (1.0f + __expf(m1 - m0)), w1 = 1.0f - w0;
        if (lane == 0) { const int E0 = 8 * gi + e0, E1 = 8 * gi + e1;
            const int p0 = (int)__hip_atomic_fetch_add(CNT + E0, 1u, __ATOMIC_RELAXED, __HIP_MEMORY_SCOPE_AGENT), p1 = (int)__hip_atomic_fetch_add(CNT + E1, 1u, __ATOMIC_RELAXED, __HIP_MEMORY_SCOPE_AGENT);
            ROWL[(size_t)E0 * T + p0] = t; ROWL[(size_t)E1 * T + p1] = t;
            TE[t * 2] = E0; TE[t * 2 + 1] = E1; TP[t * 2] = p0; TP[t * 2 + 1] = p1; TW[t * 2] = gwt * w0; TW[t * 2 + 1] = gwt * w1; }
    }
}

__device__ __forceinline__ void p7_combine(Ctx& C, int l, int en, bool last_layer) {
    const int gw = C.bx * NWAVES + C.wave, NGW = C.G * NWAVES, lane = C.lane;
    const LAS int* tb = (const LAS int*)(C.lds + LDS_SCR + SCR_TBASE);
    if (en & 16) moe_tables(C, l);
    float* X1 = WSP(float, WS_X1); const bf16_t* YS = WSP(bf16_t, WS_PM); const int* TE = WSP(int, WS_TOKE); const int* TP = WSP(int, WS_TOKP); const float* TW = WSP(float, WS_TOKW);
    for (int t = gw; t < T; t += NGW) {
        f32x4* xr = (f32x4*)(X1 + (size_t)t * DM) + lane; f32x4 xv[4];
#pragma unroll
        for (int j = 0; j < 4; ++j) xv[j] = xr[64 * j];
        if (en & 16) {
#pragma unroll
            for (int k = 0; k < 2; ++k) { const int e = __builtin_amdgcn_readfirstlane(TE[t * 2 + k]), pos = __builtin_amdgcn_readfirstlane(TP[t * 2 + k]); const float wt = TW[t * 2 + k];
                const u32x2* yr = (const u32x2*)(YS + (size_t)(tb[e] * 256 + pos) * DM) + lane;
#pragma unroll
                for (int j = 0; j < 4; ++j) { const u32x2 y = yr[64 * j]; xv[j].x += wt * bflo(y.x); xv[j].y += wt * bfhi(y.x); xv[j].z += wt * bflo(y.y); xv[j].w += wt * bfhi(y.y); } } }
        float s = 0.f;
#pragma unroll
        for (int j = 0; j < 4; ++j) s += (xv[j].x * xv[j].x + xv[j].y * xv[j].y) + (xv[j].z * xv[j].z + xv[j].w * xv[j].w);
        const float rstd = 1.0f / sqrtf(wave_sum(s) * (1.0f / DM) + RMS_EPS);
        if (last_layer) { f32x4* orow = (f32x4*)(C.out + (size_t)t * DM) + lane; const f32x4* gn = (const f32x4*)C.a->in[25] + lane;
#pragma unroll
            for (int j = 0; j < 4; ++j) orow[64 * j] = xv[j] * rstd * gn[64 * j]; }
        else {
#pragma unroll
            for (int j = 0; j < 4; ++j) xr[64 * j] = xv[j];
            if (lane == 0) WSP(float, WS_RSTD)[t] = rstd;
            u32x2* o8 = (u32x2*)(WSP(bf16_t, WS_S1) + (size_t)t * DM) + lane;
#pragma unroll
            for (int j = 0; j < 4; ++j) { u32x2 wv; wv.x = pk2(xv[j].x, xv[j].y); wv.y = pk2(xv[j].z, xv[j].w); o8[64 * j] = wv; } }
    }
}

#ifndef PHMASK
#define PHMASK 0x1ff
#endif
#define IN(k) (((PHMASK >> ((k) == 0 ? 0 : (((k) - 1) % 8) + 1)) & 1) && lo <= (k) && (k) < hi)
#define SEAM(k) do { if (IN(k) && IN((k) + 1)) xcd_barrier(bar); } while (0)
template <int l>
__device__ __forceinline__ void layer_phases(Ctx& C, const XcdBarrier& bar, int lo_, int hi_) {
#if MK_SPLIT
    const int lo = lo_, hi = hi_;
#else
    constexpr int lo = 0, hi = NPHASE;
#endif
        const int en = l ? EN1 : EN0; const int pb = 8 * l; const bool lastl = (l == (EN_L1 ? 1 : 0));
        LAUNDER();
        if (IN(pb + 1)) {
            pg8::Gemm gm{WSP(bf16_t, WS_S1), WSP(bf16_t, WS_WIN) + (size_t)l * NPROJ * 1024, T, NPROJ, DM}; pg8::StaticOrder S; S.init(T, NPROJ, C.G, C.bx);
            pg8::EpiInProj E{WSP(bf16_t, WS_PM), NPROJ, WSP(float, WS_RSTD), WSP(float, WS_FD), 10};
            pg8::gemm_phase<pg8::EpiInProj, pg8::StaticOrder, true, true>(C.lds, gm, S, E);
        }
        SEAM(pb + 1);
        LAUNDER();
        if (IN(pb + 2)) { for (int cu = C.bx; cu < NCHK; cu += C.G) p2_unit(C, l, cu, en); }
        SEAM(pb + 2);
        LAUNDER();
        if (IN(pb + 3)) {
            bf16_t* Y = WSP(bf16_t, WS_S1); const bf16_t* PM = WSP(bf16_t, WS_PM);
            for (int pu = C.bx; pu < 256; pu += C.G) { const int bh = pu >> 3, s = pu & 7, b = bh >> 2, h = bh & 3, row0 = b * SEQ;
                if (en & 2) {
                    attn_unit<64, true>(C, PM + C_FQ + 64 * h, NPROJ, PM + C_FK + 64 * h, NPROJ, PM + C_FV + 64 * h, NPROJ, Y + 256 + 64 * h, WSP(float, WS_CUM) + h, row0, 15 - s, 0.125f * LOG2E);
                    attn_unit<64, true>(C, PM + C_FQ + 64 * h, NPROJ, PM + C_FK + 64 * h, NPROJ, PM + C_FV + 64 * h, NPROJ, Y + 256 + 64 * h, WSP(float, WS_CUM) + h, row0, s, 0.125f * LOG2E); }
                if (en & 8) {
                    attn_unit<96, false>(C, WSP(bf16_t, WS_QM) + 96 * h, 384, WSP(bf16_t, WS_KM) + 96 * h, 384, WSP(bf16_t, WS_VM) + 64 * h, 256, Y + 768 + 64 * h, nullptr, row0, 15 - s, 0.10206207261596575f * LOG2E);
                    attn_unit<96, false>(C, WSP(bf16_t, WS_QM) + 96 * h, 384, WSP(bf16_t, WS_KM) + 96 * h, 384, WSP(bf16_t, WS_VM) + 64 * h, 256, Y + 768 + 64 * h, nullptr, row0, s, 0.10206207261596575f * LOG2E); } }
            if (en & 4) { for (int cu = C.bx; cu < NCHK; cu += C.G) p3_ssd_unit(C, l, cu); }
        }
        SEAM(pb + 3);
        LAUNDER();
        if (IN(pb + 4)) {
            pg8::Gemm gm{WSP(bf16_t, WS_S1), WSP(bf16_t, WS_WOUT) + (size_t)l * 1024 * 1024, T, DM, DM}; pg8::StaticOrder S; S.init(T, DM, C.G, C.bx);
            pg8::EpiResid E{l == 0 ? C.a->in[0] : WSP(float, WS_X1), WSP(float, WS_X1), DM};
            pg8::gemm_phase<pg8::EpiResid, pg8::StaticOrder, true, true>(C.lds, gm, S, E);
        }
        SEAM(pb + 4);
        LAUNDER();
        if (IN(pb + 5)) { p5_router(C, l, en); }
        SEAM(pb + 5);
        LAUNDER();
        if (IN(pb + 6)) { if (en & 16) {
            moe_tables(C, l);
            MoeOrder<2> S{C.G, C.bx, (const LAS int*)(C.lds + LDS_SCR + SCR_CNT), (const LAS int*)(C.lds + LDS_SCR + SCR_TBASE), (const LAS int*)(C.lds + LDS_SCR + SCR_TILEE),
                       __builtin_amdgcn_readfirstlane(*(const LAS int*)(C.lds + LDS_SCR + SCR_NT)), WSP(int, WS_ROWL)};
            pg8::Gemm gm{WSP(bf16_t, WS_S1), WSP(bf16_t, WS_BGU), T, 512, DM};
            pg8::EpiGateUp E{WSP(bf16_t, WS_HACT), 256};
            pg8::gemm_phase_gather<pg8::EpiGateUp, MoeOrder<2>, true>(C.lds, gm, S, E); } }
        SEAM(pb + 6);
        LAUNDER();
        if (IN(pb + 7)) { if (en & 16) {
            moe_tables(C, l);
            MoeOrder<4> S{C.G, C.bx, (const LAS int*)(C.lds + LDS_SCR + SCR_CNT), (const LAS int*)(C.lds + LDS_SCR + SCR_TBASE), (const LAS int*)(C.lds + LDS_SCR + SCR_TILEE),
                       __builtin_amdgcn_readfirstlane(*(const LAS int*)(C.lds + LDS_SCR + SCR_NT)), WSP(int, WS_ROWL)};
            int kdim = 256; asm volatile("" : "+s"(kdim));
            pg8::Gemm gm{WSP(bf16_t, WS_HACT), WSP(bf16_t, WS_BD), 160 * 256, 1024, kdim};
            pg8::EpiSlotY E{WSP(bf16_t, WS_PM), DM};
            pg8::gemm_phase<pg8::EpiSlotY, MoeOrder<4>, true, true>(C.lds, gm, S, E); } }
        SEAM(pb + 7);
        LAUNDER();
        if (IN(pb + 8)) { p7_combine(C, l, en, lastl); }
        if (!lastl) SEAM(pb + 8);
    }
__global__ void __launch_bounds__(NTHR, 2) hcc_fwd(Args args) {
    extern __shared__ __attribute__((aligned(16))) unsigned char lds_raw[];
    Ctx C; C.lds = (lptr)lds_raw; C.tid = threadIdx.x; C.lane = C.tid & 63; C.wave = __builtin_amdgcn_readfirstlane(C.tid >> 6); C.G = gridDim.x; C.bx = blockIdx.x;
    C.a = (const __attribute__((address_space(4))) Args*)__builtin_amdgcn_kernarg_segment_ptr(); C.out = C.a->out; C.ws = C.a->ws;
    volatile LAS unsigned* MISC = (volatile LAS unsigned*)(C.lds + LDS_CTL);
    if (C.tid < 64) MISC[C.tid] = 0u;
    __syncthreads();
    XcdBarrier bar; bar.bar = WSP(unsigned, WS_CTL) + CW_BAR; bar.x = 0; bar.st = nullptr;
    if (!MK_SPLIT) bar = xcd_barrier_post(WSP(unsigned, WS_CTL) + CW_BAR, MISC + 8);
#if MK_SPLIT
    const int lo = C.a->ph_lo, hi = C.a->ph_hi;
#else
    constexpr int lo = 0, hi = NPHASE;
#endif

    if (IN(0)) { p0_prologue(C); }
    SEAM(0);
    layer_phases<0>(C, bar, lo, hi);
    if (EN_L1) layer_phases<1>(C, bar, lo, hi);
#undef IN
#undef SEAM
}

extern "C" void kernel_launch(void* const* d_in, const int* in_sizes, int n_in, void* d_out, int out_size, void* d_ws, size_t ws_size, hipStream_t stream) {
    static int grid = 0;
    if (grid == 0) {
        if (n_in != 26 || in_sizes[0] != T * DM || out_size != T * DM || ws_size < WS_NEED) { fprintf(stderr, "kernel_launch: unexpected shapes (n_in %d, in0 %d, out %d, ws %zu)\n", n_in, n_in > 0 ? in_sizes[0] : -1, out_size, ws_size); grid = -1; return; }
        int dev = 0, cus = 0, per_cu = 0;
        if (hipGetDevice(&dev) != hipSuccess || hipDeviceGetAttribute(&cus, hipDeviceAttributeMultiprocessorCount, dev) != hipSuccess) { grid = -1; return; }
        if (hipFuncSetAttribute((const void*)hcc_fwd, hipFuncAttributeMaxDynamicSharedMemorySize, LDS_BYTES) != hipSuccess) { fprintf(stderr, "kernel_launch: hipFuncSetAttribute failed\n"); grid = -1; return; }
        if (hipOccupancyMaxActiveBlocksPerMultiprocessor(&per_cu, (const void*)hcc_fwd, NTHR, LDS_BYTES) != hipSuccess || per_cu < 1) { fprintf(stderr, "kernel_launch: occupancy query says %d\n", per_cu); }
        (void)hipGetLastError();
        grid = cus;
    }
    if (grid < 0) return;
    if (hipMemsetAsync((char*)d_ws + WS_CTL, 0, CTL_ZERO_BYTES, stream) != hipSuccess) return;
    Args a{};
    for (int i = 0; i < 26; ++i) a.in[i] = (const float*)d_in[i];
    a.out = (float*)d_out; a.ws = (unsigned char*)d_ws;
#if MK_SPLIT
    for (int p = 0; p < NPHASE; ++p) { a.ph_lo = p; a.ph_hi = p + 1; hipLaunchKernelGGL(hcc_fwd, dim3(grid), dim3(NTHR), LDS_BYTES, stream, a); }
#else
    a.ph_lo = 0; a.ph_hi = NPHASE; hipLaunchKernelGGL(hcc_fwd, dim3(grid), dim3(NTHR), LDS_BYTES, stream, a);
#endif
}
```

```cpp
#include <hip/hip_runtime.h>
#include <cstdio>
#include <cstdint>
#include <cmath>
#define GAS __attribute__((address_space(1)))
#define LAS __attribute__((address_space(3)))
namespace pg8 {
#define PG8_LAS __attribute__((address_space(3)))
typedef unsigned short bf16_t;
typedef short bf16x8 __attribute__((ext_vector_type(8)));
typedef float f32x4 __attribute__((ext_vector_type(4)));
typedef unsigned u32x4 __attribute__((ext_vector_type(4)));
constexpr int BM = 256, BK = 64, HALF = 128, HTB = HALF * BK * 2  , STAGE_BYTES = 8 * HTB, NXCD = 8, WGM = 8;

__host__ __device__ __forceinline__ int lds_byte(int r, int c) { const int st = (r >> 4) * 2 + (c >> 5), rr = r & 15, cc = c & 31, ob = rr * 64 + cc * 2; return st * 1024 + (ob ^ (((ob >> 9) & 1) << 5)); }
__host__ __device__ __forceinline__ void stage_rc(int b, int& R, int& C) { const int st = b / 1024, sb = b % 1024, swz = sb ^ (((sb >> 9) & 1) << 5); R = (st >> 1) * 16 + swz / 64; C = (st & 1) * 32 + (swz % 64) / 2; }
__host__ __device__ __forceinline__ int perm32(int rho) { const int n = rho >> 4, i = rho & 15; return 8 * (i >> 2) + 4 * n + (i & 3); }

struct Unit { int pm, pn, e, r0, ne; };
struct Gemm { const bf16_t* A; const bf16_t* Bt; int M, N, K; };

struct StaticOrder {
    int nM, nN, nwg, G, c;
    __host__ __device__ void init(int M, int N, int G_, int c_) { nM = M / BM; nN = N / BM; nwg = nM * nN; G = G_; c = c_; }
    __host__ __device__ bool next(int i, Unit& u) const {
        const long L = (long)i * G + c; if (L >= nwg) return false;
        int wgid = (int)L; { const int q = nwg / NXCD, r = nwg % NXCD, xcd = wgid % NXCD, off = wgid / NXCD; wgid = (xcd < r ? xcd * (q + 1) : r * (q + 1) + (xcd - r) * q) + off; }
        const int nig = WGM * nN, gid = wgid / nig, fm = gid * WGM, gsz = (nM - fm) < WGM ? (nM - fm) : WGM;
        u.pm = fm + ((wgid % nig) % gsz); u.pn = (wgid % nig) / gsz; return true;
    }
    __device__ __forceinline__ void a_ready(const Unit&) const {}
    __device__ __forceinline__ void done(const Unit&) const {}
};

__device__ __forceinline__ unsigned cvt_pk_bf16(float lo, float hi) { unsigned r; asm volatile("v_cvt_pk_bf16_f32 %0, %1, %2" : "=v"(r) : "v"(lo), "v"(hi)); return r; }

struct EpiInProj {
    static constexpr bool PERM = true, AFTER_DRAIN = false;
    bf16_t* O; int ldc; const float* rstd; float* FD; int fd_pn;
    __device__ __forceinline__ void operator()(const f32x4 (&acc)[2][2][4][2], const Unit& u, int wr, int wc, int fr, int fq) const {
        const int row0 = u.pm * BM + wr * 64 + fr; const int col0 = u.pn * BM + wc * 32 + 8 * fq;
        const bool fdl = (u.pn == fd_pn) && (wc == 1) && (fq == 0);
#pragma unroll
        for (int ai = 0; ai < 2; ++ai)
#pragma unroll
            for (int m = 0; m < 4; ++m) { const int row = row0 + ai * HALF + m * 16; const float rs = rstd[row]; bf16_t* rowp = O + (size_t)row * ldc + col0;
#pragma unroll
                for (int bj = 0; bj < 2; ++bj) { const f32x4 v0 = acc[ai][bj][m][0] * rs, v1 = acc[ai][bj][m][1] * rs;
                    u32x4 w; w.x = cvt_pk_bf16(v0[0], v0[1]); w.y = cvt_pk_bf16(v0[2], v0[3]); w.z = cvt_pk_bf16(v1[0], v1[1]); w.w = cvt_pk_bf16(v1[2], v1[3]);
                    *(u32x4*)(rowp + bj * HALF) = w;
                    if (bj == 1 && fdl) { *(f32x4*)(FD + (size_t)row * 8) = v0; *(f32x4*)(FD + (size_t)row * 8 + 4) = v1; } } }
    }
};
struct EpiResid {
    static constexpr bool PERM = false, AFTER_DRAIN = false;
    const float* base; float* out; int ldc;
    __device__ __forceinline__ void operator()(const f32x4 (&acc)[2][2][4][2], const Unit& u, int wr, int wc, int fr, int fq) const {
        const int row0 = u.pm * BM + wr * 64 + fr; const int col0 = u.pn * BM + wc * 32 + 4 * fq;
#pragma unroll
        for (int ai = 0; ai < 2; ++ai)
#pragma unroll
            for (int m = 0; m < 4; ++m) { const size_t off = (size_t)(row0 + ai * HALF + m * 16) * ldc + col0;
#pragma unroll
                for (int bj = 0; bj < 2; ++bj)
#pragma unroll
                    for (int n = 0; n < 2; ++n) { const f32x4 b = *(const f32x4*)(base + off + bj * HALF + n * 16); *(f32x4*)(out + off + bj * HALF + n * 16) = b + acc[ai][bj][m][n]; } }
    }
};
struct EpiGateUp {
    static constexpr bool PERM = true, AFTER_DRAIN = false;
    bf16_t* O; int ldc;
    __device__ __forceinline__ void operator()(const f32x4 (&acc)[2][2][4][2], const Unit& u, int wr, int wc, int fr, int fq) const {
        const int row0 = u.pm * BM + wr * 64 + fr; const int col0 = (u.pn & 1) * HALF + wc * 32 + 8 * fq;
#pragma unroll
        for (int ai = 0; ai < 2; ++ai)
#pragma unroll
            for (int m = 0; m < 4; ++m) { bf16_t* rowp = O + (size_t)(row0 + ai * HALF + m * 16) * ldc + col0; float h[8];
#pragma unroll
                for (int n = 0; n < 2; ++n)
#pragma unroll
                    for (int j = 0; j < 4; ++j) { const float gt = acc[ai][0][m][n][j], up = acc[ai][1][m][n][j]; h[n * 4 + j] = gt * up / (1.0f + __expf(-gt)); }
                u32x4 w; w.x = cvt_pk_bf16(h[0], h[1]); w.y = cvt_pk_bf16(h[2], h[3]); w.z = cvt_pk_bf16(h[4], h[5]); w.w = cvt_pk_bf16(h[6], h[7]);
                *(u32x4*)rowp = w; }
    }
};
struct EpiSlotY {
    static constexpr bool PERM = true, AFTER_DRAIN = false;
    bf16_t* O; int ldc;
    __device__ __forceinline__ void operator()(const f32x4 (&acc)[2][2][4][2], const Unit& u, int wr, int wc, int fr, int fq) const {
        const int row0 = u.pm * BM + wr * 64 + fr; const int col0 = (u.pn & 3) * BM + wc * 32 + 8 * fq;
#pragma unroll
        for (int ai = 0; ai < 2; ++ai)
#pragma unroll
            for (int m = 0; m < 4; ++m) { bf16_t* rowp = O + (size_t)(row0 + ai * HALF + m * 16) * ldc + col0;
#pragma unroll
                for (int bj = 0; bj < 2; ++bj) { const f32x4 v0 = acc[ai][bj][m][0], v1 = acc[ai][bj][m][1];
                    u32x4 w; w.x = cvt_pk_bf16(v0[0], v0[1]); w.y = cvt_pk_bf16(v0[2], v0[3]); w.z = cvt_pk_bf16(v1[0], v1[1]); w.w = cvt_pk_bf16(v1[2], v1[3]);
                    *(u32x4*)(rowp + bj * HALF) = w; } }
    }
};

template <class Epi, class Sched, bool ALIGN_EPI = false, bool SP2 = false>
__device__ __forceinline__ void gemm_phase(PG8_LAS unsigned char* lds, const Gemm g, const Sched& S, const Epi& E) {
    int tid_ = threadIdx.x; asm volatile("" : "+v"(tid_));
    const int tid = tid_, wid = __builtin_amdgcn_readfirstlane(tid >> 6), lane = tid & 63, wr = wid >> 2, wc = wid & 3, fr = lane & 15, fq = lane >> 4;
    const int K = g.K, nt = K / BK;
    unsigned voffA[2], voffB[2];
#pragma unroll
    for (int i = 0; i < 2; ++i) { int R, C; stage_rc(tid * 16 + i * 8192, R, C); const int Rb = Epi::PERM ? ((R & ~31) + perm32(R & 31)) : R;
        voffA[i] = (unsigned)(R * K + C) * 2u; voffB[i] = (unsigned)(Rb * K + C) * 2u; }
    const size_t kstep = (size_t)(BK * 2);
    const size_t hstep = (size_t)HALF * K * 2;
    const size_t tstep = 2 * hstep;
    const unsigned ldsw = (unsigned)wid * 1024u;
    const int aoff = lds_byte(wr * 64 + fr, fq * 8), boff = lds_byte(wc * 32 + fr, fq * 8);
#define PG8_SA(b, h) (((b) * 2 + (h)) * HTB)
#define PG8_SB(b, h) ((4 + (b) * 2 + (h)) * HTB)
#define PG8_STAGE(bufoff, gbase, voff) do { _Pragma("unroll") for (int _i = 0; _i < 2; ++_i) \
        __builtin_amdgcn_global_load_lds((const unsigned*)((const char*)(gbase) + (voff)[_i]), (PG8_LAS unsigned*)(lds + (bufoff) + ldsw + _i * 8192), 16, 0, 0); } while (0)
#define PG8_LDA(dst, b, h) do { _Pragma("unroll") for (int m = 0; m < 4; ++m) _Pragma("unroll") for (int k = 0; k < 2; ++k) dst[m][k] = *(const PG8_LAS bf16x8*)(lds + PG8_SA(b, h) + aoff + m * 2048 + k * 1024); } while (0)
#define PG8_LDB(dst, b, h) do { _Pragma("unroll") for (int n = 0; n < 2; ++n) _Pragma("unroll") for (int k = 0; k < 2; ++k) dst[n][k] = *(const PG8_LAS bf16x8*)(lds + PG8_SB(b, h) + boff + n * 2048 + k * 1024); } while (0)
#define PG8_MMA(ai, bj, At, Bt) do { __builtin_amdgcn_s_setprio(1); _Pragma("unroll") for (int m = 0; m < 4; ++m) _Pragma("unroll") for (int n = 0; n < 2; ++n) _Pragma("unroll") for (int k = 0; k < 2; ++k) \
        acc[ai][bj][m][n] = __builtin_amdgcn_mfma_f32_16x16x32_bf16(Bt[n][k], At[m][k], acc[ai][bj][m][n], 0, 0, 0); __builtin_amdgcn_s_setprio(0); } while (0)
#define PG8_WAIT_V(n) asm volatile("s_waitcnt vmcnt(" #n ")" ::: "memory")
#define PG8_WAIT_L(n) asm volatile("s_waitcnt lgkmcnt(" #n ")" ::: "memory")
#define PG8_BAR __builtin_amdgcn_s_barrier()
#define PG8_SCHED __builtin_amdgcn_sched_barrier(0)
    Unit cur, nxt; int ui = 0;
    if (!S.next(0, cur)) return;
    f32x4 acc[2][2][4][2];
#pragma unroll
    for (int a = 0; a < 2; ++a)
#pragma unroll
        for (int b = 0; b < 2; ++b)
#pragma unroll
            for (int m = 0; m < 4; ++m)
#pragma unroll
                for (int n = 0; n < 2; ++n) acc[a][b][m][n] = (f32x4){0.f, 0.f, 0.f, 0.f};
    bf16x8 At[4][2], B0[2][2], B1[2][2];
    const char* cA = (const char*)g.A + (size_t)cur.pm * tstep; const char* cB = (const char*)g.Bt + (size_t)cur.pn * tstep;
    S.a_ready(cur);
    if constexpr (SP2) {
        PG8_STAGE(PG8_SB(0, 0), cB, voffB); PG8_STAGE(PG8_SB(0, 1), cB + hstep, voffB); PG8_STAGE(PG8_SA(0, 0), cA, voffA); PG8_STAGE(PG8_SA(0, 1), cA + hstep, voffA);
        if (wr == 1) PG8_BAR;
        PG8_WAIT_V(2); PG8_BAR;
        PG8_STAGE(PG8_SB(1, 0), cB + kstep, voffB); PG8_STAGE(PG8_SA(1, 0), cA + kstep, voffA); PG8_STAGE(PG8_SB(1, 1), cB + hstep + kstep, voffB);
        PG8_WAIT_V(6); PG8_BAR;
    } else {
        PG8_STAGE(PG8_SB(0, 0), cB, voffB); PG8_STAGE(PG8_SA(0, 0), cA, voffA); PG8_STAGE(PG8_SB(0, 1), cB + hstep, voffB); PG8_STAGE(PG8_SA(0, 1), cA + hstep, voffA);
        if (wr == 1) PG8_BAR;
        PG8_WAIT_V(4); PG8_BAR;
        PG8_STAGE(PG8_SB(1, 0), cB + kstep, voffB); PG8_STAGE(PG8_SA(1, 0), cA + kstep, voffA); PG8_STAGE(PG8_SB(1, 1), cB + hstep + kstep, voffB);
        PG8_WAIT_V(6); PG8_BAR;
    }
    for (;;) {
        const bool has_next = S.next(ui + 1, nxt);
        const char* nA = has_next ? (const char*)g.A + (size_t)nxt.pm * tstep : cA; const char* nB = has_next ? (const char*)g.Bt + (size_t)nxt.pn * tstep : cB;
        for (int t = 0; t < nt; t += 2) {
            const bool last = (t == nt - 2);
            const char* a1 = cA + (size_t)(t + 1) * kstep;
            const char* a2 = last ? nA : cA + (size_t)(t + 2) * kstep; const char* b2 = last ? nB : cB + (size_t)(t + 2) * kstep;
            const char* a3 = a2 + kstep; const char* b3 = b2 + kstep;
            if (last && has_next) S.a_ready(nxt);
            if constexpr (SP2) {
            PG8_LDB(B0, 0, 0); PG8_LDB(B1, 0, 1); PG8_SCHED; PG8_LDA(At, 0, 0); PG8_STAGE(PG8_SA(1, 1), a1 + hstep, voffA);
            PG8_WAIT_V(8); PG8_WAIT_L(0); PG8_BAR; PG8_MMA(0, 0, At, B0); PG8_MMA(0, 1, At, B1); PG8_BAR; PG8_SCHED;
            PG8_LDA(At, 0, 1); PG8_STAGE(PG8_SB(0, 0), b2, voffB); PG8_STAGE(PG8_SB(0, 1), b2 + hstep, voffB); PG8_STAGE(PG8_SA(0, 0), a2, voffA);
            PG8_WAIT_V(8); PG8_WAIT_L(0); PG8_BAR; PG8_MMA(1, 0, At, B0); PG8_MMA(1, 1, At, B1); PG8_BAR; PG8_SCHED;
            PG8_LDB(B0, 1, 0); PG8_LDB(B1, 1, 1); PG8_SCHED; PG8_LDA(At, 1, 0); PG8_STAGE(PG8_SA(0, 1), a2 + hstep, voffA);
            PG8_WAIT_V(8); PG8_WAIT_L(0); PG8_BAR; PG8_MMA(0, 0, At, B0); PG8_MMA(0, 1, At, B1); PG8_BAR; PG8_SCHED;
            PG8_LDA(At, 1, 1); PG8_STAGE(PG8_SB(1, 0), b3, voffB); PG8_STAGE(PG8_SB(1, 1), b3 + hstep, voffB); PG8_STAGE(PG8_SA(1, 0), a3, voffA);
            PG8_WAIT_V(8); PG8_WAIT_L(0); PG8_BAR; PG8_MMA(1, 0, At, B0); PG8_MMA(1, 1, At, B1); PG8_BAR; PG8_SCHED;
            } else {
            PG8_LDB(B0, 0, 0); PG8_SCHED; PG8_LDA(At, 0, 0); PG8_STAGE(PG8_SA(1, 1), a1 + hstep, voffA);
            PG8_WAIT_L(8); PG8_BAR; PG8_WAIT_L(0); PG8_MMA(0, 0, At, B0); PG8_BAR; PG8_SCHED;
            PG8_LDB(B1, 0, 1); PG8_STAGE(PG8_SB(0, 0), b2, voffB);
            PG8_BAR; PG8_WAIT_L(0); PG8_MMA(0, 1, At, B1); PG8_BAR;
            PG8_LDA(At, 0, 1); PG8_STAGE(PG8_SA(0, 0), a2, voffA);
            PG8_BAR; PG8_WAIT_L(0); PG8_MMA(1, 0, At, B0); PG8_BAR; PG8_SCHED;
            PG8_STAGE(PG8_SB(0, 1), b2 + hstep, voffB);
            PG8_WAIT_V(6); PG8_BAR; PG8_MMA(1, 1, At, B1); PG8_BAR;
            PG8_LDB(B0, 1, 0); PG8_SCHED; PG8_LDA(At, 1, 0); PG8_STAGE(PG8_SA(0, 1), a2 + hstep, voffA);
            PG8_WAIT_L(8); PG8_BAR; PG8_WAIT_L(0); PG8_MMA(0, 0, At, B0); PG8_BAR; PG8_SCHED;
            PG8_LDB(B1, 1, 1); PG8_STAGE(PG8_SB(1, 0), b3, voffB);
            PG8_BAR; PG8_WAIT_L(0); PG8_MMA(0, 1, At, B1); PG8_BAR;
            PG8_LDA(At, 1, 1); PG8_STAGE(PG8_SA(1, 0), a3, voffA);
            PG8_BAR; PG8_WAIT_L(0); PG8_MMA(1, 0, At, B0); PG8_BAR; PG8_SCHED;
            PG8_STAGE(PG8_SB(1, 1), b3 + hstep, voffB);
            PG8_WAIT_V(6); PG8_BAR; PG8_MMA(1, 1, At, B1); PG8_BAR;
            }
        }
        if constexpr (ALIGN_EPI) { if (wr == 0) PG8_BAR; }
        if constexpr (!Epi::AFTER_DRAIN) { E(acc, cur, wr, wc, fr, fq); S.done(cur); }
        if (!has_next) break;
#pragma unroll
        for (int a = 0; a < 2; ++a)
#pragma unroll
            for (int b = 0; b < 2; ++b)
#pragma unroll
                for (int m = 0; m < 4; ++m)
#pragma unroll
                    for (int n = 0; n < 2; ++n) acc[a][b][m][n] = (f32x4){0.f, 0.f, 0.f, 0.f};
        cur = nxt; cA = nA; cB = nB; ++ui;
        if constexpr (ALIGN_EPI) { if (wr == 1) PG8_BAR; }
    }
    PG8_WAIT_V(0);
    if constexpr (!ALIGN_EPI) { if (wr == 0) PG8_BAR; }
    PG8_BAR;
    if constexpr (Epi::AFTER_DRAIN) { E.fused(acc, cur, wr, wc, fr, fq, lds, wid, lane); S.done(cur); }
#undef PG8_SA
#undef PG8_SB
#undef PG8_STAGE
#undef PG8_LDA
#undef PG8_LDB
#undef PG8_MMA
#undef PG8_WAIT_V
#undef PG8_WAIT_L
#undef PG8_BAR
#undef PG8_SCHED
}
template <class Epi, class Sched, bool ALIGN_EPI = false>
__device__ __forceinline__ void gemm_phase_gather(PG8_LAS unsigned char* lds, const Gemm g, const Sched& S, const Epi& E) {
    int tid_ = threadIdx.x; asm volatile("" : "+v"(tid_));
    const int tid = tid_, wid = __builtin_amdgcn_readfirstlane(tid >> 6), lane = tid & 63, wr = wid >> 2, wc = wid & 3, fr = lane & 15, fq = lane >> 4;
    const int K = g.K, nt = K / BK;
    unsigned voffB[2]; int RA[2]; unsigned CA[2];
#pragma unroll
    for (int i = 0; i < 2; ++i) { int R, C; stage_rc(tid * 16 + i * 8192, R, C); const int Rb = Epi::PERM ? ((R & ~31) + perm32(R & 31)) : R;
        RA[i] = R; CA[i] = (unsigned)C * 2u; voffB[i] = (unsigned)(Rb * K + C) * 2u; }
    const size_t kstep = (size_t)(BK * 2);
    const size_t hstep = (size_t)HALF * K * 2;
    const size_t tstep = 2 * hstep;
    const unsigned ldsw = (unsigned)wid * 1024u;
    const int aoff = lds_byte(wr * 64 + fr, fq * 8), boff = lds_byte(wc * 32 + fr, fq * 8);
#define PG8_SA(b, h) (((b) * 2 + (h)) * HTB)
#define PG8_SB(b, h) ((4 + (b) * 2 + (h)) * HTB)
#define PG8_STAGE(bufoff, gbase, voff) do { _Pragma("unroll") for (int _i = 0; _i < 2; ++_i) \
        __builtin_amdgcn_global_load_lds((const unsigned*)((const char*)(gbase) + (voff)[_i]), (PG8_LAS unsigned*)(lds + (bufoff) + ldsw + _i * 8192), 16, 0, 0); } while (0)
#define PG8_LDA(dst, b, h) do { _Pragma("unroll") for (int m = 0; m < 4; ++m) _Pragma("unroll") for (int k = 0; k < 2; ++k) dst[m][k] = *(const PG8_LAS bf16x8*)(lds + PG8_SA(b, h) + aoff + m * 2048 + k * 1024); } while (0)
#define PG8_LDB(dst, b, h) do { _Pragma("unroll") for (int n = 0; n < 2; ++n) _Pragma("unroll") for (int k = 0; k < 2; ++k) dst[n][k] = *(const PG8_LAS bf16x8*)(lds + PG8_SB(b, h) + boff + n * 2048 + k * 1024); } while (0)
#define PG8_MMA(ai, bj, At, Bt) do { __builtin_amdgcn_s_setprio(1); _Pragma("unroll") for (int m = 0; m < 4; ++m) _Pragma("unroll") for (int n = 0; n < 2; ++n) _Pragma("unroll") for (int k = 0; k < 2; ++k) \
        acc[ai][bj][m][n] = __builtin_amdgcn_mfma_f32_16x16x32_bf16(Bt[n][k], At[m][k], acc[ai][bj][m][n], 0, 0, 0); __builtin_amdgcn_s_setprio(0); } while (0)
#define PG8_WAIT_V(n) asm volatile("s_waitcnt vmcnt(" #n ")" ::: "memory")
#define PG8_WAIT_L(n) asm volatile("s_waitcnt lgkmcnt(" #n ")" ::: "memory")
#define PG8_BAR __builtin_amdgcn_s_barrier()
#define PG8_SCHED __builtin_amdgcn_sched_barrier(0)
#define PG8_GOFFS(dst, u) do { _Pragma("unroll") for (int _h = 0; _h < 2; ++_h) _Pragma("unroll") for (int _i = 0; _i < 2; ++_i) \
        dst[_h][_i] = (unsigned)S.arow(u, _h * HALF + RA[_i]) * (unsigned)(K * 2) + CA[_i]; } while (0)
    Unit cur, nxt; int ui = 0;
    if (!S.next(0, cur)) return;
    unsigned vA[2][2], nvA[2][2];
    PG8_GOFFS(vA, cur);
    f32x4 acc[2][2][4][2];
#pragma unroll
    for (int a = 0; a < 2; ++a)
#pragma unroll
        for (int b = 0; b < 2; ++b)
#pragma unroll
            for (int m = 0; m < 4; ++m)
#pragma unroll
                for (int n = 0; n < 2; ++n) acc[a][b][m][n] = (f32x4){0.f, 0.f, 0.f, 0.f};
    bf16x8 At[4][2], B0[2][2], B1[2][2];
    const char* const cA = (const char*)g.A; const char* cB = (const char*)g.Bt + (size_t)cur.pn * tstep;
    asm volatile("s_waitcnt vmcnt(0)" ::: "memory");
    PG8_STAGE(PG8_SB(0, 0), cB, voffB); PG8_STAGE(PG8_SB(0, 1), cB + hstep, voffB); PG8_STAGE(PG8_SA(0, 0), cA, vA[0]); PG8_STAGE(PG8_SA(0, 1), cA, vA[1]);
    if (wr == 1) PG8_BAR;
    PG8_WAIT_V(2); PG8_BAR;
    PG8_STAGE(PG8_SB(1, 0), cB + kstep, voffB); PG8_STAGE(PG8_SA(1, 0), cA + kstep, vA[0]); PG8_STAGE(PG8_SB(1, 1), cB + hstep + kstep, voffB);
    PG8_WAIT_V(6); PG8_BAR;
    for (;;) {
        const bool has_next = S.next(ui + 1, nxt);
        const char* nB = has_next ? (const char*)g.Bt + (size_t)nxt.pn * tstep : cB;
        for (int t = 0; t < nt; t += 2) {
            const bool last = (t == nt - 2);
            if (last) {
                if (has_next) { PG8_GOFFS(nvA, nxt); }
                else {
#pragma unroll
                    for (int _h = 0; _h < 2; ++_h)
#pragma unroll
                        for (int _i = 0; _i < 2; ++_i) nvA[_h][_i] = vA[_h][_i]; }
            }
            unsigned s0[2], s1[2];
#pragma unroll
            for (int _i = 0; _i < 2; ++_i) { s0[_i] = last ? nvA[0][_i] : vA[0][_i]; s1[_i] = last ? nvA[1][_i] : vA[1][_i]; }
            const char* a1 = cA + (size_t)(t + 1) * kstep;
            const char* a2 = last ? cA : cA + (size_t)(t + 2) * kstep; const char* b2 = last ? nB : cB + (size_t)(t + 2) * kstep;
            const char* a3 = a2 + kstep; const char* b3 = b2 + kstep;
            PG8_LDB(B0, 0, 0); PG8_LDB(B1, 0, 1); PG8_SCHED; PG8_LDA(At, 0, 0); PG8_STAGE(PG8_SA(1, 1), a1, vA[1]);
            PG8_WAIT_V(8); PG8_WAIT_L(0); PG8_BAR; PG8_MMA(0, 0, At, B0); PG8_MMA(0, 1, At, B1); PG8_BAR; PG8_SCHED;
            PG8_LDA(At, 0, 1); PG8_STAGE(PG8_SB(0, 0), b2, voffB); PG8_STAGE(PG8_SB(0, 1), b2 + hstep, voffB); PG8_STAGE(PG8_SA(0, 0), a2, s0);
            PG8_WAIT_V(8); PG8_WAIT_L(0); PG8_BAR; PG8_MMA(1, 0, At, B0); PG8_MMA(1, 1, At, B1); PG8_BAR; PG8_SCHED;
            PG8_LDB(B0, 1, 0); PG8_LDB(B1, 1, 1); PG8_SCHED; PG8_LDA(At, 1, 0); PG8_STAGE(PG8_SA(0, 1), a2, s1);
            PG8_WAIT_V(8); PG8_WAIT_L(0); PG8_BAR; PG8_MMA(0, 0, At, B0); PG8_MMA(0, 1, At, B1); PG8_BAR; PG8_SCHED;
            PG8_LDA(At, 1, 1); PG8_STAGE(PG8_SB(1, 0), b3, voffB); PG8_STAGE(PG8_SB(1, 1), b3 + hstep, voffB); PG8_STAGE(PG8_SA(1, 0), a3, s0);
            PG8_WAIT_V(8); PG8_WAIT_L(0); PG8_BAR; PG8_MMA(1, 0, At, B0); PG8_MMA(1, 1, At, B1); PG8_BAR; PG8_SCHED;
        }
        if constexpr (ALIGN_EPI) { if (wr == 0) PG8_BAR; }
        E(acc, cur, wr, wc, fr, fq); S.done(cur);
        if (!has_next) break;
#pragma unroll
        for (int a = 0; a < 2; ++a)
#pragma unroll
            for (int b = 0; b < 2; ++b)
#pragma unroll
                for (int m = 0; m < 4; ++m)
#pragma unroll
                    for (int n = 0; n < 2; ++n) acc[a][b][m][n] = (f32x4){0.f, 0.f, 0.f, 0.f};
        cur = nxt; cB = nB; ++ui;
#pragma unroll
        for (int _h = 0; _h < 2; ++_h)
#pragma unroll
            for (int _i = 0; _i < 2; ++_i) vA[_h][_i] = nvA[_h][_i];
        if constexpr (ALIGN_EPI) { if (wr == 1) PG8_BAR; }
    }
    PG8_WAIT_V(0);
    if constexpr (!ALIGN_EPI) { if (wr == 0) PG8_BAR; }
    PG8_BAR;
#undef PG8_SA
#undef PG8_SB
#undef PG8_STAGE
#undef PG8_LDA
#undef PG8_LDB
#undef PG8_MMA
#undef PG8_WAIT_V
#undef PG8_WAIT_L
#undef PG8_BAR
#undef PG8_SCHED
#undef PG8_GOFFS
}
}

#define XB_TMO      128
#define XB_XCNT(j)  (256  + 64 * (j))
#define XB_XSUB(j)  (1280 + 64 * (j))
#define XB_XGEN(j)  (2304 + 64 * (j))
#define XB_TOP      3328
#define XB_TOPGEN   3392
#define XCD_BAR_WORDS 3456
#define XB_SPIN_CAP (1u << 18)

__device__ __forceinline__ unsigned xb_ld(unsigned* p)              { return __hip_atomic_load(p, __ATOMIC_RELAXED, __HIP_MEMORY_SCOPE_AGENT); }
__device__ __forceinline__ unsigned xb_add(unsigned* p, unsigned v) { return __hip_atomic_fetch_add(p, v, __ATOMIC_RELAXED, __HIP_MEMORY_SCOPE_AGENT); }
__device__ __forceinline__ unsigned xb_xcc_id() { return (unsigned)__builtin_amdgcn_s_getreg((3 << 11) | 20) & 0xFu; }
#define XB_SPIN(cond, bar) do { unsigned _sp = 0; while (cond) { __builtin_amdgcn_s_sleep(1); \
    if ((++_sp & 255u) == 0u) { if (xb_ld(&(bar)[XB_TMO])) break; if (_sp > XB_SPIN_CAP) { atomicAdd(&(bar)[XB_TMO], 1u); break; } } } } while (0)

struct XcdBarrier {
    unsigned* bar; unsigned x;
    volatile LAS unsigned* st;
};

__device__ __forceinline__ XcdBarrier xcd_barrier_post(unsigned* bar, volatile LAS unsigned* st) {
    XcdBarrier b; b.bar = bar; b.x = xb_xcc_id(); b.st = st;
    if (threadIdx.x == 0) (void)xb_add(&bar[XB_XCNT(b.x)], 1u);
    return b;
}
__device__ __forceinline__ void xcd_barrier_complete(unsigned* bar, unsigned x, unsigned& nloc, unsigned& nx) {
    const unsigned G = gridDim.x * gridDim.y * gridDim.z;
    unsigned sum, cnt, mine, sp = 0u;
    for (;;) {
        sum = 0u; cnt = 0u; mine = 0u;
#pragma unroll
        for (unsigned j = 0; j < 16; ++j) { const unsigned c = xb_ld(&bar[XB_XCNT(j)]); sum += c; cnt += (c > 0u) ? 1u : 0u; mine = (j == x) ? c : mine; }
        if (sum == G) break;
        __builtin_amdgcn_s_sleep(1);
        if ((++sp & 255u) == 0u) { if (xb_ld(&bar[XB_TMO])) break; if (sp > XB_SPIN_CAP) { atomicAdd(&bar[XB_TMO], 1u); break; } }
    }
    nloc = mine > 0u ? mine : 1u; nx = cnt > 0u ? cnt : 1u;
}

__device__ __forceinline__ void xcd_barrier(const XcdBarrier& b) {
    asm volatile("s_waitcnt vmcnt(0)" ::: "memory");
    __syncthreads();
    if (threadIdx.x == 0) {
        unsigned* bar = b.bar;
        __builtin_amdgcn_s_waitcnt(0);
        unsigned nloc = b.st[0], nx = b.st[1];
        if (nloc == 0u) { xcd_barrier_complete(bar, b.x, nloc, nx); b.st[0] = nloc; b.st[1] = nx; }
        const unsigned old = xb_add(&bar[XB_XSUB(b.x)], 1u);
        const unsigned gen = old / nloc;
        if (old + 1u == (gen + 1u) * nloc) {
            __builtin_amdgcn_fence(__ATOMIC_RELEASE, "agent");
            asm volatile("s_waitcnt vmcnt(0)" ::: "memory");
            const unsigned og = xb_add(&bar[XB_TOP], 1u);
            const unsigned tg = og / nx;
            if (og + 1u == (tg + 1u) * nx) xb_add(&bar[XB_TOPGEN], 1u);
            else XB_SPIN(xb_ld(&bar[XB_TOPGEN]) == tg, bar);
            __builtin_amdgcn_fence(__ATOMIC_ACQUIRE, "agent");
            xb_add(&bar[XB_XGEN(b.x)], 1u);
            asm volatile("s_waitcnt vmcnt(0)" ::: "memory");
        } else {
            XB_SPIN(xb_ld(&bar[XB_XGEN(b.x)]) == gen, bar);
            __builtin_amdgcn_fence(__ATOMIC_ACQUIRE, "agent");
            asm volatile("s_waitcnt vmcnt(0)" ::: "memory");
        }
    }
    __syncthreads();
}


constexpr int NWAVES = 8, NTHR = 512;
constexpr int T = 16384, DM = 1024, SEQ = 2048, NPROJ = 2816, NCHK = 256;
constexpr float RMS_EPS = 1e-6f, LOG2E = 1.4426950408889634f;
constexpr int C_AB = 0, C_AC = 256, C_AV = 512, C_FQ = 768, C_FK = 1024, C_FV = 1280, C_Z = 1536, C_XBC = 1792, C_CQ = 2304, C_CKV = 2560, C_KR = 2688, C_FD = 2720;
#ifndef EN0
#define EN0 31
#endif
#ifndef EN1
#define EN1 31
#endif
#ifndef EN_L1
#define EN_L1 1
#endif
#ifndef MK_SPLIT
#define MK_SPLIT 0
#endif
constexpr int NPHASE = 17;

constexpr size_t MiB = 1u << 20;
constexpr size_t WS_CTL = 0, CTL_ZERO_BYTES = 65536;
constexpr size_t WS_X1 = 1 * MiB;
constexpr size_t WS_PM = 65 * MiB;
constexpr size_t WS_S1 = 153 * MiB;
constexpr size_t WS_HACT = 185 * MiB;
constexpr size_t WS_E = 205 * MiB;
constexpr size_t WS_QM = WS_E, WS_KM = WS_E + 12 * MiB, WS_VM = WS_E + 24 * MiB, WS_ST = WS_E + 32 * MiB;
constexpr size_t WS_BGU = WS_E, WS_BD = WS_E + 32 * MiB;
constexpr size_t WS_WIN = 261 * MiB;
constexpr size_t WS_WOUT = 272 * MiB;
constexpr size_t WS_WUQ = 276 * MiB;
constexpr size_t WS_WUKV = WS_WUQ + 512 * 1024;
constexpr size_t WS_MISC = 277 * MiB;
constexpr size_t WS_FD = WS_MISC;
constexpr size_t WS_RSTD = WS_FD + 512 * 1024;
constexpr size_t WS_CUM = WS_RSTD + 64 * 1024;
constexpr size_t WS_COS = WS_CUM + 256 * 1024;
constexpr size_t WS_SIN = WS_COS + 1 * MiB;
constexpr size_t WS_CDEC = WS_SIN + 1 * MiB;
constexpr size_t WS_ROWL = WS_CDEC + 64 * 1024;
constexpr size_t WS_TOKE = WS_ROWL + 2 * MiB;
constexpr size_t WS_TOKP = WS_TOKE + 128 * 1024;
constexpr size_t WS_TOKW = WS_TOKP + 128 * 1024;
constexpr size_t WS_END = WS_TOKW + 128 * 1024;
static_assert(WS_END <= 284 * MiB, "workspace map");
constexpr size_t WS_NEED = 284 * MiB;
constexpr int CW_CNT = 64;
constexpr int CW_BAR = 4096;

constexpr int LDS_BYTES = 155648;
constexpr int LDS_SCR = 147456;
constexpr int LDS_CTL = 151552;
constexpr int SCR_RED = 0;
constexpr int SCR_RQ = 256, SCR_RKV = 512;
constexpr int SCR_CNT = 768;
constexpr int SCR_TBASE = 896;
constexpr int SCR_TILEE = 1040;
constexpr int SCR_NT = 1680;

typedef unsigned short bf16_t;
typedef short bf16x8 __attribute__((ext_vector_type(8)));
typedef short s16x4 __attribute__((ext_vector_type(4)));
typedef float f32x4 __attribute__((ext_vector_type(4)));
typedef unsigned u32x4 __attribute__((ext_vector_type(4)));
typedef unsigned u32x2 __attribute__((ext_vector_type(2)));
typedef LAS unsigned char* lptr;
#define LDS_WAIT() asm volatile("s_waitcnt lgkmcnt(0)" ::: "memory")

__device__ __forceinline__ unsigned f2bf(float f) { unsigned u = __builtin_bit_cast(unsigned, f); return (u + 0x7fffu + ((u >> 16) & 1u)) >> 16; }
__device__ __forceinline__ unsigned pk2(float lo, float hi) { return f2bf(lo) | (f2bf(hi) << 16); }
__device__ __forceinline__ float bf2f(unsigned short u) { return __uint_as_float((unsigned)u << 16); }
__device__ __forceinline__ float bflo(unsigned u) { return __uint_as_float(u << 16); }
__device__ __forceinline__ float bfhi(unsigned u) { return __uint_as_float(u & 0xffff0000u); }
__device__ __forceinline__ float wave_sum(float v) {
#pragma unroll
    for (int o = 1; o < 64; o <<= 1) v += __shfl_xor(v, o);
    return v;
}
__device__ __forceinline__ float silu_f(float x) { return x / (1.0f + __expf(-x)); }
__device__ __forceinline__ float softplus_f(float x) { return fmaxf(x, 0.f) + log1pf(__expf(-fabsf(x))); }
__device__ __forceinline__ f32x4 mfma16(bf16x8 a, bf16x8 b, f32x4 c) { return __builtin_amdgcn_mfma_f32_16x16x32_bf16(a, b, c, 0, 0, 0); }
__device__ __forceinline__ bf16x8 tr_frag(lptr base, int ld  , int row_a, int row_b, int col0, int lane) {
    typedef short v4i16_t __attribute__((ext_vector_type(4)));
    const int i = lane & 15, q = i >> 2, p = i & 3;
    const s16x4 lo = __builtin_bit_cast(s16x4, __builtin_amdgcn_ds_read_tr16_b64_v4i16((LAS v4i16_t*)(base + ((row_a + q) * ld + col0 + 4 * p) * 2)));
    const s16x4 hi = __builtin_bit_cast(s16x4, __builtin_amdgcn_ds_read_tr16_b64_v4i16((LAS v4i16_t*)(base + ((row_b + q) * ld + col0 + 4 * p) * 2)));
    return (bf16x8){lo[0], lo[1], lo[2], lo[3], hi[0], hi[1], hi[2], hi[3]};
}

struct Args { const float* in[26]; float* out; unsigned char* ws; int ph_lo, ph_hi; };
struct Ctx {
    lptr lds;
    int tid, lane, wave, G, bx;
    const __attribute__((address_space(4))) Args* a;
    float* out; unsigned char* ws;
};
#define WSP(type, off) ((type*)(C.ws + (off)))
#define LAUNDER() do { unsigned char* p_ = C.ws; int t_ = C.tid; unsigned l_ = (unsigned)(size_t)C.lds; const __attribute__((address_space(4))) Args* a_ = C.a; asm volatile("" : "+s"(p_), "+v"(t_), "+s"(l_), "+s"(a_)); C.a = a_; C.ws = p_; C.tid = t_; C.lane = t_ & 63; C.wave = __builtin_amdgcn_readfirstlane(t_ >> 6); C.lds = (lptr)(size_t)l_; } while (0)

__device__ __forceinline__ int refcol(int n) { return n < 1536 ? n : n < 2304 ? n + 4 : n < 2720 ? n + 8 : n < 2724 ? 1536 + (n - 2720) : n < 2728 ? 2308 + (n - 2724) : -1; }

struct TrItem { const float* W; int ldw, scol4, k0; const float* gk; bf16_t* dst; int K; };
__device__ __forceinline__ void tr_load(const TrItem& t, f32x4 (&v)[8], int lane) {
    const int r8 = lane >> 3;
#pragma unroll
    for (int i = 0; i < 8; ++i) { v[i] = (f32x4){0.f, 0.f, 0.f, 0.f}; if (t.scol4 >= 0) v[i] = *(const f32x4*)(t.W + (size_t)(t.k0 + 8 * i + r8) * t.ldw + t.scol4); }
}
__device__ __forceinline__ void tr_store(const TrItem& t, const f32x4 (&v)[8], LAS float* scr, int lane) {
    const int r8 = lane >> 3, c4 = lane & 7;
#pragma unroll
    for (int i = 0; i < 8; ++i) { const int kk = 8 * i + r8; const float g = t.gk ? t.gk[t.k0 + kk] : 1.0f; LAS float* p = scr + kk * 33 + 4 * c4;
        p[0] = v[i].x * g; p[1] = v[i].y * g; p[2] = v[i].z * g; p[3] = v[i].w * g; }
    LDS_WAIT(); asm volatile("" ::: "memory");
    const int c = lane & 7;
#pragma unroll
    for (int j = 0; j < 4; ++j) { const int n = (lane >> 3) + 8 * j; const LAS float* sp = scr + (8 * c) * 33 + n;
        u32x4 o; o.x = pk2(sp[0 * 33], sp[1 * 33]); o.y = pk2(sp[2 * 33], sp[3 * 33]); o.z = pk2(sp[4 * 33], sp[5 * 33]); o.w = pk2(sp[6 * 33], sp[7 * 33]);
        *(u32x4*)(t.dst + (size_t)n * t.K + 8 * c) = o; }
    LDS_WAIT(); asm volatile("" ::: "memory");
}

__device__ __forceinline__ void row_to_bf16(const float* xrow, bf16_t* orow, float* rstd_out, int lane) {
    const f32x4* xr = (const f32x4*)xrow + lane; f32x4 v[4]; float s = 0.f;
#pragma unroll
    for (int j = 0; j < 4; ++j) { v[j] = xr[64 * j]; s += (v[j].x * v[j].x + v[j].y * v[j].y) + (v[j].z * v[j].z + v[j].w * v[j].w); }
    s = wave_sum(s);
    if (lane == 0) *rstd_out = 1.0f / sqrtf(s * (1.0f / DM) + RMS_EPS);
    u32x2* o8 = (u32x2*)orow + lane;
#pragma unroll
    for (int j = 0; j < 4; ++j) { u32x2 w; w.x = pk2(v[j].x, v[j].y); w.y = pk2(v[j].z, v[j].w); o8[64 * j] = w; }
}

constexpr int P0_I_IN = 16 * 88, P0_I_OUT = 16 * 32, P0_I_UQ = 4 * 12, P0_I_UKV = 2 * 16, P0_I_L = P0_I_IN + P0_I_OUT + P0_I_UQ + P0_I_UKV;
__device__ __forceinline__ TrItem p0_item(Ctx& C, int it, int lane) {
    const int l = it / P0_I_L; int r = it % P0_I_L; const int c4 = (lane & 7) * 4; TrItem t;
    if (r < P0_I_IN) { const int kb = r / 88, nb = r % 88; t.W = C.a->in[3] + (size_t)l * 1024 * 2728; t.ldw = 2728; t.scol4 = refcol(32 * nb + c4); t.k0 = 64 * kb; t.gk = C.a->in[2] + l * 1024;
        t.dst = WSP(bf16_t, WS_WIN) + (size_t)l * NPROJ * 1024 + (size_t)(32 * nb) * 1024 + 64 * kb; t.K = 1024; return t; }
    r -= P0_I_IN;
    if (r < P0_I_OUT) { const int kb = r / 32, nb = r % 32; t.W = C.a->in[16] + (size_t)l * 1024 * 1024; t.ldw = 1024; t.scol4 = 32 * nb + c4; t.k0 = 64 * kb; t.gk = nullptr;
        t.dst = WSP(bf16_t, WS_WOUT) + (size_t)l * 1024 * 1024 + (size_t)(32 * nb) * 1024 + 64 * kb; t.K = 1024; return t; }
    r -= P0_I_OUT;
    if (r < P0_I_UQ) { const int kb = r / 12, nb = r % 12; t.W = C.a->in[14] + (size_t)l * 256 * 384; t.ldw = 384; t.scol4 = 32 * nb + c4; t.k0 = 64 * kb; t.gk = C.a->in[12] + l * 256;
        t.dst = WSP(bf16_t, WS_WUQ) + (size_t)l * 384 * 256 + (size_t)(32 * nb) * 256 + 64 * kb; t.K = 256; return t; }
    r -= P0_I_UQ;
    { const int kb = r / 16, nb = r % 16; t.W = C.a->in[15] + (size_t)l * 128 * 512; t.ldw = 512; t.scol4 = 32 * nb + c4; t.k0 = 64 * kb; t.gk = C.a->in[13] + l * 128;
        t.dst = WSP(bf16_t, WS_WUKV) + (size_t)l * 512 * 128 + (size_t)(32 * nb) * 128 + 64 * kb; t.K = 128; return t; }
}
__device__ __forceinline__ void p0_prologue(Ctx& C) {
    LAS float* scr = (LAS float*)(C.lds + C.wave * 8704);
    const int gw = C.bx * NWAVES + C.wave, NGW = C.G * NWAVES, lane = C.lane;
    for (int m = gw; m < T; m += 2 * NGW) { const int m2 = m + NGW; const bool two = m2 < T;
        const f32x4* xa = (const f32x4*)(C.a->in[0] + (size_t)m * DM) + lane; const f32x4* xb = (const f32x4*)(C.a->in[0] + (size_t)(two ? m2 : m) * DM) + lane;
        f32x4 va[4], vb[4]; float sa = 0.f, sb = 0.f;
#pragma unroll
        for (int j = 0; j < 4; ++j) { va[j] = xa[64 * j]; vb[j] = xb[64 * j]; }
#pragma unroll
        for (int j = 0; j < 4; ++j) { sa += (va[j].x * va[j].x + va[j].y * va[j].y) + (va[j].z * va[j].z + va[j].w * va[j].w); sb += (vb[j].x * vb[j].x + vb[j].y * vb[j].y) + (vb[j].z * vb[j].z + vb[j].w * vb[j].w); }
        sa = wave_sum(sa); sb = wave_sum(sb);
        if (lane == 0) { WSP(float, WS_RSTD)[m] = 1.0f / sqrtf(sa * (1.0f / DM) + RMS_EPS); if (two) WSP(float, WS_RSTD)[m2] = 1.0f / sqrtf(sb * (1.0f / DM) + RMS_EPS); }
        u32x2* oa = (u32x2*)(WSP(bf16_t, WS_S1) + (size_t)m * DM) + lane; u32x2* ob = (u32x2*)(WSP(bf16_t, WS_S1) + (size_t)m2 * DM) + lane;
#pragma unroll
        for (int j = 0; j < 4; ++j) { u32x2 w; w.x = pk2(va[j].x, va[j].y); w.y = pk2(va[j].z, va[j].w); oa[64 * j] = w; if (two) { u32x2 w2; w2.x = pk2(vb[j].x, vb[j].y); w2.y = pk2(vb[j].z, vb[j].w); ob[64 * j] = w2; } } }
    { f32x4 cur[8], nx[8]; int it = gw;
      if (it < 2 * P0_I_L) { TrItem t = p0_item(C, it, lane); tr_load(t, cur, lane); }
#pragma unroll 1
      for (; it < 2 * P0_I_L; it += NGW) { const bool more = it + NGW < 2 * P0_I_L;
          if (more) { TrItem tn = p0_item(C, it + NGW, lane); tr_load(tn, nx, lane); }
          TrItem t = p0_item(C, it, lane); tr_store(t, cur, scr, lane);
#pragma unroll
          for (int i = 0; i < 8; ++i) cur[i] = nx[i]; } }
    { const int* pos = (const int*)C.a->in[1]; float* cs = WSP(float, WS_COS); float* sn = WSP(float, WS_SIN);
      for (int e = C.bx * NTHR + C.tid; e < T * 16; e += C.G * NTHR) { const int t = e >> 4, i = e & 15;
          const float inv = powf(10000.0f, -(float)(2 * i) / 32.0f); const float ang = (float)pos[t] * inv;
          const double rev = (double)ang * 0.15915494309189535; const double fr = rev - floor(rev); const float a = (float)(fr * 6.283185307179586);
          cs[e] = cosf(a); sn[e] = sinf(a); } }
}

constexpr int XS_LD = 264, BC_LD = 136, ML_LD = 72;
constexpr int XS_OFF = 0, BL_OFF = 33792, CL_OFF = 51200, ACUM_OFF = 68608, DT_OFF = 69632, SSQ_OFF = 70656, ML_OFF = 71680, PV_OFF = 108544;
static_assert(PV_OFF + 36864 <= LDS_SCR, "ssd lds");
__device__ __forceinline__ float log_sigmoid_f(float x) { return -(fmaxf(-x, 0.f) + log1pf(__expf(-fabsf(x)))); }

__device__ __forceinline__ void ssd_fill(Ctx& C, int l, int cu) {
    const int c = cu & 31, t0 = cu * 64; const bf16_t* PM = WSP(bf16_t, WS_PM);
    const float* cw = C.a->in[6] + l * 4 * 512; const float* cb = C.a->in[7] + l * 512;
#pragma unroll 1
    for (int it = 0; it < 8; ++it) { const int item = C.tid + NTHR * it, lt = item >> 6, ch = (item & 63) * 8;
        float acc[8];
#pragma unroll
        for (int j = 0; j < 8; ++j) acc[j] = cb[ch + j];
#pragma unroll
        for (int d = 0; d < 4; ++d) { const int sp = 64 * c + lt - 3 + d;
            if (sp >= 0) { const u32x4 raw = *(const u32x4*)(PM + (size_t)(t0 + lt - 3 + d) * NPROJ + C_XBC + ch); const float* w = cw + d * 512 + ch;
                acc[0] += w[0] * bflo(raw.x); acc[1] += w[1] * bfhi(raw.x); acc[2] += w[2] * bflo(raw.y); acc[3] += w[3] * bfhi(raw.y);
                acc[4] += w[4] * bflo(raw.z); acc[5] += w[5] * bfhi(raw.z); acc[6] += w[6] * bflo(raw.w); acc[7] += w[7] * bfhi(raw.w); } }
        u32x4 o; o.x = pk2(silu_f(acc[0]), silu_f(acc[1])); o.y = pk2(silu_f(acc[2]), silu_f(acc[3])); o.z = pk2(silu_f(acc[4]), silu_f(acc[5])); o.w = pk2(silu_f(acc[6]), silu_f(acc[7]));
        lptr dst = ch < 256 ? C.lds + XS_OFF + (lt * XS_LD + ch) * 2 : ch < 384 ? C.lds + BL_OFF + (lt * BC_LD + (ch - 256)) * 2 : C.lds + CL_OFF + (lt * BC_LD + (ch - 384)) * 2;
        *(LAS u32x4*)dst = o; }
    if (C.tid < 256) { const int lt = C.tid >> 2, h = C.tid & 3;
        const float dt = softplus_f(WSP(float, WS_FD)[(size_t)(t0 + lt) * 8 + 4 + h] + C.a->in[8][l * 4 + h]);
        ((LAS float*)(C.lds + DT_OFF))[lt * 4 + h] = dt; ((LAS float*)(C.lds + ACUM_OFF))[lt * 4 + h] = -__expf(C.a->in[9][l * 4 + h]) * dt; }
    __syncthreads();
    if (C.wave < 4) { LAS float* ac = (LAS float*)(C.lds + ACUM_OFF) + C.lane * 4 + C.wave; float v = *ac;
#pragma unroll
        for (int o = 1; o < 64; o <<= 1) { const float y = __shfl_up(v, o); if (C.lane >= o) v += y; }
        *ac = v; }
    __syncthreads();
}

__device__ __forceinline__ void p2_unit(Ctx& C, int l, int cu, int en) {
    const int b = cu >> 5, c = cu & 31, t0 = cu * 64; const int tid = C.tid, lane = C.lane, w = C.wave, g = lane >> 4, i = lane & 15;
    const bf16_t* PM = WSP(bf16_t, WS_PM); bf16_t* Y = WSP(bf16_t, WS_S1);
    { const float* cw = C.a->in[4] + l * 3 * 256;
#pragma unroll 1
      for (int it = 0; it < 4; ++it) { const int item = tid + NTHR * it, lt = item >> 5, ch = (item & 31) * 8; const size_t r = (size_t)(t0 + lt) * NPROJ;
          float acc[8] = {0.f, 0.f, 0.f, 0.f, 0.f, 0.f, 0.f, 0.f};
          if (en & 1) {
#pragma unroll
          for (int d = 0; d < 3; ++d) { const int sp = 64 * c + lt - 2 + d;
              if (sp >= 0) { const size_t rr = (size_t)(t0 + lt - 2 + d) * NPROJ; const u32x4 cg = *(const u32x4*)(PM + rr + C_AC + ch), vl = *(const u32x4*)(PM + rr + C_AV + ch); const float* wv = cw + d * 256 + ch;
                  acc[0] += wv[0] * bflo(cg.x) * bflo(vl.x); acc[1] += wv[1] * bfhi(cg.x) * bfhi(vl.x); acc[2] += wv[2] * bflo(cg.y) * bflo(vl.y); acc[3] += wv[3] * bfhi(cg.y) * bfhi(vl.y);
                  acc[4] += wv[4] * bflo(cg.z) * bflo(vl.z); acc[5] += wv[5] * bfhi(cg.z) * bfhi(vl.z); acc[6] += wv[6] * bflo(cg.w) * bflo(vl.w); acc[7] += wv[7] * bfhi(cg.w) * bfhi(vl.w); } }
          const u32x4 bg = *(const u32x4*)(PM + r + C_AB + ch);
          acc[0] *= bflo(bg.x); acc[1] *= bfhi(bg.x); acc[2] *= bflo(bg.y); acc[3] *= bfhi(bg.y); acc[4] *= bflo(bg.z); acc[5] *= bfhi(bg.z); acc[6] *= bflo(bg.w); acc[7] *= bfhi(bg.w); }
          u32x4 o; o.x = pk2(acc[0], acc[1]); o.y = pk2(acc[2], acc[3]); o.z = pk2(acc[4], acc[5]); o.w = pk2(acc[6], acc[7]);
          *(u32x4*)(Y + (size_t)(t0 + lt) * DM + ch) = o; } }
    for (int mx = 1; mx < 4; ++mx) if (!((en >> mx) & 1)) {
        for (int it = 0; it < 4; ++it) { const int item = tid + NTHR * it, lt = item >> 5, ch = (item & 31) * 8; *(u32x4*)(Y + (size_t)(t0 + lt) * DM + 256 * mx + ch) = (u32x4){0u, 0u, 0u, 0u}; } }
    LAUNDER();
    if (en & 2) {
        const float* FD = WSP(float, WS_FD); const float* fb = C.a->in[5] + l * 4; LAS float* red = (LAS float*)(C.lds + LDS_SCR + SCR_RED);
        float ps[4] = {0.f, 0.f, 0.f, 0.f};
        for (int tk = tid; tk < 64 * c; tk += NTHR) { const f32x4 f = *(const f32x4*)(FD + (size_t)(b * SEQ + tk) * 8);
            ps[0] += log_sigmoid_f(f.x + fb[0]); ps[1] += log_sigmoid_f(f.y + fb[1]); ps[2] += log_sigmoid_f(f.z + fb[2]); ps[3] += log_sigmoid_f(f.w + fb[3]); }
#pragma unroll
        for (int h = 0; h < 4; ++h) ps[h] = wave_sum(ps[h]);
        if (lane == 0) { red[w * 4 + 0] = ps[0]; red[w * 4 + 1] = ps[1]; red[w * 4 + 2] = ps[2]; red[w * 4 + 3] = ps[3]; }
        __syncthreads();
        if (w < 4) { float pre = 0.f;
#pragma unroll
            for (int k = 0; k < 8; ++k) pre += red[k * 4 + w];
            float v = log_sigmoid_f(FD[(size_t)(t0 + lane) * 8 + w] + fb[w]);
#pragma unroll
            for (int o = 1; o < 64; o <<= 1) { const float y = __shfl_up(v, o); if (lane >= o) v += y; }
            WSP(float, WS_CUM)[(size_t)(t0 + lane) * 4 + w] = (pre + v) * LOG2E; }
        __syncthreads();
    }
    LAUNDER();
    if (en & 4) {
        ssd_fill(C, l, cu);
        const LAS float* AC = (const LAS float*)(C.lds + ACUM_OFF); const LAS float* DT = (const LAS float*)(C.lds + DT_OFF);
#pragma unroll 1
        for (int it = 0; it < 4; ++it) { const int item = tid + NTHR * it, lt = item >> 5, col = (item & 31) * 8, h = col >> 6, n = col & 63;
            const u32x4 s = *(const LAS u32x4*)(C.lds + BL_OFF + (lt * BC_LD + 64 * (h >> 1) + n) * 2);
            const float sc = DT[lt * 4 + h] * __expf(AC[63 * 4 + h] - AC[lt * 4 + h]);
            u32x4 o; o.x = pk2(bflo(s.x) * sc, bfhi(s.x) * sc); o.y = pk2(bflo(s.y) * sc, bfhi(s.y) * sc); o.z = pk2(bflo(s.z) * sc, bfhi(s.z) * sc); o.w = pk2(bflo(s.w) * sc, bfhi(s.w) * sc);
            *(LAS u32x4*)(C.lds + PV_OFF + (lt * XS_LD + col) * 2) = o; }
        __syncthreads();
        { const int h = w >> 1, rh = w & 1; float* ST = WSP(float, WS_ST) + (size_t)(cu * 4 + h) * 4096;
#pragma unroll
          for (int mbl = 0; mbl < 2; ++mbl) { const int mb = 2 * rh + mbl;
#pragma unroll
              for (int nb = 0; nb < 4; ++nb) { f32x4 acc = {0.f, 0.f, 0.f, 0.f};
#pragma unroll
                  for (int kk = 0; kk < 2; ++kk) { const int rb = 32 * kk + 8 * g;
                      const bf16x8 a = tr_frag(C.lds + XS_OFF, XS_LD, rb, rb + 4, 64 * h + 16 * mb, lane);
                      const bf16x8 bq = tr_frag(C.lds + PV_OFF, XS_LD, rb, rb + 4, 64 * h + 16 * nb, lane);
                      acc = mfma16(a, bq, acc); }
#pragma unroll
                  for (int r = 0; r < 4; ++r) ST[(16 * mb + 4 * g + r) * 64 + 16 * nb + i] = acc[r]; } }
          if (tid < 4) WSP(float, WS_CDEC)[cu * 4 + tid] = __expf(AC[63 * 4 + tid]); }
        __syncthreads();
    }
    LAUNDER();
    if (en & 8) {
        LAS float* RQ = (LAS float*)(C.lds + LDS_SCR + SCR_RQ); LAS float* RKV = (LAS float*)(C.lds + LDS_SCR + SCR_RKV);
        { const int lt = tid >> 3, sub = tid & 7; const bf16_t* pr = PM + (size_t)(t0 + lt) * NPROJ; float s1 = 0.f, s2 = 0.f;
#pragma unroll
          for (int k = 0; k < 4; ++k) { const u32x4 v = *(const u32x4*)(pr + C_CQ + sub * 32 + 8 * k);
              s1 += bflo(v.x) * bflo(v.x) + bfhi(v.x) * bfhi(v.x) + bflo(v.y) * bflo(v.y) + bfhi(v.y) * bfhi(v.y) + bflo(v.z) * bflo(v.z) + bfhi(v.z) * bfhi(v.z) + bflo(v.w) * bflo(v.w) + bfhi(v.w) * bfhi(v.w); }
#pragma unroll
          for (int k = 0; k < 2; ++k) { const u32x4 v = *(const u32x4*)(pr + C_CKV + sub * 16 + 8 * k);
              s2 += bflo(v.x) * bflo(v.x) + bfhi(v.x) * bfhi(v.x) + bflo(v.y) * bflo(v.y) + bfhi(v.y) * bfhi(v.y) + bflo(v.z) * bflo(v.z) + bfhi(v.z) * bfhi(v.z) + bflo(v.w) * bflo(v.w) + bfhi(v.w) * bfhi(v.w); }
          s1 += __shfl_xor(s1, 1); s1 += __shfl_xor(s1, 2); s1 += __shfl_xor(s1, 4); s2 += __shfl_xor(s2, 1); s2 += __shfl_xor(s2, 2); s2 += __shfl_xor(s2, 4);
          if (sub == 0) { RQ[lt] = 1.0f / sqrtf(s1 * (1.0f / 256.0f) + RMS_EPS); RKV[lt] = 1.0f / sqrtf(s2 * (1.0f / 128.0f) + RMS_EPS); } }
        __syncthreads();
        const float* COS = WSP(float, WS_COS); const float* SIN = WSP(float, WS_SIN);
        bf16_t* QM = WSP(bf16_t, WS_QM); bf16_t* KM = WSP(bf16_t, WS_KM); bf16_t* VM = WSP(bf16_t, WS_VM);
        {
          const bf16_t* WU = WSP(bf16_t, WS_WUQ) + (size_t)l * 384 * 256; f32x4 acc[3][4];
#pragma unroll
          for (int a = 0; a < 3; ++a)
#pragma unroll
              for (int m = 0; m < 4; ++m) acc[a][m] = (f32x4){0.f, 0.f, 0.f, 0.f};
#pragma unroll 1
          for (int kk = 0; kk < 8; ++kk) { bf16x8 bq[4];
#pragma unroll
              for (int m = 0; m < 4; ++m) bq[m] = *(const bf16x8*)(PM + (size_t)(t0 + 16 * m + i) * NPROJ + C_CQ + 32 * kk + 8 * g);
#pragma unroll
              for (int a = 0; a < 3; ++a) { const bf16x8 af = *(const bf16x8*)(WU + (size_t)(16 * (3 * w + a) + i) * 256 + 32 * kk + 8 * g);
#pragma unroll
                  for (int m = 0; m < 4; ++m) acc[a][m] = mfma16(af, bq[m], acc[a][m]); } }
#pragma unroll
          for (int m = 0; m < 4; ++m) { const int tk = 16 * m + i; const float rq = RQ[tk];
#pragma unroll
              for (int a = 0; a < 3; ++a) acc[a][m] = acc[a][m] * rq;
              if (w & 1) { const f32x4 cs = *(const f32x4*)(COS + (size_t)(t0 + tk) * 16 + 4 * g), sn = *(const f32x4*)(SIN + (size_t)(t0 + tk) * 16 + 4 * g);
                  const f32x4 x1 = acc[1][m], x2 = acc[2][m]; acc[1][m] = x1 * cs - x2 * sn; acc[2][m] = x2 * cs + x1 * sn; }
#pragma unroll
              for (int a = 0; a < 3; ++a) { u32x2 o; o.x = pk2(acc[a][m][0], acc[a][m][1]); o.y = pk2(acc[a][m][2], acc[a][m][3]);
                  *(u32x2*)(QM + (size_t)(t0 + tk) * 384 + 16 * (3 * w + a) + 4 * g) = o; } } }
        LAUNDER();
        {
          const bf16_t* WU = WSP(bf16_t, WS_WUKV) + (size_t)l * 512 * 128; f32x4 acc[4][4];
#pragma unroll
          for (int a = 0; a < 4; ++a)
#pragma unroll
              for (int m = 0; m < 4; ++m) acc[a][m] = (f32x4){0.f, 0.f, 0.f, 0.f};
#pragma unroll 1
          for (int kk = 0; kk < 4; ++kk) { bf16x8 bq[4];
#pragma unroll
              for (int m = 0; m < 4; ++m) bq[m] = *(const bf16x8*)(PM + (size_t)(t0 + 16 * m + i) * NPROJ + C_CKV + 32 * kk + 8 * g);
#pragma unroll
              for (int a = 0; a < 4; ++a) { const bf16x8 af = *(const bf16x8*)(WU + (size_t)(16 * (4 * w + a) + i) * 128 + 32 * kk + 8 * g);
#pragma unroll
                  for (int m = 0; m < 4; ++m) acc[a][m] = mfma16(af, bq[m], acc[a][m]); } }
          const int hd = w >> 1;
#pragma unroll
          for (int m = 0; m < 4; ++m) { const int tk = 16 * m + i; const float rk = RKV[tk];
#pragma unroll
              for (int a = 0; a < 4; ++a) { const f32x4 v = acc[a][m] * rk; u32x2 o; o.x = pk2(v[0], v[1]); o.y = pk2(v[2], v[3]);
                  if (w & 1) *(u32x2*)(VM + (size_t)(t0 + tk) * 256 + 64 * hd + 16 * a + 4 * g) = o;
                  else       *(u32x2*)(KM + (size_t)(t0 + tk) * 384 + 96 * hd + 16 * a + 4 * g) = o; } } }
        {
          const int lt = tid >> 3, i0 = (tid & 7) * 2; const bf16_t* pr = PM + (size_t)(t0 + lt) * NPROJ + C_KR;
          const unsigned a = *(const unsigned*)(pr + i0), bb = *(const unsigned*)(pr + 16 + i0);
          const float c0 = COS[(size_t)(t0 + lt) * 16 + i0], c1 = COS[(size_t)(t0 + lt) * 16 + i0 + 1], s0 = SIN[(size_t)(t0 + lt) * 16 + i0], s1 = SIN[(size_t)(t0 + lt) * 16 + i0 + 1];
          const float x10 = bflo(a), x11 = bfhi(a), x20 = bflo(bb), x21 = bfhi(bb);
          const unsigned o1 = pk2(x10 * c0 - x20 * s0, x11 * c1 - x21 * s1), o2 = pk2(x20 * c0 + x10 * s0, x21 * c1 + x11 * s1);
#pragma unroll
          for (int hd = 0; hd < 4; ++hd) { *(unsigned*)(KM + (size_t)(t0 + lt) * 384 + 96 * hd + 64 + i0) = o1; *(unsigned*)(KM + (size_t)(t0 + lt) * 384 + 96 * hd + 80 + i0) = o2; } }
        __syncthreads();
    }
}

template <int DK, bool FOX>
__device__ __forceinline__ void attn_unit(Ctx& C, const bf16_t* Qg, int qp, const bf16_t* Kg, int kp, const bf16_t* Vg, int vp, bf16_t* Og, const float* cumg, int row0, int qb, float qscale) {
    constexpr int KLD = DK + 8, VLD = 72, KBUF = 64 * KLD * 2, VBUF = 64 * VLD * 2, BUFB = KBUF + VBUF + 256, NKK = DK / 32, CPR = DK / 8;
    const int tid = C.tid, lane = C.lane, w = C.wave, g = lane >> 4, i = lane & 15;
    const int q0w = qb * 128 + 16 * w, nt = 2 * (qb + 1);
    bf16x8 qf[NKK];
    { const bf16_t* qrow = Qg + (size_t)(row0 + q0w + i) * qp;
#pragma unroll
      for (int kk = 0; kk < NKK; ++kk) qf[kk] = *(const bf16x8*)(qrow + 32 * kk + 8 * g); }
    const float cq = FOX ? cumg[(size_t)(row0 + q0w + i) * 4] : 0.f;
    f32x4 o[4];
#pragma unroll
    for (int m = 0; m < 4; ++m) o[m] = (f32x4){0.f, 0.f, 0.f, 0.f};
    float mrun = -INFINITY, lsum = 0.f;
    const int kr0 = tid / CPR, kc0 = tid % CPR, kr1 = (tid + NTHR) / CPR, kc1 = (tid + NTHR) % CPR, vr = tid >> 3, vc = tid & 7;
    const bool k1 = (DK == 96) && (tid < 256);
    u32x4 kreg0, kreg1 = {0u, 0u, 0u, 0u}, vreg; float ckreg = 0.f;
#define AT_LOAD(kt) do { const size_t rb_ = (size_t)row0 + 64 * (kt); \
        kreg0 = *(const u32x4*)(Kg + (rb_ + kr0) * kp + 8 * kc0); if (k1) kreg1 = *(const u32x4*)(Kg + (rb_ + kr1) * kp + 8 * kc1); \
        vreg = *(const u32x4*)(Vg + (rb_ + vr) * vp + 8 * vc); if (FOX && tid < 64) ckreg = cumg[(rb_ + tid) * 4]; } while (0)
#define AT_STORE(buf) do { lptr b_ = C.lds + (buf) * BUFB; \
        *(LAS u32x4*)(b_ + (kr0 * KLD + 8 * kc0) * 2) = kreg0; if (k1) *(LAS u32x4*)(b_ + (kr1 * KLD + 8 * kc1) * 2) = kreg1; \
        *(LAS u32x4*)(b_ + KBUF + (vr * VLD + 8 * vc) * 2) = vreg; if (FOX && tid < 64) *(LAS float*)(b_ + KBUF + VBUF + tid * 4) = ckreg; } while (0)
    AT_LOAD(0); AT_STORE(0); __syncthreads();
#pragma unroll 1
    for (int kt = 0; kt < nt; ++kt) {
        const int cur = kt & 1;
        if (kt + 1 < nt) AT_LOAD(kt + 1);
        const bool active = FOX ? (64 * kt <= q0w + 15) : (kt <= (q0w >> 6));
        if (active) {
            lptr kb = C.lds + cur * BUFB; lptr vb = kb + KBUF; lptr ckb = vb + VBUF;
            f32x4 s[4];
#pragma unroll
            for (int n = 0; n < 4; ++n) { s[n] = (f32x4){0.f, 0.f, 0.f, 0.f};
#pragma unroll
                for (int kk = 0; kk < NKK; ++kk) { const bf16x8 a = *(const LAS bf16x8*)(kb + ((16 * n + i) * KLD + 32 * kk + 8 * g) * 2); s[n] = mfma16(a, qf[kk], s[n]); } }
            const bool needmask = FOX && (64 * kt + 63 > q0w);
            float mx = -INFINITY;
#pragma unroll
            for (int n = 0; n < 4; ++n) { f32x4 ck4 = {0.f, 0.f, 0.f, 0.f}; if (FOX) ck4 = *(const LAS f32x4*)(ckb + (16 * n + 4 * g) * 4);
#pragma unroll
                for (int r = 0; r < 4; ++r) { float v = s[n][r] * qscale; if (FOX) v += cq - ck4[r];
                    if (needmask && (64 * kt + 16 * n + 4 * g + r > q0w + i)) v = -INFINITY;
                    s[n][r] = v; mx = fmaxf(mx, v); } }
            mx = fmaxf(mx, __shfl_xor(mx, 16)); mx = fmaxf(mx, __shfl_xor(mx, 32));
            const float mnew = fmaxf(mrun, mx), alpha = __builtin_amdgcn_exp2f(mrun - mnew); mrun = mnew;
            float psum = 0.f;
#pragma unroll
            for (int n = 0; n < 4; ++n)
#pragma unroll
                for (int r = 0; r < 4; ++r) { const float p = __builtin_amdgcn_exp2f(s[n][r] - mnew); s[n][r] = p; psum += p; }
            lsum = lsum * alpha + psum;
#pragma unroll
            for (int m = 0; m < 4; ++m) o[m] = o[m] * alpha;
            bf16x8 pf[2];
#pragma unroll
            for (int kk = 0; kk < 2; ++kk) { const unsigned a0 = pk2(s[2 * kk][0], s[2 * kk][1]), a1 = pk2(s[2 * kk][2], s[2 * kk][3]), a2 = pk2(s[2 * kk + 1][0], s[2 * kk + 1][1]), a3 = pk2(s[2 * kk + 1][2], s[2 * kk + 1][3]);
                pf[kk] = __builtin_bit_cast(bf16x8, (u32x4){a0, a1, a2, a3}); }
#pragma unroll
            for (int m = 0; m < 4; ++m)
#pragma unroll
                for (int kk = 0; kk < 2; ++kk) { const bf16x8 a = tr_frag(vb, VLD, 32 * kk + 4 * g, 32 * kk + 16 + 4 * g, 16 * m, lane); o[m] = mfma16(a, pf[kk], o[m]); }
        }
        if (kt + 1 < nt) AT_STORE(cur ^ 1);
        __syncthreads();
    }
#undef AT_LOAD
#undef AT_STORE
    lsum += __shfl_xor(lsum, 16); lsum += __shfl_xor(lsum, 32);
    const float inv = 1.0f / lsum; bf16_t* orow = Og + (size_t)(row0 + q0w + i) * DM;
#pragma unroll
    for (int m = 0; m < 4; ++m) { u32x2 ov; ov.x = pk2(o[m][0] * inv, o[m][1] * inv); ov.y = pk2(o[m][2] * inv, o[m][3] * inv); *(u32x2*)(orow + 16 * m + 4 * g) = ov; }
}

__device__ __forceinline__ void p3_ssd_unit(Ctx& C, int l, int cu) {
    const int b = cu >> 5, c = cu & 31, t0 = cu * 64; const int tid = C.tid, lane = C.lane, w = C.wave, g = lane >> 4, i = lane & 15;
    const bf16_t* PM = WSP(bf16_t, WS_PM); bf16_t* Y = WSP(bf16_t, WS_S1);
    ssd_fill(C, l, cu);
    const LAS float* AC = (const LAS float*)(C.lds + ACUM_OFF); const LAS float* DT = (const LAS float*)(C.lds + DT_OFF);
    { f32x4 st[8];
#pragma unroll
      for (int k = 0; k < 8; ++k) st[k] = (f32x4){0.f, 0.f, 0.f, 0.f};
      const float* STG = WSP(float, WS_ST); const float* CD = WSP(float, WS_CDEC);
#pragma unroll 1
      for (int cp = 0; cp < c; ++cp) { const int cuu = b * 32 + cp; const f32x4 dec4 = *(const f32x4*)(CD + cuu * 4);
#pragma unroll
          for (int k = 0; k < 8; ++k) { const int f = tid + NTHR * k; const f32x4 v = *(const f32x4*)(STG + (size_t)cuu * 16384 + (size_t)f * 4); const float dec = dec4[k >> 1]; st[k] = st[k] * dec + v; } }
#pragma unroll
      for (int k = 0; k < 8; ++k) { const int f = tid + NTHR * k, h = f >> 10, rem = f & 1023, p = rem >> 4, n = (rem & 15) * 4;
          u32x2 o; o.x = pk2(st[k][0], st[k][1]); o.y = pk2(st[k][2], st[k][3]); *(LAS u32x2*)(C.lds + PV_OFF + ((h * 64 + p) * ML_LD + n) * 2) = o; } }
    __syncthreads();
    const int h = w >> 1, rh = w & 1, grp = h >> 1; lptr MLw = C.lds + ML_OFF + w * (32 * ML_LD * 2);
    const float Dh = C.a->in[10][l * 4 + h];
#pragma unroll 1
    for (int mbl = 0; mbl < 2; ++mbl) { const int mb = 2 * rh + mbl;
#pragma unroll
        for (int nb = 0; nb < 4; ++nb) { f32x4 acc = {0.f, 0.f, 0.f, 0.f};
#pragma unroll
            for (int kk = 0; kk < 2; ++kk) { const bf16x8 a = *(const LAS bf16x8*)(C.lds + CL_OFF + ((16 * mb + i) * BC_LD + 64 * grp + 32 * kk + 8 * g) * 2);
                const bf16x8 bq = *(const LAS bf16x8*)(C.lds + BL_OFF + ((16 * nb + i) * BC_LD + 64 * grp + 32 * kk + 8 * g) * 2); acc = mfma16(a, bq, acc); }
            const int s = 16 * nb + i; const float as = AC[s * 4 + h], ds = DT[s * 4 + h];
#pragma unroll
            for (int r = 0; r < 4; ++r) { const int lr = 16 * mb + 4 * g + r; const float v = (s <= lr) ? acc[r] * __expf(AC[lr * 4 + h] - as) * ds : 0.f;
                *(LAS unsigned short*)(MLw + ((16 * mbl + 4 * g + r) * ML_LD + s) * 2) = (unsigned short)f2bf(v); } }
        LDS_WAIT(); asm volatile("" ::: "memory");
        f32x4 ad[4], ao[4];
#pragma unroll
        for (int nb = 0; nb < 4; ++nb) { ad[nb] = (f32x4){0.f, 0.f, 0.f, 0.f}; ao[nb] = (f32x4){0.f, 0.f, 0.f, 0.f};
#pragma unroll
            for (int kk = 0; kk < 2; ++kk) {
                const bf16x8 a = *(const LAS bf16x8*)(MLw + ((16 * mbl + i) * ML_LD + 32 * kk + 8 * g) * 2);
                const bf16x8 bx = tr_frag(C.lds + XS_OFF, XS_LD, 32 * kk + 8 * g, 32 * kk + 8 * g + 4, 64 * h + 16 * nb, lane);
                ad[nb] = mfma16(a, bx, ad[nb]);
                const bf16x8 a2 = *(const LAS bf16x8*)(C.lds + CL_OFF + ((16 * mb + i) * BC_LD + 64 * grp + 32 * kk + 8 * g) * 2);
                const bf16x8 b2 = *(const LAS bf16x8*)(C.lds + PV_OFF + ((h * 64 + 16 * nb + i) * ML_LD + 32 * kk + 8 * g) * 2);
                ao[nb] = mfma16(a2, b2, ao[nb]); } }
        LDS_WAIT(); asm volatile("" ::: "memory");
        float ssq[4] = {0.f, 0.f, 0.f, 0.f};
#pragma unroll
        for (int nb = 0; nb < 4; ++nb)
#pragma unroll
            for (int r = 0; r < 4; ++r) { const int lr = 16 * mb + 4 * g + r; const int ch = 64 * h + 16 * nb + i;
                const float xs = bf2f(*(const LAS unsigned short*)(C.lds + XS_OFF + (lr * XS_LD + ch) * 2));
                float y = ad[nb][r] + __expf(AC[lr * 4 + h]) * ao[nb][r] + Dh * xs;
                const float z = bf2f(PM[(size_t)(t0 + lr) * NPROJ + C_Z + ch]); y *= silu_f(z);
                ssq[r] += y * y;
                *(LAS unsigned short*)(MLw + ((16 * mbl + 4 * g + r) * ML_LD + 16 * nb + i) * 2) = (unsigned short)f2bf(y); }
#pragma unroll
        for (int r = 0; r < 4; ++r) { float q = ssq[r]; q += __shfl_xor(q, 1); q += __shfl_xor(q, 2); q += __shfl_xor(q, 4); q += __shfl_xor(q, 8);
            if (i == 0) ((LAS float*)(C.lds + SSQ_OFF))[(16 * mb + 4 * g + r) * 4 + h] = q; } }
    __syncthreads();
    { const float* gn = C.a->in[11] + l * 256;
      const int lr_l = lane >> 1, hf = lane & 1, lr = 32 * rh + lr_l; const f32x4 q4 = *(const LAS f32x4*)(C.lds + SSQ_OFF + lr * 16);
      const float rs = 1.0f / sqrtf(((q4.x + q4.y) + (q4.z + q4.w)) * (1.0f / 256.0f) + RMS_EPS);
#pragma unroll
      for (int k = 0; k < 4; ++k) { const int ch = 64 * h + 32 * hf + 8 * k; const u32x4 yv = *(const LAS u32x4*)(MLw + (lr_l * ML_LD + 32 * hf + 8 * k) * 2);
          u32x4 o; o.x = pk2(bflo(yv.x) * rs * gn[ch + 0], bfhi(yv.x) * rs * gn[ch + 1]); o.y = pk2(bflo(yv.y) * rs * gn[ch + 2], bfhi(yv.y) * rs * gn[ch + 3]);
          o.z = pk2(bflo(yv.z) * rs * gn[ch + 4], bfhi(yv.z) * rs * gn[ch + 5]); o.w = pk2(bflo(yv.w) * rs * gn[ch + 6], bfhi(yv.w) * rs * gn[ch + 7]);
          *(u32x4*)(Y + (size_t)(t0 + lr) * DM + 512 + ch) = o; } }
    __syncthreads();
}

__device__ __forceinline__ void moe_tables(Ctx& C, int l) {
    LAS int* cnt = (LAS int*)(C.lds + LDS_SCR + SCR_CNT); LAS int* tb = (LAS int*)(C.lds + LDS_SCR + SCR_TBASE); LAS int* te = (LAS int*)(C.lds + LDS_SCR + SCR_TILEE); LAS int* ntp = (LAS int*)(C.lds + LDS_SCR + SCR_NT);
    if (C.tid < 32) cnt[C.tid] = (int)__hip_atomic_load(WSP(unsigned, WS_CTL) + CW_CNT + l * 32 + C.tid, __ATOMIC_RELAXED, __HIP_MEMORY_SCOPE_AGENT);
    __syncthreads();
    if (C.tid == 0) { int a = 0; for (int e = 0; e < 32; ++e) { tb[e] = a; a += (cnt[e] + 255) >> 8; } tb[32] = a; *ntp = a; }
    __syncthreads();
    if (C.tid < 160) { int e = 0; for (int k = 1; k < 32; ++k) if (tb[k] <= C.tid) e = k; te[C.tid] = e; }
    __syncthreads();
}
template <int NPN> struct MoeOrder {
    static constexpr int npn = NPN; int G, c; const LAS int* cnt; const LAS int* tb; const LAS int* te; int ntile; const int* rowl;
    __device__ __forceinline__ bool next(int i, pg8::Unit& u) const {
        const int L = i * G + c; if (L >= ntile * npn) return false;
        const int ti = L / npn, pnl = L % npn; const int e = __builtin_amdgcn_readfirstlane(te[ti]);
        u.pm = ti; u.pn = e * npn + pnl; u.e = e; u.r0 = (ti - __builtin_amdgcn_readfirstlane(tb[e])) * 256; u.ne = __builtin_amdgcn_readfirstlane(cnt[e]); return true;
    }
    __device__ __forceinline__ int arow(const pg8::Unit& u, int r) const { const int rr = u.r0 + r; return rr < u.ne ? rowl[(size_t)u.e * T + rr] : 0; }
    __device__ __forceinline__ void a_ready(const pg8::Unit&) const {}
    __device__ __forceinline__ void done(const pg8::Unit&) const {}
};

__device__ __forceinline__ TrItem p5_item(Ctx& C, int l, int it, int lane) {
    const int e = it / 384, r = it % 384, c4 = (lane & 7) * 4; TrItem t;
    if (r < 256) { const int kb = r >> 4, nb = r & 15, n = 32 * nb, pn = n >> 8, bj = (n >> 7) & 1, ff = (n & 127) + c4;
        t.W = (bj ? C.a->in[23] : C.a->in[22]) + (size_t)(l * 32 + e) * 1024 * 256; t.ldw = 256; t.scol4 = 128 * pn + ff; t.k0 = 64 * kb; t.gk = C.a->in[17] + l * 1024;
        t.dst = WSP(bf16_t, WS_BGU) + (size_t)e * 512 * 1024 + (size_t)(32 * nb) * 1024 + 64 * kb; t.K = 1024; }
    else { const int r2 = r - 256, kb = r2 >> 5, nb = r2 & 31;
        t.W = C.a->in[24] + (size_t)(l * 32 + e) * 256 * 1024; t.ldw = 1024; t.scol4 = 32 * nb + c4; t.k0 = 64 * kb; t.gk = nullptr;
        t.dst = WSP(bf16_t, WS_BD) + (size_t)e * 1024 * 256 + (size_t)(32 * nb) * 256 + 64 * kb; t.K = 256; }
    return t;
}
__device__ __forceinline__ void p5_router(Ctx& C, int l, int en) {
    const int gw = C.bx * NWAVES + C.wave, NGW = C.G * NWAVES, lane = C.lane;
    if (!(en & 16)) return;
    { LAS float* scr = (LAS float*)(C.lds + C.wave * 8704); f32x4 cur[8], nx[8]; int it = gw;
      if (it < 32 * 384) { TrItem t = p5_item(C, l, it, lane); tr_load(t, cur, lane); }
#pragma unroll 1
      for (; it < 32 * 384; it += NGW) { const bool more = it + NGW < 32 * 384;
          if (more) { TrItem tn = p5_item(C, l, it + NGW, lane); tr_load(tn, nx, lane); }
          TrItem t = p5_item(C, l, it, lane); tr_store(t, cur, scr, lane);
#pragma unroll
          for (int i = 0; i < 8; ++i) cur[i] = nx[i]; } }
    __syncthreads();
    LAS float* WR = (LAS float*)C.lds; const float* gain = C.a->in[17] + l * 1024;
    for (int idx = C.tid; idx < 36 * 1024; idx += NTHR) { const int cc = idx >> 10, k = idx & 1023;
        WR[idx] = gain[k] * (cc < 4 ? C.a->in[18][(size_t)l * 4096 + k * 4 + cc] : C.a->in[20][(size_t)l * 32768 + k * 32 + (cc - 4)]); }
    LAS int* cntL = (LAS int*)(C.lds + LDS_SCR + SCR_CNT); LAS int* baseL = (LAS int*)(C.lds + LDS_SCR + SCR_TBASE);
    const float* X1 = WSP(float, WS_X1); bf16_t* HB = WSP(bf16_t, WS_S1);
    unsigned* CNT = WSP(unsigned, WS_CTL) + CW_CNT + l * 32; int* ROWL = WSP(int, WS_ROWL); int* TE = WSP(int, WS_TOKE); int* TP = WSP(int, WS_TOKP); float* TW = WSP(float, WS_TOKW);
    for (int chunk = C.bx; chunk < T / 64; chunk += C.G) {
        if (C.tid < 32) cntL[C.tid] = 0;
        __syncthreads();
        const int tb0 = chunk * 64 + C.wave * 8; int mE0 = 0, mE1 = 0; float mW0 = 0.f, mW1 = 0.f;
        f32x4 xn[4];
        { const f32x4* xr = (const f32x4*)(X1 + (size_t)tb0 * DM) + lane;
#pragma unroll
          for (int j = 0; j < 4; ++j) xn[j] = xr[64 * j]; }
#pragma unroll 1
        for (int jt = 0; jt < 8; ++jt) { const int t = tb0 + jt;
            f32x4 xv[4];
#pragma unroll
            for (int j = 0; j < 4; ++j) xv[j] = xn[j];
            if (jt + 1 < 8) { const f32x4* xr = (const f32x4*)(X1 + (size_t)(t + 1) * DM) + lane;
#pragma unroll
                for (int j = 0; j < 4; ++j) xn[j] = xr[64 * j]; }
            float sq = 0.f;
#pragma unroll
            for (int j = 0; j < 4; ++j) sq += (xv[j].x * xv[j].x + xv[j].y * xv[j].y) + (xv[j].z * xv[j].z + xv[j].w * xv[j].w);
            const float rstd = 1.0f / sqrtf(wave_sum(sq) * (1.0f / DM) + RMS_EPS);
            { u32x2* o8 = (u32x2*)(HB + (size_t)t * DM) + lane;
#pragma unroll
              for (int j = 0; j < 4; ++j) { u32x2 wv; wv.x = pk2(xv[j].x * rstd, xv[j].y * rstd); wv.y = pk2(xv[j].z * rstd, xv[j].w * rstd); o8[64 * j] = wv; } }
            float lg[4];
#pragma unroll
            for (int cc = 0; cc < 4; ++cc) { float p = 0.f;
#pragma unroll
                for (int j = 0; j < 4; ++j) { const f32x4 wv = *(const LAS f32x4*)(WR + cc * 1024 + 256 * j + 4 * lane); p += (xv[j].x * wv.x + xv[j].y * wv.y) + (xv[j].z * wv.z + xv[j].w * wv.w); }
                lg[cc] = wave_sum(p) * rstd + C.a->in[19][l * 4 + cc]; }
            int gi = 0; float gm = lg[0];
#pragma unroll
            for (int cc = 1; cc < 4; ++cc) if (lg[cc] > gm) { gm = lg[cc]; gi = cc; }
            float gs = 0.f;
#pragma unroll
            for (int cc = 0; cc < 4; ++cc) gs += __expf(lg[cc] - gm);
            const float gwt = 1.0f / gs;
            gi = __builtin_amdgcn_readfirstlane(gi);
            float le[8];
#pragma unroll
            for (int e = 0; e < 8; ++e) { float p = 0.f; const LAS float* wrow = WR + (4 + 8 * gi + e) * 1024;
#pragma unroll
                for (int j = 0; j < 4; ++j) { const f32x4 wv = *(const LAS f32x4*)(wrow + 256 * j + 4 * lane); p += (xv[j].x * wv.x + xv[j].y * wv.y) + (xv[j].z * wv.z + xv[j].w * wv.w); }
                le[e] = wave_sum(p) * rstd + C.a->in[21][l * 32 + 8 * gi + e]; }
            int e0 = 0; float m0 = le[0];
#pragma unroll
            for (int e = 1; e < 8; ++e) if (le[e] > m0) { m0 = le[e]; e0 = e; }
            int e1 = -1; float m1 = -INFINITY;
#pragma unroll
            for (int e = 0; e < 8; ++e) if (e != e0 && le[e] > m1) { m1 = le[e]; e1 = e; }
            const float w0 = 1.0f / (1.0f + __expf(m1 - m0)), w1 = 1.0f - w0;
            if (lane == jt) { mE0 = 8 * gi + e0; mE1 = 8 * gi + e1; mW0 = gwt * w0; mW1 = gwt * w1; }
        }
        int r0 = 0, r1 = 0;
        if (lane < 8) { r0 = __hip_atomic_fetch_add(cntL + mE0, 1, __ATOMIC_RELAXED, __HIP_MEMORY_SCOPE_WORKGROUP); r1 = __hip_atomic_fetch_add(cntL + mE1, 1, __ATOMIC_RELAXED, __HIP_MEMORY_SCOPE_WORKGROUP); }
        __syncthreads();
        if (C.tid < 32) { const int n = cntL[C.tid]; baseL[C.tid] = n ? (int)__hip_atomic_fetch_add(CNT + C.tid, (unsigned)n, __ATOMIC_RELAXED, __HIP_MEMORY_SCOPE_AGENT) : 0; }
        __syncthreads();
        if (lane < 8) { const int t = tb0 + lane; const int p0 = baseL[mE0] + r0, p1 = baseL[mE1] + r1;
            ROWL[(size_t)mE0 * T + p0] = t; ROWL[(size_t)mE1 * T + p1] = t;
            TE[t * 2] = mE0; TE[t * 2 + 1] = mE1; TP[t * 2] = p0; TP[t * 2 + 1] = p1; TW[t * 2] = mW0; TW[t * 2 + 1] = mW1; }
        __syncthreads();
    }
}

__device__ __forceinline__ void p7_combine(Ctx& C, int l, int en, bool last_layer) {
    const int gw = C.bx * NWAVES + C.wave, NGW = C.G * NWAVES, lane = C.lane;
    const LAS int* tb = (const LAS int*)(C.lds + LDS_SCR + SCR_TBASE);
    const bool moe = (en & 16) != 0;
    if (moe) moe_tables(C, l);
    float* X1 = WSP(float, WS_X1); const bf16_t* YS = WSP(bf16_t, WS_PM); const int* TE = WSP(int, WS_TOKE); const int* TP = WSP(int, WS_TOKP); const float* TW = WSP(float, WS_TOKW);
    for (int tbase = gw; tbase < T; tbase += 64 * NGW) {
        int ms0 = 0, ms1 = 0; float mw0 = 0.f, mw1 = 0.f;
        { const int t = tbase + lane * NGW;
          if (moe && t < T) { const int e0 = TE[t * 2], e1 = TE[t * 2 + 1]; ms0 = tb[e0] * 256 + TP[t * 2]; ms1 = tb[e1] * 256 + TP[t * 2 + 1]; mw0 = TW[t * 2]; mw1 = TW[t * 2 + 1]; } }
#pragma unroll 1
        for (int j0 = 0; j0 < 64; j0 += 2) { const int ta = tbase + j0 * NGW; if (ta >= T) break;
            const int tb2 = ta + NGW; const bool two = tb2 < T; const int tbb = two ? tb2 : ta;
            f32x4* xra = (f32x4*)(X1 + (size_t)ta * DM) + lane; f32x4* xrb = (f32x4*)(X1 + (size_t)tbb * DM) + lane; f32x4 xa[4], xb[4];
#pragma unroll
            for (int j = 0; j < 4; ++j) { xa[j] = xra[64 * j]; xb[j] = xrb[64 * j]; }
            if (moe) {
                const int sa0 = __builtin_amdgcn_readlane(ms0, j0), sa1 = __builtin_amdgcn_readlane(ms1, j0), sb0 = __builtin_amdgcn_readlane(ms0, j0 + 1), sb1 = __builtin_amdgcn_readlane(ms1, j0 + 1);
                const float wa0 = __builtin_bit_cast(float, __builtin_amdgcn_readlane(__builtin_bit_cast(int, mw0), j0)), wa1 = __builtin_bit_cast(float, __builtin_amdgcn_readlane(__builtin_bit_cast(int, mw1), j0));
                const float wb0 = __builtin_bit_cast(float, __builtin_amdgcn_readlane(__builtin_bit_cast(int, mw0), j0 + 1)), wb1 = __builtin_bit_cast(float, __builtin_amdgcn_readlane(__builtin_bit_cast(int, mw1), j0 + 1));
                const u32x2* ya0 = (const u32x2*)(YS + (size_t)sa0 * DM) + lane; const u32x2* ya1 = (const u32x2*)(YS + (size_t)sa1 * DM) + lane;
                const u32x2* yb0 = (const u32x2*)(YS + (size_t)sb0 * DM) + lane; const u32x2* yb1 = (const u32x2*)(YS + (size_t)sb1 * DM) + lane;
                u32x2 va0[4], va1[4], vb0[4], vb1[4];
#pragma unroll
                for (int j = 0; j < 4; ++j) { va0[j] = ya0[64 * j]; va1[j] = ya1[64 * j]; vb0[j] = yb0[64 * j]; vb1[j] = yb1[64 * j]; }
#pragma unroll
                for (int j = 0; j < 4; ++j) {
                    xa[j].x += wa0 * bflo(va0[j].x) + wa1 * bflo(va1[j].x); xa[j].y += wa0 * bfhi(va0[j].x) + wa1 * bfhi(va1[j].x); xa[j].z += wa0 * bflo(va0[j].y) + wa1 * bflo(va1[j].y); xa[j].w += wa0 * bfhi(va0[j].y) + wa1 * bfhi(va1[j].y);
                    xb[j].x += wb0 * bflo(vb0[j].x) + wb1 * bflo(vb1[j].x); xb[j].y += wb0 * bfhi(vb0[j].x) + wb1 * bfhi(vb1[j].x); xb[j].z += wb0 * bflo(vb0[j].y) + wb1 * bflo(vb1[j].y); xb[j].w += wb0 * bfhi(vb0[j].y) + wb1 * bfhi(vb1[j].y); } }
            float sa = 0.f, sb = 0.f;
#pragma unroll
            for (int j = 0; j < 4; ++j) { sa += (xa[j].x * xa[j].x + xa[j].y * xa[j].y) + (xa[j].z * xa[j].z + xa[j].w * xa[j].w); sb += (xb[j].x * xb[j].x + xb[j].y * xb[j].y) + (xb[j].z * xb[j].z + xb[j].w * xb[j].w); }
            const float ra = 1.0f / sqrtf(wave_sum(sa) * (1.0f / DM) + RMS_EPS), rb = 1.0f / sqrtf(wave_sum(sb) * (1.0f / DM) + RMS_EPS);
            if (last_layer) { f32x4* oa = (f32x4*)(C.out + (size_t)ta * DM) + lane; f32x4* ob = (f32x4*)(C.out + (size_t)tbb * DM) + lane; const f32x4* gn = (const f32x4*)C.a->in[25] + lane;
#pragma unroll
                for (int j = 0; j < 4; ++j) { const f32x4 g4 = gn[64 * j]; oa[64 * j] = xa[j] * ra * g4; if (two) ob[64 * j] = xb[j] * rb * g4; } }
            else {
#pragma unroll
                for (int j = 0; j < 4; ++j) { xra[64 * j] = xa[j]; if (two) xrb[64 * j] = xb[j]; }
                if (lane == 0) { WSP(float, WS_RSTD)[ta] = ra; if (two) WSP(float, WS_RSTD)[tbb] = rb; }
                u32x2* oa = (u32x2*)(WSP(bf16_t, WS_S1) + (size_t)ta * DM) + lane; u32x2* ob = (u32x2*)(WSP(bf16_t, WS_S1) + (size_t)tbb * DM) + lane;
#pragma unroll
                for (int j = 0; j < 4; ++j) { u32x2 wv; wv.x = pk2(xa[j].x, xa[j].y); wv.y = pk2(xa[j].z, xa[j].w); oa[64 * j] = wv;
                    if (two) { u32x2 w2; w2.x = pk2(xb[j].x, xb[j].y); w2.y = pk2(xb[j].z, xb[j].w); ob[64 * j] = w2; } } }
        }
    }
}

#ifndef PHMASK
#define PHMASK 0x1ff
#endif
#define IN(k) (((PHMASK >> ((k) == 0 ? 0 : (((k) - 1) % 8) + 1)) & 1) && lo <= (k) && (k) < hi && ((k) == 0 || ((((k) - 1) % 8) + 1 >= PLO && (((k) - 1) % 8) + 1 < PHI)))
#define SEAM(k) do { if (IN(k) && IN((k) + 1)) xcd_barrier(bar); } while (0)
#ifndef REP_PHASE
#define REP_PHASE -1
#endif
#define PH_BEGIN(k) if (IN(k)) {
#define PH_END }
template <int l, int PLO = 1, int PHI = 9>
__device__ __forceinline__ void layer_phases(Ctx& C, const XcdBarrier& bar, int lo_, int hi_) {
#if MK_SPLIT
    const int lo = lo_, hi = hi_;
#else
    constexpr int lo = 0, hi = NPHASE;
#endif
        const int en = l ? EN1 : EN0; const int pb = 8 * l; const bool lastl = (l == (EN_L1 ? 1 : 0));
        LAUNDER();
        PH_BEGIN(pb + 1)
            pg8::Gemm gm{WSP(bf16_t, WS_S1), WSP(bf16_t, WS_WIN) + (size_t)l * NPROJ * 1024, T, NPROJ, DM}; pg8::StaticOrder S; S.init(T, NPROJ, C.G, C.bx);
            pg8::EpiInProj E{WSP(bf16_t, WS_PM), NPROJ, WSP(float, WS_RSTD), WSP(float, WS_FD), 10};
            pg8::gemm_phase<pg8::EpiInProj, pg8::StaticOrder, true, true>(C.lds, gm, S, E);
        PH_END
        SEAM(pb + 1);
        LAUNDER();
        PH_BEGIN(pb + 2) for (int cu = C.bx; cu < NCHK; cu += C.G) p2_unit(C, l, cu, en); PH_END
        SEAM(pb + 2);
        LAUNDER();
        PH_BEGIN(pb + 3)
            bf16_t* Y = WSP(bf16_t, WS_S1); const bf16_t* PM = WSP(bf16_t, WS_PM);
            for (int pu = C.bx; pu < 256; pu += C.G) { const int bh = pu >> 3, s = pu & 7, b = bh >> 2, h = bh & 3, row0 = b * SEQ;
                if (en & 2) {
                    attn_unit<64, true>(C, PM + C_FQ + 64 * h, NPROJ, PM + C_FK + 64 * h, NPROJ, PM + C_FV + 64 * h, NPROJ, Y + 256 + 64 * h, WSP(float, WS_CUM) + h, row0, 15 - s, 0.125f * LOG2E);
                    attn_unit<64, true>(C, PM + C_FQ + 64 * h, NPROJ, PM + C_FK + 64 * h, NPROJ, PM + C_FV + 64 * h, NPROJ, Y + 256 + 64 * h, WSP(float, WS_CUM) + h, row0, s, 0.125f * LOG2E); }
                if (en & 8) {
                    attn_unit<96, false>(C, WSP(bf16_t, WS_QM) + 96 * h, 384, WSP(bf16_t, WS_KM) + 96 * h, 384, WSP(bf16_t, WS_VM) + 64 * h, 256, Y + 768 + 64 * h, nullptr, row0, 15 - s, 0.10206207261596575f * LOG2E);
                    attn_unit<96, false>(C, WSP(bf16_t, WS_QM) + 96 * h, 384, WSP(bf16_t, WS_KM) + 96 * h, 384, WSP(bf16_t, WS_VM) + 64 * h, 256, Y + 768 + 64 * h, nullptr, row0, s, 0.10206207261596575f * LOG2E); } }
            if (en & 4) { for (int cu = C.bx; cu < NCHK; cu += C.G) p3_ssd_unit(C, l, cu); }
        PH_END
        SEAM(pb + 3);
        LAUNDER();
        PH_BEGIN(pb + 4)
            pg8::Gemm gm{WSP(bf16_t, WS_S1), WSP(bf16_t, WS_WOUT) + (size_t)l * 1024 * 1024, T, DM, DM}; pg8::StaticOrder S; S.init(T, DM, C.G, C.bx);
            pg8::EpiResid E{l == 0 ? C.a->in[0] : WSP(float, WS_X1), WSP(float, WS_X1), DM};
            pg8::gemm_phase<pg8::EpiResid, pg8::StaticOrder, true, true>(C.lds, gm, S, E);
        PH_END
        SEAM(pb + 4);
        LAUNDER();
        PH_BEGIN(pb + 5) p5_router(C, l, en); PH_END
        SEAM(pb + 5);
        LAUNDER();
        PH_BEGIN(pb + 6) if (en & 16) {
            moe_tables(C, l);
            MoeOrder<2> S{C.G, C.bx, (const LAS int*)(C.lds + LDS_SCR + SCR_CNT), (const LAS int*)(C.lds + LDS_SCR + SCR_TBASE), (const LAS int*)(C.lds + LDS_SCR + SCR_TILEE),
                       __builtin_amdgcn_readfirstlane(*(const LAS int*)(C.lds + LDS_SCR + SCR_NT)), WSP(int, WS_ROWL)};
            pg8::Gemm gm{WSP(bf16_t, WS_S1), WSP(bf16_t, WS_BGU), T, 512, DM};
            pg8::EpiGateUp E{WSP(bf16_t, WS_HACT), 256};
            pg8::gemm_phase_gather<pg8::EpiGateUp, MoeOrder<2>, true>(C.lds, gm, S, E); } PH_END
        SEAM(pb + 6);
        LAUNDER();
        PH_BEGIN(pb + 7) if (en & 16) {
            moe_tables(C, l);
            MoeOrder<4> S{C.G, C.bx, (const LAS int*)(C.lds + LDS_SCR + SCR_CNT), (const LAS int*)(C.lds + LDS_SCR + SCR_TBASE), (const LAS int*)(C.lds + LDS_SCR + SCR_TILEE),
                       __builtin_amdgcn_readfirstlane(*(const LAS int*)(C.lds + LDS_SCR + SCR_NT)), WSP(int, WS_ROWL)};
            int kdim = 256; asm volatile("" : "+s"(kdim));
            pg8::Gemm gm{WSP(bf16_t, WS_HACT), WSP(bf16_t, WS_BD), 160 * 256, 1024, kdim};
            pg8::EpiSlotY E{WSP(bf16_t, WS_PM), DM};
            pg8::gemm_phase<pg8::EpiSlotY, MoeOrder<4>, true, true>(C.lds, gm, S, E); } PH_END
        SEAM(pb + 7);
        LAUNDER();
        PH_BEGIN(pb + 8) p7_combine(C, l, en, lastl); PH_END
        if (!lastl && IN(pb + 8)) xcd_barrier(bar);
    }
__global__ void __launch_bounds__(NTHR, 2) hcc_fwd(Args args) {
    extern __shared__ __attribute__((aligned(16))) unsigned char lds_raw[];
    Ctx C; C.lds = (lptr)lds_raw; C.tid = threadIdx.x; C.lane = C.tid & 63; C.wave = __builtin_amdgcn_readfirstlane(C.tid >> 6); C.G = gridDim.x; C.bx = blockIdx.x;
    C.a = (const __attribute__((address_space(4))) Args*)__builtin_amdgcn_kernarg_segment_ptr(); C.out = C.a->out; C.ws = C.a->ws;
    volatile LAS unsigned* MISC = (volatile LAS unsigned*)(C.lds + LDS_CTL);
    if (C.tid < 64) MISC[C.tid] = 0u;
    __syncthreads();
    XcdBarrier bar; bar.bar = WSP(unsigned, WS_CTL) + CW_BAR; bar.x = 0; bar.st = nullptr;
    if (!MK_SPLIT) bar = xcd_barrier_post(WSP(unsigned, WS_CTL) + CW_BAR, MISC + 8);
#if MK_SPLIT
    const int lo = C.a->ph_lo, hi = C.a->ph_hi;
#else
    constexpr int lo = 0, hi = NPHASE;
#endif

    constexpr int PLO = 1, PHI = 9;
    PH_BEGIN(0) p0_prologue(C); PH_END
#if REP_PHASE == 0
    xcd_barrier(bar); p0_prologue(C);
#endif
    SEAM(0);
#if REP_PHASE >= 1 && REP_PHASE <= 8
    layer_phases<0, 1, REP_PHASE + 1>(C, bar, lo, hi); xcd_barrier(bar); layer_phases<0, REP_PHASE, 9>(C, bar, lo, hi);
#else
    layer_phases<0>(C, bar, lo, hi);
#endif
    if (EN_L1) layer_phases<1>(C, bar, lo, hi);
#undef IN
#undef SEAM
}

extern "C" void kernel_launch(void* const* d_in, const int* in_sizes, int n_in, void* d_out, int out_size, void* d_ws, size_t ws_size, hipStream_t stream) {
    static int grid = 0;
    if (grid == 0) {
        if (n_in != 26 || in_sizes[0] != T * DM || out_size != T * DM || ws_size < WS_NEED) { fprintf(stderr, "kernel_launch: unexpected shapes (n_in %d, in0 %d, out %d, ws %zu)\n", n_in, n_in > 0 ? in_sizes[0] : -1, out_size, ws_size); grid = -1; return; }
        int dev = 0, cus = 0, per_cu = 0;
        if (hipGetDevice(&dev) != hipSuccess || hipDeviceGetAttribute(&cus, hipDeviceAttributeMultiprocessorCount, dev) != hipSuccess) { grid = -1; return; }
        if (hipFuncSetAttribute((const void*)hcc_fwd, hipFuncAttributeMaxDynamicSharedMemorySize, LDS_BYTES) != hipSuccess) { fprintf(stderr, "kernel_launch: hipFuncSetAttribute failed\n"); grid = -1; return; }
        if (hipOccupancyMaxActiveBlocksPerMultiprocessor(&per_cu, (const void*)hcc_fwd, NTHR, LDS_BYTES) != hipSuccess || per_cu < 1) { fprintf(stderr, "kernel_launch: occupancy query says %d\n", per_cu); }
        (void)hipGetLastError();
        grid = cus;
    }
    if (grid < 0) return;
    if (hipMemsetAsync((char*)d_ws + WS_CTL, 0, CTL_ZERO_BYTES, stream) != hipSuccess) return;
    Args a{};
    for (int i = 0; i < 26; ++i) a.in[i] = (const float*)d_in[i];
    a.out = (float*)d_out; a.ws = (unsigned char*)d_ws;
#if MK_SPLIT
    for (int p = 0; p < NPHASE; ++p) { a.ph_lo = p; a.ph_hi = p + 1; hipLaunchKernelGGL(hcc_fwd, dim3(grid), dim3(NTHR), LDS_BYTES, stream, a); }
#else
    a.ph_lo = 0; a.ph_hi = NPHASE; hipLaunchKernelGGL(hcc_fwd, dim3(grid), dim3(NTHR), LDS_BYTES, stream, a);
#endif
}
```

```cpp
#include <hip/hip_runtime.h>
#include <cstdio>
#include <cstdint>
#include <cmath>
#define GAS __attribute__((address_space(1)))
#define LAS __attribute__((address_space(3)))
namespace pg8 {
#define PG8_LAS __attribute__((address_space(3)))
typedef unsigned short bf16_t;
typedef short bf16x8 __attribute__((ext_vector_type(8)));
typedef float f32x4 __attribute__((ext_vector_type(4)));
typedef unsigned u32x4 __attribute__((ext_vector_type(4)));
constexpr int BM = 256, BK = 64, HALF = 128, HTB = HALF * BK * 2  , STAGE_BYTES = 8 * HTB, NXCD = 8, WGM = 8;

__host__ __device__ __forceinline__ int lds_byte(int r, int c) { const int st = (r >> 4) * 2 + (c >> 5), rr = r & 15, cc = c & 31, ob = rr * 64 + cc * 2; return st * 1024 + (ob ^ (((ob >> 9) & 1) << 5)); }
__host__ __device__ __forceinline__ void stage_rc(int b, int& R, int& C) { const int st = b / 1024, sb = b % 1024, swz = sb ^ (((sb >> 9) & 1) << 5); R = (st >> 1) * 16 + swz / 64; C = (st & 1) * 32 + (swz % 64) / 2; }
__host__ __device__ __forceinline__ int perm32(int rho) { const int n = rho >> 4, i = rho & 15; return 8 * (i >> 2) + 4 * n + (i & 3); }

struct Unit { int pm, pn, e, r0, ne; };
struct Gemm { const bf16_t* A; const bf16_t* Bt; int M, N, K; };

struct StaticOrder {
    int nM, nN, nwg, G, c;
    __host__ __device__ void init(int M, int N, int G_, int c_) { nM = M / BM; nN = N / BM; nwg = nM * nN; G = G_; c = c_; }
    __host__ __device__ bool next(int i, Unit& u) const {
        const long L = (long)i * G + c; if (L >= nwg) return false;
        int wgid = (int)L; { const int q = nwg / NXCD, r = nwg % NXCD, xcd = wgid % NXCD, off = wgid / NXCD; wgid = (xcd < r ? xcd * (q + 1) : r * (q + 1) + (xcd - r) * q) + off; }
        const int nig = WGM * nN, gid = wgid / nig, fm = gid * WGM, gsz = (nM - fm) < WGM ? (nM - fm) : WGM;
        u.pm = fm + ((wgid % nig) % gsz); u.pn = (wgid % nig) / gsz; return true;
    }
    __device__ __forceinline__ void a_ready(const Unit&) const {}
    __device__ __forceinline__ void done(const Unit&) const {}
};

__device__ __forceinline__ unsigned cvt_pk_bf16(float lo, float hi) { unsigned r; asm volatile("v_cvt_pk_bf16_f32 %0, %1, %2" : "=v"(r) : "v"(lo), "v"(hi)); return r; }

struct EpiInProj {
    static constexpr bool PERM = true, AFTER_DRAIN = false;
    bf16_t* O; int ldc; const float* rstd; float* FD; int fd_pn;
    __device__ __forceinline__ void operator()(const f32x4 (&acc)[2][2][4][2], const Unit& u, int wr, int wc, int fr, int fq) const {
        const int row0 = u.pm * BM + wr * 64 + fr; const int col0 = u.pn * BM + wc * 32 + 8 * fq;
        const bool fdl = (u.pn == fd_pn) && (wc == 1) && (fq == 0);
#pragma unroll
        for (int ai = 0; ai < 2; ++ai)
#pragma unroll
            for (int m = 0; m < 4; ++m) { const int row = row0 + ai * HALF + m * 16; const float rs = rstd[row]; bf16_t* rowp = O + (size_t)row * ldc + col0;
#pragma unroll
                for (int bj = 0; bj < 2; ++bj) { const f32x4 v0 = acc[ai][bj][m][0] * rs, v1 = acc[ai][bj][m][1] * rs;
                    u32x4 w; w.x = cvt_pk_bf16(v0[0], v0[1]); w.y = cvt_pk_bf16(v0[2], v0[3]); w.z = cvt_pk_bf16(v1[0], v1[1]); w.w = cvt_pk_bf16(v1[2], v1[3]);
                    *(u32x4*)(rowp + bj * HALF) = w;
                    if (bj == 1 && fdl) { *(f32x4*)(FD + (size_t)row * 8) = v0; *(f32x4*)(FD + (size_t)row * 8 + 4) = v1; } } }
    }
};
struct EpiResid {
    static constexpr bool PERM = false, AFTER_DRAIN = false;
    const float* base; float* out; int ldc;
    __device__ __forceinline__ void operator()(const f32x4 (&acc)[2][2][4][2], const Unit& u, int wr, int wc, int fr, int fq) const {
        const int row0 = u.pm * BM + wr * 64 + fr; const int col0 = u.pn * BM + wc * 32 + 4 * fq;
#pragma unroll
        for (int ai = 0; ai < 2; ++ai)
#pragma unroll
            for (int m = 0; m < 4; ++m) { const size_t off = (size_t)(row0 + ai * HALF + m * 16) * ldc + col0;
#pragma unroll
                for (int bj = 0; bj < 2; ++bj)
#pragma unroll
                    for (int n = 0; n < 2; ++n) { const f32x4 b = *(const f32x4*)(base + off + bj * HALF + n * 16); *(f32x4*)(out + off + bj * HALF + n * 16) = b + acc[ai][bj][m][n]; } }
    }
};
struct EpiGateUp {
    static constexpr bool PERM = true, AFTER_DRAIN = false;
    bf16_t* O; int ldc;
    __device__ __forceinline__ void operator()(const f32x4 (&acc)[2][2][4][2], const Unit& u, int wr, int wc, int fr, int fq) const {
        const int row0 = u.pm * BM + wr * 64 + fr; const int col0 = (u.pn & 1) * HALF + wc * 32 + 8 * fq;
#pragma unroll
        for (int ai = 0; ai < 2; ++ai)
#pragma unroll
            for (int m = 0; m < 4; ++m) { bf16_t* rowp = O + (size_t)(row0 + ai * HALF + m * 16) * ldc + col0; float h[8];
#pragma unroll
                for (int n = 0; n < 2; ++n)
#pragma unroll
                    for (int j = 0; j < 4; ++j) { const float gt = acc[ai][0][m][n][j], up = acc[ai][1][m][n][j]; h[n * 4 + j] = gt * up / (1.0f + __expf(-gt)); }
                u32x4 w; w.x = cvt_pk_bf16(h[0], h[1]); w.y = cvt_pk_bf16(h[2], h[3]); w.z = cvt_pk_bf16(h[4], h[5]); w.w = cvt_pk_bf16(h[6], h[7]);
                *(u32x4*)rowp = w; }
    }
};
struct EpiSlotY {
    static constexpr bool PERM = true, AFTER_DRAIN = false;
    bf16_t* O; int ldc;
    __device__ __forceinline__ void operator()(const f32x4 (&acc)[2][2][4][2], const Unit& u, int wr, int wc, int fr, int fq) const {
        const int row0 = u.pm * BM + wr * 64 + fr; const int col0 = (u.pn & 3) * BM + wc * 32 + 8 * fq;
#pragma unroll
        for (int ai = 0; ai < 2; ++ai)
#pragma unroll
            for (int m = 0; m < 4; ++m) { bf16_t* rowp = O + (size_t)(row0 + ai * HALF + m * 16) * ldc + col0;
#pragma unroll
                for (int bj = 0; bj < 2; ++bj) { const f32x4 v0 = acc[ai][bj][m][0], v1 = acc[ai][bj][m][1];
                    u32x4 w; w.x = cvt_pk_bf16(v0[0], v0[1]); w.y = cvt_pk_bf16(v0[2], v0[3]); w.z = cvt_pk_bf16(v1[0], v1[1]); w.w = cvt_pk_bf16(v1[2], v1[3]);
                    *(u32x4*)(rowp + bj * HALF) = w; } }
    }
};

template <class Epi, class Sched, bool ALIGN_EPI = false, bool SP2 = false>
__device__ __forceinline__ void gemm_phase(PG8_LAS unsigned char* lds, const Gemm g, const Sched& S, const Epi& E) {
    int tid_ = threadIdx.x; asm volatile("" : "+v"(tid_));
    const int tid = tid_, wid = __builtin_amdgcn_readfirstlane(tid >> 6), lane = tid & 63, wr = wid >> 2, wc = wid & 3, fr = lane & 15, fq = lane >> 4;
    const int K = g.K, nt = K / BK;
    unsigned voffA[2], voffB[2];
#pragma unroll
    for (int i = 0; i < 2; ++i) { int R, C; stage_rc(tid * 16 + i * 8192, R, C); const int Rb = Epi::PERM ? ((R & ~31) + perm32(R & 31)) : R;
        voffA[i] = (unsigned)(R * K + C) * 2u; voffB[i] = (unsigned)(Rb * K + C) * 2u; }
    const size_t kstep = (size_t)(BK * 2);
    const size_t hstep = (size_t)HALF * K * 2;
    const size_t tstep = 2 * hstep;
    const unsigned ldsw = (unsigned)wid * 1024u;
    const int aoff = lds_byte(wr * 64 + fr, fq * 8), boff = lds_byte(wc * 32 + fr, fq * 8);
#define PG8_SA(b, h) (((b) * 2 + (h)) * HTB)
#define PG8_SB(b, h) ((4 + (b) * 2 + (h)) * HTB)
#define PG8_STAGE(bufoff, gbase, voff) do { _Pragma("unroll") for (int _i = 0; _i < 2; ++_i) \
        __builtin_amdgcn_global_load_lds((const unsigned*)((const char*)(gbase) + (voff)[_i]), (PG8_LAS unsigned*)(lds + (bufoff) + ldsw + _i * 8192), 16, 0, 0); } while (0)
#define PG8_LDA(dst, b, h) do { _Pragma("unroll") for (int m = 0; m < 4; ++m) _Pragma("unroll") for (int k = 0; k < 2; ++k) dst[m][k] = *(const PG8_LAS bf16x8*)(lds + PG8_SA(b, h) + aoff + m * 2048 + k * 1024); } while (0)
#define PG8_LDB(dst, b, h) do { _Pragma("unroll") for (int n = 0; n < 2; ++n) _Pragma("unroll") for (int k = 0; k < 2; ++k) dst[n][k] = *(const PG8_LAS bf16x8*)(lds + PG8_SB(b, h) + boff + n * 2048 + k * 1024); } while (0)
#define PG8_MMA(ai, bj, At, Bt) do { __builtin_amdgcn_s_setprio(1); _Pragma("unroll") for (int m = 0; m < 4; ++m) _Pragma("unroll") for (int n = 0; n < 2; ++n) _Pragma("unroll") for (int k = 0; k < 2; ++k) \
        acc[ai][bj][m][n] = __builtin_amdgcn_mfma_f32_16x16x32_bf16(Bt[n][k], At[m][k], acc[ai][bj][m][n], 0, 0, 0); __builtin_amdgcn_s_setprio(0); } while (0)
#define PG8_WAIT_V(n) asm volatile("s_waitcnt vmcnt(" #n ")" ::: "memory")
#define PG8_WAIT_L(n) asm volatile("s_waitcnt lgkmcnt(" #n ")" ::: "memory")
#define PG8_BAR __builtin_amdgcn_s_barrier()
#define PG8_SCHED __builtin_amdgcn_sched_barrier(0)
    Unit cur, nxt; int ui = 0;
    if (!S.next(0, cur)) return;
    f32x4 acc[2][2][4][2];
#pragma unroll
    for (int a = 0; a < 2; ++a)
#pragma unroll
        for (int b = 0; b < 2; ++b)
#pragma unroll
            for (int m = 0; m < 4; ++m)
#pragma unroll
                for (int n = 0; n < 2; ++n) acc[a][b][m][n] = (f32x4){0.f, 0.f, 0.f, 0.f};
    bf16x8 At[4][2], B0[2][2], B1[2][2];
    const char* cA = (const char*)g.A + (size_t)cur.pm * tstep; const char* cB = (const char*)g.Bt + (size_t)cur.pn * tstep;
    S.a_ready(cur);
    if constexpr (SP2) {
        PG8_STAGE(PG8_SB(0, 0), cB, voffB); PG8_STAGE(PG8_SB(0, 1), cB + hstep, voffB); PG8_STAGE(PG8_SA(0, 0), cA, voffA); PG8_STAGE(PG8_SA(0, 1), cA + hstep, voffA);
        if (wr == 1) PG8_BAR;
        PG8_WAIT_V(2); PG8_BAR;
        PG8_STAGE(PG8_SB(1, 0), cB + kstep, voffB); PG8_STAGE(PG8_SA(1, 0), cA + kstep, voffA); PG8_STAGE(PG8_SB(1, 1), cB + hstep + kstep, voffB);
        PG8_WAIT_V(6); PG8_BAR;
    } else {
        PG8_STAGE(PG8_SB(0, 0), cB, voffB); PG8_STAGE(PG8_SA(0, 0), cA, voffA); PG8_STAGE(PG8_SB(0, 1), cB + hstep, voffB); PG8_STAGE(PG8_SA(0, 1), cA + hstep, voffA);
        if (wr == 1) PG8_BAR;
        PG8_WAIT_V(4); PG8_BAR;
        PG8_STAGE(PG8_SB(1, 0), cB + kstep, voffB); PG8_STAGE(PG8_SA(1, 0), cA + kstep, voffA); PG8_STAGE(PG8_SB(1, 1), cB + hstep + kstep, voffB);
        PG8_WAIT_V(6); PG8_BAR;
    }
    for (;;) {
        const bool has_next = S.next(ui + 1, nxt);
        const char* nA = has_next ? (const char*)g.A + (size_t)nxt.pm * tstep : cA; const char* nB = has_next ? (const char*)g.Bt + (size_t)nxt.pn * tstep : cB;
        for (int t = 0; t < nt; t += 2) {
            const bool last = (t == nt - 2);
            const char* a1 = cA + (size_t)(t + 1) * kstep;
            const char* a2 = last ? nA : cA + (size_t)(t + 2) * kstep; const char* b2 = last ? nB : cB + (size_t)(t + 2) * kstep;
            const char* a3 = a2 + kstep; const char* b3 = b2 + kstep;
            if (last && has_next) S.a_ready(nxt);
            if constexpr (SP2) {
            PG8_LDB(B0, 0, 0); PG8_LDB(B1, 0, 1); PG8_SCHED; PG8_LDA(At, 0, 0); PG8_STAGE(PG8_SA(1, 1), a1 + hstep, voffA);
            PG8_WAIT_V(8); PG8_WAIT_L(0); PG8_BAR; PG8_MMA(0, 0, At, B0); PG8_MMA(0, 1, At, B1); PG8_BAR; PG8_SCHED;
            PG8_LDA(At, 0, 1); PG8_STAGE(PG8_SB(0, 0), b2, voffB); PG8_STAGE(PG8_SB(0, 1), b2 + hstep, voffB); PG8_STAGE(PG8_SA(0, 0), a2, voffA);
            PG8_WAIT_V(8); PG8_WAIT_L(0); PG8_BAR; PG8_MMA(1, 0, At, B0); PG8_MMA(1, 1, At, B1); PG8_BAR; PG8_SCHED;
            PG8_LDB(B0, 1, 0); PG8_LDB(B1, 1, 1); PG8_SCHED; PG8_LDA(At, 1, 0); PG8_STAGE(PG8_SA(0, 1), a2 + hstep, voffA);
            PG8_WAIT_V(8); PG8_WAIT_L(0); PG8_BAR; PG8_MMA(0, 0, At, B0); PG8_MMA(0, 1, At, B1); PG8_BAR; PG8_SCHED;
            PG8_LDA(At, 1, 1); PG8_STAGE(PG8_SB(1, 0), b3, voffB); PG8_STAGE(PG8_SB(1, 1), b3 + hstep, voffB); PG8_STAGE(PG8_SA(1, 0), a3, voffA);
            PG8_WAIT_V(8); PG8_WAIT_L(0); PG8_BAR; PG8_MMA(1, 0, At, B0); PG8_MMA(1, 1, At, B1); PG8_BAR; PG8_SCHED;
            } else {
            PG8_LDB(B0, 0, 0); PG8_SCHED; PG8_LDA(At, 0, 0); PG8_STAGE(PG8_SA(1, 1), a1 + hstep, voffA);
            PG8_WAIT_L(8); PG8_BAR; PG8_WAIT_L(0); PG8_MMA(0, 0, At, B0); PG8_BAR; PG8_SCHED;
            PG8_LDB(B1, 0, 1); PG8_STAGE(PG8_SB(0, 0), b2, voffB);
            PG8_BAR; PG8_WAIT_L(0); PG8_MMA(0, 1, At, B1); PG8_BAR;
            PG8_LDA(At, 0, 1); PG8_STAGE(PG8_SA(0, 0), a2, voffA);
            PG8_BAR; PG8_WAIT_L(0); PG8_MMA(1, 0, At, B0); PG8_BAR; PG8_SCHED;
            PG8_STAGE(PG8_SB(0, 1), b2 + hstep, voffB);
            PG8_WAIT_V(6); PG8_BAR; PG8_MMA(1, 1, At, B1); PG8_BAR;
            PG8_LDB(B0, 1, 0); PG8_SCHED; PG8_LDA(At, 1, 0); PG8_STAGE(PG8_SA(0, 1), a2 + hstep, voffA);
            PG8_WAIT_L(8); PG8_BAR; PG8_WAIT_L(0); PG8_MMA(0, 0, At, B0); PG8_BAR; PG8_SCHED;
            PG8_LDB(B1, 1, 1); PG8_STAGE(PG8_SB(1, 0), b3, voffB);
            PG8_BAR; PG8_WAIT_L(0); PG8_MMA(0, 1, At, B1); PG8_BAR;
            PG8_LDA(At, 1, 1); PG8_STAGE(PG8_SA(1, 0), a3, voffA);
            PG8_BAR; PG8_WAIT_L(0); PG8_MMA(1, 0, At, B0); PG8_BAR; PG8_SCHED;
            PG8_STAGE(PG8_SB(1, 1), b3 + hstep, voffB);
            PG8_WAIT_V(6); PG8_BAR; PG8_MMA(1, 1, At, B1); PG8_BAR;
            }
        }
        if constexpr (ALIGN_EPI) { if (wr == 0) PG8_BAR; }
        if constexpr (!Epi::AFTER_DRAIN) { E(acc, cur, wr, wc, fr, fq); S.done(cur); }
        if (!has_next) break;
#pragma unroll
        for (int a = 0; a < 2; ++a)
#pragma unroll
            for (int b = 0; b < 2; ++b)
#pragma unroll
                for (int m = 0; m < 4; ++m)
#pragma unroll
                    for (int n = 0; n < 2; ++n) acc[a][b][m][n] = (f32x4){0.f, 0.f, 0.f, 0.f};
        cur = nxt; cA = nA; cB = nB; ++ui;
        if constexpr (ALIGN_EPI) { if (wr == 1) PG8_BAR; }
    }
    PG8_WAIT_V(0);
    if constexpr (!ALIGN_EPI) { if (wr == 0) PG8_BAR; }
    PG8_BAR;
    if constexpr (Epi::AFTER_DRAIN) { E.fused(acc, cur, wr, wc, fr, fq, lds, wid, lane); S.done(cur); }
#undef PG8_SA
#undef PG8_SB
#undef PG8_STAGE
#undef PG8_LDA
#undef PG8_LDB
#undef PG8_MMA
#undef PG8_WAIT_V
#undef PG8_WAIT_L
#undef PG8_BAR
#undef PG8_SCHED
}
template <class Epi, class Sched, bool ALIGN_EPI = false>
__device__ __forceinline__ void gemm_phase_gather(PG8_LAS unsigned char* lds, const Gemm g, const Sched& S, const Epi& E) {
    int tid_ = threadIdx.x; asm volatile("" : "+v"(tid_));
    const int tid = tid_, wid = __builtin_amdgcn_readfirstlane(tid >> 6), lane = tid & 63, wr = wid >> 2, wc = wid & 3, fr = lane & 15, fq = lane >> 4;
    const int K = g.K, nt = K / BK;
    unsigned voffB[2]; int RA[2]; unsigned CA[2];
#pragma unroll
    for (int i = 0; i < 2; ++i) { int R, C; stage_rc(tid * 16 + i * 8192, R, C); const int Rb = Epi::PERM ? ((R & ~31) + perm32(R & 31)) : R;
        RA[i] = R; CA[i] = (unsigned)C * 2u; voffB[i] = (unsigned)(Rb * K + C) * 2u; }
    const size_t kstep = (size_t)(BK * 2);
    const size_t hstep = (size_t)HALF * K * 2;
    const size_t tstep = 2 * hstep;
    const unsigned ldsw = (unsigned)wid * 1024u;
    const int aoff = lds_byte(wr * 64 + fr, fq * 8), boff = lds_byte(wc * 32 + fr, fq * 8);
#define PG8_SA(b, h) (((b) * 2 + (h)) * HTB)
#define PG8_SB(b, h) ((4 + (b) * 2 + (h)) * HTB)
#define PG8_STAGE(bufoff, gbase, voff) do { _Pragma("unroll") for (int _i = 0; _i < 2; ++_i) \
        __builtin_amdgcn_global_load_lds((const unsigned*)((const char*)(gbase) + (voff)[_i]), (PG8_LAS unsigned*)(lds + (bufoff) + ldsw + _i * 8192), 16, 0, 0); } while (0)
#define PG8_LDA(dst, b, h) do { _Pragma("unroll") for (int m = 0; m < 4; ++m) _Pragma("unroll") for (int k = 0; k < 2; ++k) dst[m][k] = *(const PG8_LAS bf16x8*)(lds + PG8_SA(b, h) + aoff + m * 2048 + k * 1024); } while (0)
#define PG8_LDB(dst, b, h) do { _Pragma("unroll") for (int n = 0; n < 2; ++n) _Pragma("unroll") for (int k = 0; k < 2; ++k) dst[n][k] = *(const PG8_LAS bf16x8*)(lds + PG8_SB(b, h) + boff + n * 2048 + k * 1024); } while (0)
#define PG8_MMA(ai, bj, At, Bt) do { __builtin_amdgcn_s_setprio(1); _Pragma("unroll") for (int m = 0; m < 4; ++m) _Pragma("unroll") for (int n = 0; n < 2; ++n) _Pragma("unroll") for (int k = 0; k < 2; ++k) \
        acc[ai][bj][m][n] = __builtin_amdgcn_mfma_f32_16x16x32_bf16(Bt[n][k], At[m][k], acc[ai][bj][m][n], 0, 0, 0); __builtin_amdgcn_s_setprio(0); } while (0)
#define PG8_WAIT_V(n) asm volatile("s_waitcnt vmcnt(" #n ")" ::: "memory")
#define PG8_WAIT_L(n) asm volatile("s_waitcnt lgkmcnt(" #n ")" ::: "memory")
#define PG8_BAR __builtin_amdgcn_s_barrier()
#define PG8_SCHED __builtin_amdgcn_sched_barrier(0)
#define PG8_GOFFS(dst, u) do { _Pragma("unroll") for (int _h = 0; _h < 2; ++_h) _Pragma("unroll") for (int _i = 0; _i < 2; ++_i) \
        dst[_h][_i] = (unsigned)S.arow(u, _h * HALF + RA[_i]) * (unsigned)(K * 2) + CA[_i]; } while (0)
    Unit cur, nxt; int ui = 0;
    if (!S.next(0, cur)) return;
    unsigned vA[2][2], nvA[2][2];
    PG8_GOFFS(vA, cur);
    f32x4 acc[2][2][4][2];
#pragma unroll
    for (int a = 0; a < 2; ++a)
#pragma unroll
        for (int b = 0; b < 2; ++b)
#pragma unroll
            for (int m = 0; m < 4; ++m)
#pragma unroll
                for (int n = 0; n < 2; ++n) acc[a][b][m][n] = (f32x4){0.f, 0.f, 0.f, 0.f};
    bf16x8 At[4][2], B0[2][2], B1[2][2];
    const char* const cA = (const char*)g.A; const char* cB = (const char*)g.Bt + (size_t)cur.pn * tstep;
    asm volatile("s_waitcnt vmcnt(0)" ::: "memory");
    PG8_STAGE(PG8_SB(0, 0), cB, voffB); PG8_STAGE(PG8_SB(0, 1), cB + hstep, voffB); PG8_STAGE(PG8_SA(0, 0), cA, vA[0]); PG8_STAGE(PG8_SA(0, 1), cA, vA[1]);
    if (wr == 1) PG8_BAR;
    PG8_WAIT_V(2); PG8_BAR;
    PG8_STAGE(PG8_SB(1, 0), cB + kstep, voffB); PG8_STAGE(PG8_SA(1, 0), cA + kstep, vA[0]); PG8_STAGE(PG8_SB(1, 1), cB + hstep + kstep, voffB);
    PG8_WAIT_V(6); PG8_BAR;
    for (;;) {
        const bool has_next = S.next(ui + 1, nxt);
        const char* nB = has_next ? (const char*)g.Bt + (size_t)nxt.pn * tstep : cB;
        for (int t = 0; t < nt; t += 2) {
            const bool last = (t == nt - 2);
            if (last) {
                if (has_next) { PG8_GOFFS(nvA, nxt); }
                else {
#pragma unroll
                    for (int _h = 0; _h < 2; ++_h)
#pragma unroll
                        for (int _i = 0; _i < 2; ++_i) nvA[_h][_i] = vA[_h][_i]; }
            }
            unsigned s0[2], s1[2];
#pragma unroll
            for (int _i = 0; _i < 2; ++_i) { s0[_i] = last ? nvA[0][_i] : vA[0][_i]; s1[_i] = last ? nvA[1][_i] : vA[1][_i]; }
            const char* a1 = cA + (size_t)(t + 1) * kstep;
            const char* a2 = last ? cA : cA + (size_t)(t + 2) * kstep; const char* b2 = last ? nB : cB + (size_t)(t + 2) * kstep;
            const char* a3 = a2 + kstep; const char* b3 = b2 + kstep;
            PG8_LDB(B0, 0, 0); PG8_LDB(B1, 0, 1); PG8_SCHED; PG8_LDA(At, 0, 0); PG8_STAGE(PG8_SA(1, 1), a1, vA[1]);
            PG8_WAIT_V(8); PG8_WAIT_L(0); PG8_BAR; PG8_MMA(0, 0, At, B0); PG8_MMA(0, 1, At, B1); PG8_BAR; PG8_SCHED;
            PG8_LDA(At, 0, 1); PG8_STAGE(PG8_SB(0, 0), b2, voffB); PG8_STAGE(PG8_SB(0, 1), b2 + hstep, voffB); PG8_STAGE(PG8_SA(0, 0), a2, s0);
            PG8_WAIT_V(8); PG8_WAIT_L(0); PG8_BAR; PG8_MMA(1, 0, At, B0); PG8_MMA(1, 1, At, B1); PG8_BAR; PG8_SCHED;
            PG8_LDB(B0, 1, 0); PG8_LDB(B1, 1, 1); PG8_SCHED; PG8_LDA(At, 1, 0); PG8_STAGE(PG8_SA(0, 1), a2, s1);
            PG8_WAIT_V(8); PG8_WAIT_L(0); PG8_BAR; PG8_MMA(0, 0, At, B0); PG8_MMA(0, 1, At, B1); PG8_BAR; PG8_SCHED;
            PG8_LDA(At, 1, 1); PG8_STAGE(PG8_SB(1, 0), b3, voffB); PG8_STAGE(PG8_SB(1, 1), b3 + hstep, voffB); PG8_STAGE(PG8_SA(1, 0), a3, s0);
            PG8_WAIT_V(8); PG8_WAIT_L(0); PG8_BAR; PG8_MMA(1, 0, At, B0); PG8_MMA(1, 1, At, B1); PG8_BAR; PG8_SCHED;
        }
        if constexpr (ALIGN_EPI) { if (wr == 0) PG8_BAR; }
        E(acc, cur, wr, wc, fr, fq); S.done(cur);
        if (!has_next) break;
#pragma unroll
        for (int a = 0; a < 2; ++a)
#pragma unroll
            for (int b = 0; b < 2; ++b)
#pragma unroll
                for (int m = 0; m < 4; ++m)
#pragma unroll
                    for (int n = 0; n < 2; ++n) acc[a][b][m][n] = (f32x4){0.f, 0.f, 0.f, 0.f};
        cur = nxt; cB = nB; ++ui;
#pragma unroll
        for (int _h = 0; _h < 2; ++_h)
#pragma unroll
            for (int _i = 0; _i < 2; ++_i) vA[_h][_i] = nvA[_h][_i];
        if constexpr (ALIGN_EPI) { if (wr == 1) PG8_BAR; }
    }
    PG8_WAIT_V(0);
    if constexpr (!ALIGN_EPI) { if (wr == 0) PG8_BAR; }
    PG8_BAR;
#undef PG8_SA
#undef PG8_SB
#undef PG8_STAGE
#undef PG8_LDA
#undef PG8_LDB
#undef PG8_MMA
#undef PG8_WAIT_V
#undef PG8_WAIT_L
#undef PG8_BAR
#undef PG8_SCHED
#undef PG8_GOFFS
}
}

#define XB_TMO      128
#define XB_XCNT(j)  (256  + 64 * (j))
#define XB_XSUB(j)  (1280 + 64 * (j))
#define XB_XGEN(j)  (2304 + 64 * (j))
#define XB_TOP      3328
#define XB_TOPGEN   3392
#define XCD_BAR_WORDS 3456
#define XB_SPIN_CAP (1u << 18)

__device__ __forceinline__ unsigned xb_ld(unsigned* p)              { return __hip_atomic_load(p, __ATOMIC_RELAXED, __HIP_MEMORY_SCOPE_AGENT); }
__device__ __forceinline__ unsigned xb_add(unsigned* p, unsigned v) { return __hip_atomic_fetch_add(p, v, __ATOMIC_RELAXED, __HIP_MEMORY_SCOPE_AGENT); }
__device__ __forceinline__ unsigned xb_xcc_id() { return (unsigned)__builtin_amdgcn_s_getreg((3 << 11) | 20) & 0xFu; }
#define XB_SPIN(cond, bar) do { unsigned _sp = 0; while (cond) { __builtin_amdgcn_s_sleep(1); \
    if ((++_sp & 255u) == 0u) { if (xb_ld(&(bar)[XB_TMO])) break; if (_sp > XB_SPIN_CAP) { atomicAdd(&(bar)[XB_TMO], 1u); break; } } } } while (0)

struct XcdBarrier {
    unsigned* bar; unsigned x;
    volatile LAS unsigned* st;
};

__device__ __forceinline__ XcdBarrier xcd_barrier_post(unsigned* bar, volatile LAS unsigned* st) {
    XcdBarrier b; b.bar = bar; b.x = xb_xcc_id(); b.st = st;
    if (threadIdx.x == 0) (void)xb_add(&bar[XB_XCNT(b.x)], 1u);
    return b;
}
__device__ __forceinline__ void xcd_barrier_complete(unsigned* bar, unsigned x, unsigned& nloc, unsigned& nx) {
    const unsigned G = gridDim.x * gridDim.y * gridDim.z;
    unsigned sum, cnt, mine, sp = 0u;
    for (;;) {
        sum = 0u; cnt = 0u; mine = 0u;
#pragma unroll
        for (unsigned j = 0; j < 16; ++j) { const unsigned c = xb_ld(&bar[XB_XCNT(j)]); sum += c; cnt += (c > 0u) ? 1u : 0u; mine = (j == x) ? c : mine; }
        if (sum == G) break;
        __builtin_amdgcn_s_sleep(1);
        if ((++sp & 255u) == 0u) { if (xb_ld(&bar[XB_TMO])) break; if (sp > XB_SPIN_CAP) { atomicAdd(&bar[XB_TMO], 1u); break; } }
    }
    nloc = mine > 0u ? mine : 1u; nx = cnt > 0u ? cnt : 1u;
}

__device__ __forceinline__ void xcd_barrier(const XcdBarrier& b) {
    asm volatile("s_waitcnt vmcnt(0)" ::: "memory");
    __syncthreads();
    if (threadIdx.x == 0) {
        unsigned* bar = b.bar;
        __builtin_amdgcn_s_waitcnt(0);
        unsigned nloc = b.st[0], nx = b.st[1];
        if (nloc == 0u) { xcd_barrier_complete(bar, b.x, nloc, nx); b.st[0] = nloc; b.st[1] = nx; }
        const unsigned old = xb_add(&bar[XB_XSUB(b.x)], 1u);
        const unsigned gen = old / nloc;
        if (old + 1u == (gen + 1u) * nloc) {
            __builtin_amdgcn_fence(__ATOMIC_RELEASE, "agent");
            asm volatile("s_waitcnt vmcnt(0)" ::: "memory");
            const unsigned og = xb_add(&bar[XB_TOP], 1u);
            const unsigned tg = og / nx;
            if (og + 1u == (tg + 1u) * nx) xb_add(&bar[XB_TOPGEN], 1u);
            else XB_SPIN(xb_ld(&bar[XB_TOPGEN]) == tg, bar);
            __builtin_amdgcn_fence(__ATOMIC_ACQUIRE, "agent");
            xb_add(&bar[XB_XGEN(b.x)], 1u);
            asm volatile("s_waitcnt vmcnt(0)" ::: "memory");
        } else {
            XB_SPIN(xb_ld(&bar[XB_XGEN(b.x)]) == gen, bar);
            __builtin_amdgcn_fence(__ATOMIC_ACQUIRE, "agent");
            asm volatile("s_waitcnt vmcnt(0)" ::: "memory");
        }
    }
    __syncthreads();
}


constexpr int NWAVES = 8, NTHR = 512;
constexpr int T = 16384, DM = 1024, SEQ = 2048, NPROJ = 2816, NCHK = 256;
constexpr float RMS_EPS = 1e-6f, LOG2E = 1.4426950408889634f;
constexpr int C_AB = 0, C_AC = 256, C_AV = 512, C_FQ = 768, C_FK = 1024, C_FV = 1280, C_Z = 1536, C_XBC = 1792, C_CQ = 2304, C_CKV = 2560, C_KR = 2688, C_FD = 2720;
#ifndef EN0
#define EN0 31
#endif
#ifndef EN1
#define EN1 31
#endif
#ifndef EN_L1
#define EN_L1 1
#endif
#ifndef REP_ATT
#define REP_ATT 0
#endif
#ifndef REP_SSD
#define REP_SSD 0
#endif
#ifndef MK_SPLIT
#define MK_SPLIT 0
#endif
constexpr int NPL = 9, NPHASE = 1 + 2 * NPL;

constexpr size_t MiB = 1u << 20;
constexpr size_t WS_CTL = 0, CTL_ZERO_BYTES = 65536;
constexpr size_t WS_X1 = 1 * MiB;
constexpr size_t WS_PM = 65 * MiB;
constexpr size_t WS_S1 = 153 * MiB;
constexpr size_t WS_HACT = 185 * MiB;
constexpr size_t WS_E = 205 * MiB;
constexpr size_t WS_QM = WS_E, WS_KM = WS_E + 12 * MiB, WS_VM = WS_E + 24 * MiB, WS_ST = WS_E + 32 * MiB, WS_PREV = WS_E + 48 * MiB;
constexpr size_t WS_BGU = WS_E, WS_BD = WS_E + 32 * MiB;
constexpr size_t WS_WIN = 261 * MiB;
constexpr size_t WS_WOUT = 272 * MiB;
constexpr size_t WS_WUQ = 276 * MiB;
constexpr size_t WS_WUKV = WS_WUQ + 512 * 1024;
constexpr size_t WS_MISC = 277 * MiB;
constexpr size_t WS_FD = WS_MISC;
constexpr size_t WS_RSTD = WS_FD + 512 * 1024;
constexpr size_t WS_CUM = WS_RSTD + 64 * 1024;
constexpr size_t WS_COS = WS_CUM + 256 * 1024;
constexpr size_t WS_SIN = WS_COS + 1 * MiB;
constexpr size_t WS_CDEC = WS_SIN + 1 * MiB;
constexpr size_t WS_ROWL = WS_CDEC + 64 * 1024;
constexpr size_t WS_TOKE = WS_ROWL + 2 * MiB;
constexpr size_t WS_TOKP = WS_TOKE + 128 * 1024;
constexpr size_t WS_TOKW = WS_TOKP + 128 * 1024;
constexpr size_t WS_WR = WS_TOKW + 128 * 1024;
constexpr size_t WS_END = WS_WR + 288 * 1024;
static_assert(WS_END <= 284 * MiB, "workspace map");
constexpr size_t WS_NEED = 284 * MiB;
constexpr int CW_CNT = 64;
constexpr int CW_BAR = 4096;

constexpr int LDS_BYTES = 155648;
constexpr int LDS_SCR = 147456;
constexpr int LDS_CTL = 151552;
constexpr int SCR_RED = 0;
constexpr int SCR_RQ = 256, SCR_RKV = 512;
constexpr int SCR_CNT = 768;
constexpr int SCR_TBASE = 896;
constexpr int SCR_TILEE = 1040;
constexpr int SCR_NT = 1680;

typedef unsigned short bf16_t;
typedef short bf16x8 __attribute__((ext_vector_type(8)));
typedef short s16x4 __attribute__((ext_vector_type(4)));
typedef float f32x4 __attribute__((ext_vector_type(4)));
typedef unsigned u32x4 __attribute__((ext_vector_type(4)));
typedef unsigned u32x2 __attribute__((ext_vector_type(2)));
typedef LAS unsigned char* lptr;
#define LDS_WAIT() asm volatile("s_waitcnt lgkmcnt(0)" ::: "memory")

__device__ __forceinline__ unsigned f2bf(float f) { unsigned u = __builtin_bit_cast(unsigned, f); return (u + 0x7fffu + ((u >> 16) & 1u)) >> 16; }
__device__ __forceinline__ unsigned pk2(float lo, float hi) { unsigned r; asm("v_cvt_pk_bf16_f32 %0, %1, %2" : "=v"(r) : "v"(lo), "v"(hi)); return r; }
__device__ __forceinline__ float bf2f(unsigned short u) { return __uint_as_float((unsigned)u << 16); }
__device__ __forceinline__ float bflo(unsigned u) { return __uint_as_float(u << 16); }
__device__ __forceinline__ float bfhi(unsigned u) { return __uint_as_float(u & 0xffff0000u); }
__device__ __forceinline__ float wave_sum(float v) {
#pragma unroll
    for (int o = 1; o < 64; o <<= 1) v += __shfl_xor(v, o);
    return v;
}
__device__ __forceinline__ float silu_f(float x) { return x / (1.0f + __expf(-x)); }
__device__ __forceinline__ float softplus_f(float x) { return fmaxf(x, 0.f) + log1pf(__expf(-fabsf(x))); }
__device__ __forceinline__ f32x4 mfma16(bf16x8 a, bf16x8 b, f32x4 c) { return __builtin_amdgcn_mfma_f32_16x16x32_bf16(a, b, c, 0, 0, 0); }
__device__ __forceinline__ bf16x8 tr_frag(lptr base, int ld  , int row_a, int row_b, int col0, int lane) {
    typedef short v4i16_t __attribute__((ext_vector_type(4)));
    const int i = lane & 15, q = i >> 2, p = i & 3;
    const s16x4 lo = __builtin_bit_cast(s16x4, __builtin_amdgcn_ds_read_tr16_b64_v4i16((LAS v4i16_t*)(base + ((row_a + q) * ld + col0 + 4 * p) * 2)));
    const s16x4 hi = __builtin_bit_cast(s16x4, __builtin_amdgcn_ds_read_tr16_b64_v4i16((LAS v4i16_t*)(base + ((row_b + q) * ld + col0 + 4 * p) * 2)));
    return (bf16x8){lo[0], lo[1], lo[2], lo[3], hi[0], hi[1], hi[2], hi[3]};
}

struct Args { const float* in[26]; float* out; unsigned char* ws; int ph_lo, ph_hi; };
struct Ctx {
    lptr lds;
    int tid, lane, wave, G, bx;
    const __attribute__((address_space(4))) Args* a;
    float* out; unsigned char* ws;
};
#define WSP(type, off) ((type*)(C.ws + (off)))
#define LAUNDER() do { unsigned char* p_ = C.ws; int t_ = C.tid; unsigned l_ = (unsigned)(size_t)C.lds; const __attribute__((address_space(4))) Args* a_ = C.a; asm volatile("" : "+s"(p_), "+v"(t_), "+s"(l_), "+s"(a_)); C.a = a_; C.ws = p_; C.tid = t_; C.lane = t_ & 63; C.wave = __builtin_amdgcn_readfirstlane(t_ >> 6); C.lds = (lptr)(size_t)l_; } while (0)

__device__ __forceinline__ int refcol(int n) { return n < 1536 ? n : n < 2304 ? n + 4 : n < 2720 ? n + 8 : n < 2724 ? 1536 + (n - 2720) : n < 2728 ? 2308 + (n - 2724) : -1; }

struct TrItem { const float* W; int ldw, scol4, k0; const float* gk; bf16_t* dst; int K; };
__device__ __forceinline__ void tr_load(const TrItem& t, f32x4 (&v)[8], int lane) {
    const int r8 = lane >> 3;
#pragma unroll
    for (int i = 0; i < 8; ++i) { v[i] = (f32x4){0.f, 0.f, 0.f, 0.f}; if (t.scol4 >= 0) v[i] = *(const f32x4*)(t.W + (size_t)(t.k0 + 8 * i + r8) * t.ldw + t.scol4); }
}
__device__ __forceinline__ void tr_store(const TrItem& t, const f32x4 (&v)[8], LAS float* scr, int lane) {
    const int r8 = lane >> 3, c4 = lane & 7;
#pragma unroll
    for (int i = 0; i < 8; ++i) { const int kk = 8 * i + r8; const float g = t.gk ? t.gk[t.k0 + kk] : 1.0f; LAS float* p = scr + kk * 33 + 4 * c4;
        p[0] = v[i].x * g; p[1] = v[i].y * g; p[2] = v[i].z * g; p[3] = v[i].w * g; }
    LDS_WAIT(); asm volatile("" ::: "memory");
    const int c = lane & 7;
#pragma unroll
    for (int j = 0; j < 4; ++j) { const int n = (lane >> 3) + 8 * j; const LAS float* sp = scr + (8 * c) * 33 + n;
        u32x4 o; o.x = pk2(sp[0 * 33], sp[1 * 33]); o.y = pk2(sp[2 * 33], sp[3 * 33]); o.z = pk2(sp[4 * 33], sp[5 * 33]); o.w = pk2(sp[6 * 33], sp[7 * 33]);
        *(u32x4*)(t.dst + (size_t)n * t.K + 8 * c) = o; }
    LDS_WAIT(); asm volatile("" ::: "memory");
}

__device__ __forceinline__ void row_to_bf16(const float* xrow, bf16_t* orow, float* rstd_out, int lane) {
    const f32x4* xr = (const f32x4*)xrow + lane; f32x4 v[4]; float s = 0.f;
#pragma unroll
    for (int j = 0; j < 4; ++j) { v[j] = xr[64 * j]; s += (v[j].x * v[j].x + v[j].y * v[j].y) + (v[j].z * v[j].z + v[j].w * v[j].w); }
    s = wave_sum(s);
    if (lane == 0) *rstd_out = 1.0f / sqrtf(s * (1.0f / DM) + RMS_EPS);
    u32x2* o8 = (u32x2*)orow + lane;
#pragma unroll
    for (int j = 0; j < 4; ++j) { u32x2 w; w.x = pk2(v[j].x, v[j].y); w.y = pk2(v[j].z, v[j].w); o8[64 * j] = w; }
}

constexpr int P0_I_IN = 16 * 88, P0_I_OUT = 16 * 32, P0_I_UQ = 4 * 12, P0_I_UKV = 2 * 16, P0_I_L = P0_I_IN + P0_I_OUT + P0_I_UQ + P0_I_UKV;
__device__ __forceinline__ TrItem p0_item(Ctx& C, int it, int lane) {
    const int l = it / P0_I_L; int r = it % P0_I_L; const int c4 = (lane & 7) * 4; TrItem t;
    if (r < P0_I_IN) { const int kb = r / 88, nb = r % 88; t.W = C.a->in[3] + (size_t)l * 1024 * 2728; t.ldw = 2728; t.scol4 = refcol(32 * nb + c4); t.k0 = 64 * kb; t.gk = C.a->in[2] + l * 1024;
        t.dst = WSP(bf16_t, WS_WIN) + (size_t)l * NPROJ * 1024 + (size_t)(32 * nb) * 1024 + 64 * kb; t.K = 1024; return t; }
    r -= P0_I_IN;
    if (r < P0_I_OUT) { const int kb = r / 32, nb = r % 32; t.W = C.a->in[16] + (size_t)l * 1024 * 1024; t.ldw = 1024; t.scol4 = 32 * nb + c4; t.k0 = 64 * kb; t.gk = nullptr;
        t.dst = WSP(bf16_t, WS_WOUT) + (size_t)l * 1024 * 1024 + (size_t)(32 * nb) * 1024 + 64 * kb; t.K = 1024; return t; }
    r -= P0_I_OUT;
    if (r < P0_I_UQ) { const int kb = r / 12, nb = r % 12; t.W = C.a->in[14] + (size_t)l * 256 * 384; t.ldw = 384; t.scol4 = 32 * nb + c4; t.k0 = 64 * kb; t.gk = C.a->in[12] + l * 256;
        t.dst = WSP(bf16_t, WS_WUQ) + (size_t)l * 384 * 256 + (size_t)(32 * nb) * 256 + 64 * kb; t.K = 256; return t; }
    r -= P0_I_UQ;
    { const int kb = r / 16, nb = r % 16; t.W = C.a->in[15] + (size_t)l * 128 * 512; t.ldw = 512; t.scol4 = 32 * nb + c4; t.k0 = 64 * kb; t.gk = C.a->in[13] + l * 128;
        t.dst = WSP(bf16_t, WS_WUKV) + (size_t)l * 512 * 128 + (size_t)(32 * nb) * 128 + 64 * kb; t.K = 128; return t; }
}
__device__ __forceinline__ void p0_prologue(Ctx& C) {
    LAS float* scr = (LAS float*)(C.lds + C.wave * 8704);
    const int gw = C.bx * NWAVES + C.wave, NGW = C.G * NWAVES, lane = C.lane;
    for (int m = gw; m < T; m += 2 * NGW) { const int m2 = m + NGW; const bool two = m2 < T;
        const f32x4* xa = (const f32x4*)(C.a->in[0] + (size_t)m * DM) + lane; const f32x4* xb = (const f32x4*)(C.a->in[0] + (size_t)(two ? m2 : m) * DM) + lane;
        f32x4 va[4], vb[4]; float sa = 0.f, sb = 0.f;
#pragma unroll
        for (int j = 0; j < 4; ++j) { va[j] = xa[64 * j]; vb[j] = xb[64 * j]; }
#pragma unroll
        for (int j = 0; j < 4; ++j) { sa += (va[j].x * va[j].x + va[j].y * va[j].y) + (va[j].z * va[j].z + va[j].w * va[j].w); sb += (vb[j].x * vb[j].x + vb[j].y * vb[j].y) + (vb[j].z * vb[j].z + vb[j].w * vb[j].w); }
        sa = wave_sum(sa); sb = wave_sum(sb);
        if (lane == 0) { WSP(float, WS_RSTD)[m] = 1.0f / sqrtf(sa * (1.0f / DM) + RMS_EPS); if (two) WSP(float, WS_RSTD)[m2] = 1.0f / sqrtf(sb * (1.0f / DM) + RMS_EPS); }
        u32x2* oa = (u32x2*)(WSP(bf16_t, WS_S1) + (size_t)m * DM) + lane; u32x2* ob = (u32x2*)(WSP(bf16_t, WS_S1) + (size_t)m2 * DM) + lane;
#pragma unroll
        for (int j = 0; j < 4; ++j) { u32x2 w; w.x = pk2(va[j].x, va[j].y); w.y = pk2(va[j].z, va[j].w); oa[64 * j] = w; if (two) { u32x2 w2; w2.x = pk2(vb[j].x, vb[j].y); w2.y = pk2(vb[j].z, vb[j].w); ob[64 * j] = w2; } } }
    { f32x4 cur[8], nx[8]; int it = gw;
      if (it < 2 * P0_I_L) { TrItem t = p0_item(C, it, lane); tr_load(t, cur, lane); }
#pragma unroll 1
      for (; it < 2 * P0_I_L; it += NGW) { const bool more = it + NGW < 2 * P0_I_L;
          if (more) { TrItem tn = p0_item(C, it + NGW, lane); tr_load(tn, nx, lane); }
          TrItem t = p0_item(C, it, lane); tr_store(t, cur, scr, lane);
#pragma unroll
          for (int i = 0; i < 8; ++i) cur[i] = nx[i]; } }
    { float* wr = WSP(float, WS_WR);
      for (int e = C.bx * NTHR + C.tid; e < 2 * 36 * 1024; e += C.G * NTHR) { const int l = e / 36864, r = e % 36864, cc = r >> 10, k = r & 1023;
          wr[e] = C.a->in[17][l * 1024 + k] * (cc < 4 ? C.a->in[18][(size_t)l * 4096 + k * 4 + cc] : C.a->in[20][(size_t)l * 32768 + k * 32 + (cc - 4)]); } }
    { const int* pos = (const int*)C.a->in[1]; float* cs = WSP(float, WS_COS); float* sn = WSP(float, WS_SIN);
      for (int e = C.bx * NTHR + C.tid; e < T * 16; e += C.G * NTHR) { const int t = e >> 4, i = e & 15;
          const float inv = powf(10000.0f, -(float)(2 * i) / 32.0f); const float ang = (float)pos[t] * inv;
          const double rev = (double)ang * 0.15915494309189535; const double fr = rev - floor(rev); const float a = (float)(fr * 6.283185307179586);
          cs[e] = cosf(a); sn[e] = sinf(a); } }
}

constexpr int XS_LD = 264, BC_LD = 136, ML_LD = 72;
constexpr int XS_OFF = 0, BL_OFF = 33792, CL_OFF = 51200, ACUM_OFF = 68608, DT_OFF = 69632, SSQ_OFF = 70656, ML_OFF = 71680, PV_OFF = 108544;
static_assert(PV_OFF + 36864 <= LDS_SCR, "ssd lds");
__device__ __forceinline__ float log_sigmoid_f(float x) { return -(fmaxf(-x, 0.f) + log1pf(__expf(-fabsf(x)))); }

__device__ __forceinline__ void ssd_fill(Ctx& C, int l, int cu) {
    const int c = cu & 31, t0 = cu * 64; const bf16_t* PM = WSP(bf16_t, WS_PM);
    const float* cw = C.a->in[6] + l * 4 * 512; const float* cb = C.a->in[7] + l * 512;
#pragma unroll 1
    for (int it = 0; it < 8; ++it) { const int item = C.tid + NTHR * it, lt = item >> 6, ch = (item & 63) * 8;
        float acc[8];
#pragma unroll
        for (int j = 0; j < 8; ++j) acc[j] = cb[ch + j];
#pragma unroll
        for (int d = 0; d < 4; ++d) { const int sp = 64 * c + lt - 3 + d;
            if (sp >= 0) { const u32x4 raw = *(const u32x4*)(PM + (size_t)(t0 + lt - 3 + d) * NPROJ + C_XBC + ch); const float* w = cw + d * 512 + ch;
                acc[0] += w[0] * bflo(raw.x); acc[1] += w[1] * bfhi(raw.x); acc[2] += w[2] * bflo(raw.y); acc[3] += w[3] * bfhi(raw.y);
                acc[4] += w[4] * bflo(raw.z); acc[5] += w[5] * bfhi(raw.z); acc[6] += w[6] * bflo(raw.w); acc[7] += w[7] * bfhi(raw.w); } }
        u32x4 o; o.x = pk2(silu_f(acc[0]), silu_f(acc[1])); o.y = pk2(silu_f(acc[2]), silu_f(acc[3])); o.z = pk2(silu_f(acc[4]), silu_f(acc[5])); o.w = pk2(silu_f(acc[6]), silu_f(acc[7]));
        lptr dst = ch < 256 ? C.lds + XS_OFF + (lt * XS_LD + ch) * 2 : ch < 384 ? C.lds + BL_OFF + (lt * BC_LD + (ch - 256)) * 2 : C.lds + CL_OFF + (lt * BC_LD + (ch - 384)) * 2;
        *(LAS u32x4*)dst = o; }
    if (C.tid < 256) { const int lt = C.tid >> 2, h = C.tid & 3;
        const float dt = softplus_f(WSP(float, WS_FD)[(size_t)(t0 + lt) * 8 + 4 + h] + C.a->in[8][l * 4 + h]);
        ((LAS float*)(C.lds + DT_OFF))[lt * 4 + h] = dt; ((LAS float*)(C.lds + ACUM_OFF))[lt * 4 + h] = -__expf(C.a->in[9][l * 4 + h]) * dt; }
    __syncthreads();
    if (C.wave < 4) { LAS float* ac = (LAS float*)(C.lds + ACUM_OFF) + C.lane * 4 + C.wave; float v = *ac;
#pragma unroll
        for (int o = 1; o < 64; o <<= 1) { const float y = __shfl_up(v, o); if (C.lane >= o) v += y; }
        *ac = v; }
    __syncthreads();
}

__device__ __forceinline__ void p2_unit(Ctx& C, int l, int cu, int en) {
    const int b = cu >> 5, c = cu & 31, t0 = cu * 64; const int tid = C.tid, lane = C.lane, w = C.wave, g = lane >> 4, i = lane & 15;
    const bf16_t* PM = WSP(bf16_t, WS_PM); bf16_t* Y = WSP(bf16_t, WS_S1);
    { const float* cw = C.a->in[4] + l * 3 * 256;
#pragma unroll 1
      for (int it = 0; it < 4; ++it) { const int item = tid + NTHR * it, lt = item >> 5, ch = (item & 31) * 8; const size_t r = (size_t)(t0 + lt) * NPROJ;
          float acc[8] = {0.f, 0.f, 0.f, 0.f, 0.f, 0.f, 0.f, 0.f};
          if (en & 1) {
#pragma unroll
          for (int d = 0; d < 3; ++d) { const int sp = 64 * c + lt - 2 + d;
              if (sp >= 0) { const size_t rr = (size_t)(t0 + lt - 2 + d) * NPROJ; const u32x4 cg = *(const u32x4*)(PM + rr + C_AC + ch), vl = *(const u32x4*)(PM + rr + C_AV + ch); const float* wv = cw + d * 256 + ch;
                  acc[0] += wv[0] * bflo(cg.x) * bflo(vl.x); acc[1] += wv[1] * bfhi(cg.x) * bfhi(vl.x); acc[2] += wv[2] * bflo(cg.y) * bflo(vl.y); acc[3] += wv[3] * bfhi(cg.y) * bfhi(vl.y);
                  acc[4] += wv[4] * bflo(cg.z) * bflo(vl.z); acc[5] += wv[5] * bfhi(cg.z) * bfhi(vl.z); acc[6] += wv[6] * bflo(cg.w) * bflo(vl.w); acc[7] += wv[7] * bfhi(cg.w) * bfhi(vl.w); } }
          const u32x4 bg = *(const u32x4*)(PM + r + C_AB + ch);
          acc[0] *= bflo(bg.x); acc[1] *= bfhi(bg.x); acc[2] *= bflo(bg.y); acc[3] *= bfhi(bg.y); acc[4] *= bflo(bg.z); acc[5] *= bfhi(bg.z); acc[6] *= bflo(bg.w); acc[7] *= bfhi(bg.w); }
          u32x4 o; o.x = pk2(acc[0], acc[1]); o.y = pk2(acc[2], acc[3]); o.z = pk2(acc[4], acc[5]); o.w = pk2(acc[6], acc[7]);
          *(u32x4*)(Y + (size_t)(t0 + lt) * DM + ch) = o; } }
    for (int mx = 1; mx < 4; ++mx) if (!((en >> mx) & 1)) {
        for (int it = 0; it < 4; ++it) { const int item = tid + NTHR * it, lt = item >> 5, ch = (item & 31) * 8; *(u32x4*)(Y + (size_t)(t0 + lt) * DM + 256 * mx + ch) = (u32x4){0u, 0u, 0u, 0u}; } }
    LAUNDER();
    if (en & 2) {
        const float* FD = WSP(float, WS_FD); const float* fb = C.a->in[5] + l * 4; LAS float* red = (LAS float*)(C.lds + LDS_SCR + SCR_RED);
        float ps[4] = {0.f, 0.f, 0.f, 0.f};
        for (int tk = tid; tk < 64 * c; tk += NTHR) { const f32x4 f = *(const f32x4*)(FD + (size_t)(b * SEQ + tk) * 8);
            ps[0] += log_sigmoid_f(f.x + fb[0]); ps[1] += log_sigmoid_f(f.y + fb[1]); ps[2] += log_sigmoid_f(f.z + fb[2]); ps[3] += log_sigmoid_f(f.w + fb[3]); }
#pragma unroll
        for (int h = 0; h < 4; ++h) ps[h] = wave_sum(ps[h]);
        if (lane == 0) { red[w * 4 + 0] = ps[0]; red[w * 4 + 1] = ps[1]; red[w * 4 + 2] = ps[2]; red[w * 4 + 3] = ps[3]; }
        __syncthreads();
        if (w < 4) { float pre = 0.f;
#pragma unroll
            for (int k = 0; k < 8; ++k) pre += red[k * 4 + w];
            float v = log_sigmoid_f(FD[(size_t)(t0 + lane) * 8 + w] + fb[w]);
#pragma unroll
            for (int o = 1; o < 64; o <<= 1) { const float y = __shfl_up(v, o); if (lane >= o) v += y; }
            WSP(float, WS_CUM)[(size_t)(t0 + lane) * 4 + w] = (pre + v) * LOG2E; }
        __syncthreads();
    }
    LAUNDER();
    if (en & 4) {
        ssd_fill(C, l, cu);
        const LAS float* AC = (const LAS float*)(C.lds + ACUM_OFF); const LAS float* DT = (const LAS float*)(C.lds + DT_OFF);
#pragma unroll 1
        for (int it = 0; it < 4; ++it) { const int item = tid + NTHR * it, lt = item >> 5, col = (item & 31) * 8, h = col >> 6, n = col & 63;
            const u32x4 s = *(const LAS u32x4*)(C.lds + BL_OFF + (lt * BC_LD + 64 * (h >> 1) + n) * 2);
            const float sc = DT[lt * 4 + h] * __expf(AC[63 * 4 + h] - AC[lt * 4 + h]);
            u32x4 o; o.x = pk2(bflo(s.x) * sc, bfhi(s.x) * sc); o.y = pk2(bflo(s.y) * sc, bfhi(s.y) * sc); o.z = pk2(bflo(s.z) * sc, bfhi(s.z) * sc); o.w = pk2(bflo(s.w) * sc, bfhi(s.w) * sc);
            *(LAS u32x4*)(C.lds + PV_OFF + (lt * XS_LD + col) * 2) = o; }
        __syncthreads();
        { const int h = w >> 1, rh = w & 1; float* ST = WSP(float, WS_ST) + (size_t)(cu * 4 + h) * 4096;
#pragma unroll
          for (int mbl = 0; mbl < 2; ++mbl) { const int mb = 2 * rh + mbl;
#pragma unroll
              for (int nb = 0; nb < 4; ++nb) { f32x4 acc = {0.f, 0.f, 0.f, 0.f};
#pragma unroll
                  for (int kk = 0; kk < 2; ++kk) { const int rb = 32 * kk + 8 * g;
                      const bf16x8 a = tr_frag(C.lds + XS_OFF, XS_LD, rb, rb + 4, 64 * h + 16 * mb, lane);
                      const bf16x8 bq = tr_frag(C.lds + PV_OFF, XS_LD, rb, rb + 4, 64 * h + 16 * nb, lane);
                      acc = mfma16(a, bq, acc); }
#pragma unroll
                  for (int r = 0; r < 4; ++r) ST[(16 * mb + 4 * g + r) * 64 + 16 * nb + i] = acc[r]; } }
          if (tid < 4) WSP(float, WS_CDEC)[cu * 4 + tid] = __expf(AC[63 * 4 + tid]); }
        __syncthreads();
    }
    LAUNDER();
    if (en & 8) {
        LAS float* RQ = (LAS float*)(C.lds + LDS_SCR + SCR_RQ); LAS float* RKV = (LAS float*)(C.lds + LDS_SCR + SCR_RKV);
        { const int lt = tid >> 3, sub = tid & 7; const bf16_t* pr = PM + (size_t)(t0 + lt) * NPROJ; float s1 = 0.f, s2 = 0.f;
#pragma unroll
          for (int k = 0; k < 4; ++k) { const u32x4 v = *(const u32x4*)(pr + C_CQ + sub * 32 + 8 * k);
              s1 += bflo(v.x) * bflo(v.x) + bfhi(v.x) * bfhi(v.x) + bflo(v.y) * bflo(v.y) + bfhi(v.y) * bfhi(v.y) + bflo(v.z) * bflo(v.z) + bfhi(v.z) * bfhi(v.z) + bflo(v.w) * bflo(v.w) + bfhi(v.w) * bfhi(v.w); }
#pragma unroll
          for (int k = 0; k < 2; ++k) { const u32x4 v = *(const u32x4*)(pr + C_CKV + sub * 16 + 8 * k);
              s2 += bflo(v.x) * bflo(v.x) + bfhi(v.x) * bfhi(v.x) + bflo(v.y) * bflo(v.y) + bfhi(v.y) * bfhi(v.y) + bflo(v.z) * bflo(v.z) + bfhi(v.z) * bfhi(v.z) + bflo(v.w) * bflo(v.w) + bfhi(v.w) * bfhi(v.w); }
          s1 += __shfl_xor(s1, 1); s1 += __shfl_xor(s1, 2); s1 += __shfl_xor(s1, 4); s2 += __shfl_xor(s2, 1); s2 += __shfl_xor(s2, 2); s2 += __shfl_xor(s2, 4);
          if (sub == 0) { RQ[lt] = 1.0f / sqrtf(s1 * (1.0f / 256.0f) + RMS_EPS); RKV[lt] = 1.0f / sqrtf(s2 * (1.0f / 128.0f) + RMS_EPS); } }
        __syncthreads();
        const float* COS = WSP(float, WS_COS); const float* SIN = WSP(float, WS_SIN);
        bf16_t* QM = WSP(bf16_t, WS_QM); bf16_t* KM = WSP(bf16_t, WS_KM); bf16_t* VM = WSP(bf16_t, WS_VM);
        {
          const bf16_t* WU = WSP(bf16_t, WS_WUQ) + (size_t)l * 384 * 256; f32x4 acc[3][4];
#pragma unroll
          for (int a = 0; a < 3; ++a)
#pragma unroll
              for (int m = 0; m < 4; ++m) acc[a][m] = (f32x4){0.f, 0.f, 0.f, 0.f};
#pragma unroll 1
          for (int kk = 0; kk < 8; ++kk) { bf16x8 bq[4];
#pragma unroll
              for (int m = 0; m < 4; ++m) bq[m] = *(const bf16x8*)(PM + (size_t)(t0 + 16 * m + i) * NPROJ + C_CQ + 32 * kk + 8 * g);
#pragma unroll
              for (int a = 0; a < 3; ++a) { const bf16x8 af = *(const bf16x8*)(WU + (size_t)(16 * (3 * w + a) + i) * 256 + 32 * kk + 8 * g);
#pragma unroll
                  for (int m = 0; m < 4; ++m) acc[a][m] = mfma16(af, bq[m], acc[a][m]); } }
#pragma unroll
          for (int m = 0; m < 4; ++m) { const int tk = 16 * m + i; const float rq = RQ[tk];
#pragma unroll
              for (int a = 0; a < 3; ++a) acc[a][m] = acc[a][m] * rq;
              if (w & 1) { const f32x4 cs = *(const f32x4*)(COS + (size_t)(t0 + tk) * 16 + 4 * g), sn = *(const f32x4*)(SIN + (size_t)(t0 + tk) * 16 + 4 * g);
                  const f32x4 x1 = acc[1][m], x2 = acc[2][m]; acc[1][m] = x1 * cs - x2 * sn; acc[2][m] = x2 * cs + x1 * sn; }
#pragma unroll
              for (int a = 0; a < 3; ++a) { u32x2 o; o.x = pk2(acc[a][m][0], acc[a][m][1]); o.y = pk2(acc[a][m][2], acc[a][m][3]);
                  *(u32x2*)(QM + (size_t)(t0 + tk) * 384 + 16 * (3 * w + a) + 4 * g) = o; } } }
        LAUNDER();
        {
          const bf16_t* WU = WSP(bf16_t, WS_WUKV) + (size_t)l * 512 * 128; f32x4 acc[4][4];
#pragma unroll
          for (int a = 0; a < 4; ++a)
#pragma unroll
              for (int m = 0; m < 4; ++m) acc[a][m] = (f32x4){0.f, 0.f, 0.f, 0.f};
#pragma unroll 1
          for (int kk = 0; kk < 4; ++kk) { bf16x8 bq[4];
#pragma unroll
              for (int m = 0; m < 4; ++m) bq[m] = *(const bf16x8*)(PM + (size_t)(t0 + 16 * m + i) * NPROJ + C_CKV + 32 * kk + 8 * g);
#pragma unroll
              for (int a = 0; a < 4; ++a) { const bf16x8 af = *(const bf16x8*)(WU + (size_t)(16 * (4 * w + a) + i) * 128 + 32 * kk + 8 * g);
#pragma unroll
                  for (int m = 0; m < 4; ++m) acc[a][m] = mfma16(af, bq[m], acc[a][m]); } }
          const int hd = w >> 1;
#pragma unroll
          for (int m = 0; m < 4; ++m) { const int tk = 16 * m + i; const float rk = RKV[tk];
#pragma unroll
              for (int a = 0; a < 4; ++a) { const f32x4 v = acc[a][m] * rk; u32x2 o; o.x = pk2(v[0], v[1]); o.y = pk2(v[2], v[3]);
                  if (w & 1) *(u32x2*)(VM + (size_t)(t0 + tk) * 256 + 64 * hd + 16 * a + 4 * g) = o;
                  else       *(u32x2*)(KM + (size_t)(t0 + tk) * 384 + 96 * hd + 16 * a + 4 * g) = o; } } }
        {
          const int lt = tid >> 3, i0 = (tid & 7) * 2; const bf16_t* pr = PM + (size_t)(t0 + lt) * NPROJ + C_KR;
          const unsigned a = *(const unsigned*)(pr + i0), bb = *(const unsigned*)(pr + 16 + i0);
          const float c0 = COS[(size_t)(t0 + lt) * 16 + i0], c1 = COS[(size_t)(t0 + lt) * 16 + i0 + 1], s0 = SIN[(size_t)(t0 + lt) * 16 + i0], s1 = SIN[(size_t)(t0 + lt) * 16 + i0 + 1];
          const float x10 = bflo(a), x11 = bfhi(a), x20 = bflo(bb), x21 = bfhi(bb);
          const unsigned o1 = pk2(x10 * c0 - x20 * s0, x11 * c1 - x21 * s1), o2 = pk2(x20 * c0 + x10 * s0, x21 * c1 + x11 * s1);
#pragma unroll
          for (int hd = 0; hd < 4; ++hd) { *(unsigned*)(KM + (size_t)(t0 + lt) * 384 + 96 * hd + 64 + i0) = o1; *(unsigned*)(KM + (size_t)(t0 + lt) * 384 + 96 * hd + 80 + i0) = o2; } }
        __syncthreads();
    }
}

template <int DK, bool FOX>
__device__ __forceinline__ void attn_unit(Ctx& C, const bf16_t* Qg, int qp, const bf16_t* Kg, int kp, const bf16_t* Vg, int vp, bf16_t* Og, const float* cumg, int row0, int qb, float qscale) {
    constexpr int KLD = DK + 8, VLD = 72, KBUF = 64 * KLD * 2, VBUF = 64 * VLD * 2, BUFB = KBUF + VBUF + 256, NKK = DK / 32, CPR = DK / 8;
    const int tid = C.tid, lane = C.lane, w = C.wave, g = lane >> 4, i = lane & 15;
    const int q0w = qb * 128 + 16 * w, nt = 2 * (qb + 1);
    bf16x8 qf[NKK];
    { const bf16_t* qrow = Qg + (size_t)(row0 + q0w + i) * qp;
#pragma unroll
      for (int kk = 0; kk < NKK; ++kk) qf[kk] = *(const bf16x8*)(qrow + 32 * kk + 8 * g); }
    const float cq = FOX ? cumg[(size_t)(row0 + q0w + i) * 4] : 0.f;
    f32x4 o[4];
#pragma unroll
    for (int m = 0; m < 4; ++m) o[m] = (f32x4){0.f, 0.f, 0.f, 0.f};
    float mrun = -INFINITY, lsum = 0.f;
    const int kr0 = tid / CPR, kc0 = tid % CPR, kr1 = (tid + NTHR) / CPR, kc1 = (tid + NTHR) % CPR, vr = tid >> 3, vc = tid & 7;
    const bool k1 = (DK == 96) && (tid < 256);
    u32x4 kreg0, kreg1 = {0u, 0u, 0u, 0u}, vreg; float ckreg = 0.f;
#define AT_LOAD(kt) do { const size_t rb_ = (size_t)row0 + 64 * (kt); \
        kreg0 = *(const u32x4*)(Kg + (rb_ + kr0) * kp + 8 * kc0); if (k1) kreg1 = *(const u32x4*)(Kg + (rb_ + kr1) * kp + 8 * kc1); \
        vreg = *(const u32x4*)(Vg + (rb_ + vr) * vp + 8 * vc); if (FOX && tid < 64) ckreg = cumg[(rb_ + tid) * 4]; } while (0)
#define AT_STORE(buf) do { lptr b_ = C.lds + (buf) * BUFB; \
        *(LAS u32x4*)(b_ + (kr0 * KLD + 8 * kc0) * 2) = kreg0; if (k1) *(LAS u32x4*)(b_ + (kr1 * KLD + 8 * kc1) * 2) = kreg1; \
        *(LAS u32x4*)(b_ + KBUF + (vr * VLD + 8 * vc) * 2) = vreg; if (FOX && tid < 64) *(LAS float*)(b_ + KBUF + VBUF + tid * 4) = ckreg; } while (0)
    AT_LOAD(0); AT_STORE(0); __syncthreads();
#pragma unroll 1
    for (int kt = 0; kt < nt; ++kt) {
        const int cur = kt & 1;
        if (kt + 1 < nt) AT_LOAD(kt + 1);
        const bool active = FOX ? (64 * kt <= q0w + 15) : (kt <= (q0w >> 6));
        if (active) {
            lptr kb = C.lds + cur * BUFB; lptr vb = kb + KBUF; lptr ckb = vb + VBUF;
            f32x4 s[4];
#pragma unroll
            for (int n = 0; n < 4; ++n) { s[n] = (f32x4){0.f, 0.f, 0.f, 0.f};
#pragma unroll
                for (int kk = 0; kk < NKK; ++kk) { const bf16x8 a = *(const LAS bf16x8*)(kb + ((16 * n + i) * KLD + 32 * kk + 8 * g) * 2); s[n] = mfma16(a, qf[kk], s[n]); } }
            const bool needmask = FOX && (64 * kt + 63 > q0w);
            float mx = -INFINITY;
            if (FOX) {
#pragma unroll
                for (int n = 0; n < 4; ++n) { const f32x4 ck4 = *(const LAS f32x4*)(ckb + (16 * n + 4 * g) * 4);
#pragma unroll
                    for (int r = 0; r < 4; ++r) { float v = __builtin_fmaf(s[n][r], qscale, cq - ck4[r]);
                        if (needmask && (64 * kt + 16 * n + 4 * g + r > q0w + i)) v = -INFINITY;
                        s[n][r] = v; mx = fmaxf(mx, v); } }
            } else {
#pragma unroll
                for (int n = 0; n < 4; ++n)
#pragma unroll
                    for (int r = 0; r < 4; ++r) mx = fmaxf(mx, s[n][r]);
                mx *= qscale;
            }
            mx = fmaxf(mx, __shfl_xor(mx, 16)); mx = fmaxf(mx, __shfl_xor(mx, 32));
            if (__any(mx > mrun)) {
                const float mnew = fmaxf(mrun, mx), alpha = __builtin_amdgcn_exp2f(mrun - mnew); mrun = mnew; lsum *= alpha;
#pragma unroll
                for (int m = 0; m < 4; ++m) o[m] = o[m] * alpha; }
            float psum = 0.f;
#pragma unroll
            for (int n = 0; n < 4; ++n)
#pragma unroll
                for (int r = 0; r < 4; ++r) { const float p = __builtin_amdgcn_exp2f(FOX ? s[n][r] - mrun : __builtin_fmaf(s[n][r], qscale, -mrun)); s[n][r] = p; psum += p; }
            lsum += psum;
            bf16x8 pf[2];
#pragma unroll
            for (int kk = 0; kk < 2; ++kk) { const unsigned a0 = pk2(s[2 * kk][0], s[2 * kk][1]), a1 = pk2(s[2 * kk][2], s[2 * kk][3]), a2 = pk2(s[2 * kk + 1][0], s[2 * kk + 1][1]), a3 = pk2(s[2 * kk + 1][2], s[2 * kk + 1][3]);
                pf[kk] = __builtin_bit_cast(bf16x8, (u32x4){a0, a1, a2, a3}); }
#pragma unroll
            for (int m = 0; m < 4; ++m)
#pragma unroll
                for (int kk = 0; kk < 2; ++kk) { const bf16x8 a = tr_frag(vb, VLD, 32 * kk + 4 * g, 32 * kk + 16 + 4 * g, 16 * m, lane); o[m] = mfma16(a, pf[kk], o[m]); }
        }
        if (kt + 1 < nt) AT_STORE(cur ^ 1);
        __syncthreads();
    }
#undef AT_LOAD
#undef AT_STORE
    lsum += __shfl_xor(lsum, 16); lsum += __shfl_xor(lsum, 32);
    const float inv = 1.0f / lsum; bf16_t* orow = Og + (size_t)(row0 + q0w + i) * DM;
#pragma unroll
    for (int m = 0; m < 4; ++m) { u32x2 ov; ov.x = pk2(o[m][0] * inv, o[m][1] * inv); ov.y = pk2(o[m][2] * inv, o[m][3] * inv); *(u32x2*)(orow + 16 * m + 4 * g) = ov; }
}

template <int DK, bool FOX>
__device__ __forceinline__ void attn_half(lptr lds, int htid, int hw, int lane, const bf16_t* Qg, int qp, const bf16_t* Kg, int kp, const bf16_t* Vg, int vp, bf16_t* Og, const float* cumg, int row0, int qb, float qscale) {
    constexpr int KLD = DK + 8, VLD = 72, KBUF = 64 * KLD * 2, VBUF = 64 * VLD * 2, BUFB = KBUF + VBUF + 256, NKK = DK / 32, CPR = DK / 8, NKC = (64 * CPR) / 256;
    asm volatile("" : "+s"(Qg), "+s"(Kg), "+s"(Vg), "+s"(Og), "+s"(cumg), "+v"(htid), "+v"(lane));
    const int g = lane >> 4, i = lane & 15;
    const int q0w = qb * 128 + 32 * hw, nt = 2 * (qb + 1);
    bf16x8 qf[2][NKK]; float cq[2];
#pragma unroll
    for (int mq = 0; mq < 2; ++mq) { const bf16_t* qrow = Qg + (size_t)(row0 + q0w + 16 * mq + i) * qp;
#pragma unroll
        for (int kk = 0; kk < NKK; ++kk) qf[mq][kk] = *(const bf16x8*)(qrow + 32 * kk + 8 * g);
        cq[mq] = FOX ? cumg[(size_t)(row0 + q0w + 16 * mq + i) * 4] : 0.f; }
    f32x4 o[2][4];
#pragma unroll
    for (int mq = 0; mq < 2; ++mq)
#pragma unroll
        for (int m = 0; m < 4; ++m) o[mq][m] = (f32x4){0.f, 0.f, 0.f, 0.f};
    float mrun[2] = {-INFINITY, -INFINITY}, lsum[2] = {0.f, 0.f};
    u32x4 kreg[NKC], vreg[2]; float ckreg = 0.f;
    unsigned kgo[NKC], klo[NKC], vgo[2], vlo[2];
#pragma unroll
    for (int c_ = 0; c_ < NKC; ++c_) { const int id_ = htid + 256 * c_; kgo[c_] = (unsigned)((id_ / CPR) * kp + 8 * (id_ % CPR)) * 2u; klo[c_] = (unsigned)((id_ / CPR) * KLD + 8 * (id_ % CPR)) * 2u; }
#pragma unroll
    for (int c_ = 0; c_ < 2; ++c_) { const int id_ = htid + 256 * c_; vgo[c_] = (unsigned)((id_ >> 3) * vp + 8 * (id_ & 7)) * 2u; vlo[c_] = (unsigned)(KBUF + ((id_ >> 3) * VLD + 8 * (id_ & 7)) * 2); }
#define AH_LOAD(kt) do { const size_t rb_ = (size_t)row0 + 64 * (kt); const char* kbase_ = (const char*)(Kg + rb_ * kp); const char* vbase_ = (const char*)(Vg + rb_ * vp); \
        _Pragma("unroll") for (int c_ = 0; c_ < NKC; ++c_) kreg[c_] = *(const u32x4*)(kbase_ + kgo[c_]); \
        _Pragma("unroll") for (int c_ = 0; c_ < 2; ++c_) vreg[c_] = *(const u32x4*)(vbase_ + vgo[c_]); \
        if (FOX && htid < 64) ckreg = cumg[(rb_ + htid) * 4]; } while (0)
#define AH_STORE(buf) do { lptr b_ = lds + (buf) * BUFB; \
        _Pragma("unroll") for (int c_ = 0; c_ < NKC; ++c_) *(LAS u32x4*)(b_ + klo[c_]) = kreg[c_]; \
        _Pragma("unroll") for (int c_ = 0; c_ < 2; ++c_) *(LAS u32x4*)(b_ + vlo[c_]) = vreg[c_]; \
        if (FOX && htid < 64) *(LAS float*)(b_ + KBUF + VBUF + htid * 4) = ckreg; } while (0)
    AH_LOAD(0); AH_STORE(0); __syncthreads();
#pragma unroll 1
    for (int kt = 0; kt < nt; ++kt) {
        const int cur = kt & 1;
        if (kt + 1 < nt) AH_LOAD(kt + 1);
        const bool active = FOX ? (64 * kt <= q0w + 31) : (kt <= (q0w >> 6));
        if (active) {
            lptr kb = lds + cur * BUFB; lptr vb = kb + KBUF; lptr ckb = vb + VBUF;
            f32x4 s[2][4];
#pragma unroll
            for (int n = 0; n < 4; ++n) { s[0][n] = (f32x4){0.f, 0.f, 0.f, 0.f}; s[1][n] = (f32x4){0.f, 0.f, 0.f, 0.f};
#pragma unroll
                for (int kk = 0; kk < NKK; ++kk) { const bf16x8 a = *(const LAS bf16x8*)(kb + ((16 * n + i) * KLD + 32 * kk + 8 * g) * 2); s[0][n] = mfma16(a, qf[0][kk], s[0][n]); s[1][n] = mfma16(a, qf[1][kk], s[1][n]); }
                if (n & 1) __builtin_amdgcn_sched_barrier(0); }
            const bool needmask = FOX && (64 * kt + 63 > q0w);
            float mx[2] = {-INFINITY, -INFINITY};
            if (FOX) {
#pragma unroll
                for (int n = 0; n < 4; ++n) { const f32x4 ck4 = *(const LAS f32x4*)(ckb + (16 * n + 4 * g) * 4);
#pragma unroll
                    for (int mq = 0; mq < 2; ++mq)
#pragma unroll
                        for (int r = 0; r < 4; ++r) { float v = __builtin_fmaf(s[mq][n][r], qscale, cq[mq] - ck4[r]);
                            if (needmask && (64 * kt + 16 * n + 4 * g + r > q0w + 16 * mq + i)) v = -INFINITY;
                            s[mq][n][r] = v; mx[mq] = fmaxf(mx[mq], v); } }
            } else {
#pragma unroll
                for (int mq = 0; mq < 2; ++mq) {
#pragma unroll
                    for (int n = 0; n < 4; ++n)
#pragma unroll
                        for (int r = 0; r < 4; ++r) mx[mq] = fmaxf(mx[mq], s[mq][n][r]);
                    mx[mq] *= qscale; }
            }
#pragma unroll
            for (int mq = 0; mq < 2; ++mq) { mx[mq] = fmaxf(mx[mq], __shfl_xor(mx[mq], 16)); mx[mq] = fmaxf(mx[mq], __shfl_xor(mx[mq], 32)); }
            if (__any(mx[0] > mrun[0] || mx[1] > mrun[1])) {
#pragma unroll
                for (int mq = 0; mq < 2; ++mq) { const float mnew = fmaxf(mrun[mq], mx[mq]), alpha = __builtin_amdgcn_exp2f(mrun[mq] - mnew); mrun[mq] = mnew; lsum[mq] *= alpha;
#pragma unroll
                    for (int m = 0; m < 4; ++m) o[mq][m] = o[mq][m] * alpha; } }
            bf16x8 pf[2][2];
#pragma unroll
            for (int mq = 0; mq < 2; ++mq) { float psum = 0.f;
#pragma unroll
                for (int n = 0; n < 4; ++n)
#pragma unroll
                    for (int r = 0; r < 4; ++r) { const float p = __builtin_amdgcn_exp2f(FOX ? s[mq][n][r] - mrun[mq] : __builtin_fmaf(s[mq][n][r], qscale, -mrun[mq])); s[mq][n][r] = p; psum += p; }
                lsum[mq] += psum;
#pragma unroll
                for (int kk = 0; kk < 2; ++kk) { const unsigned a0 = pk2(s[mq][2 * kk][0], s[mq][2 * kk][1]), a1 = pk2(s[mq][2 * kk][2], s[mq][2 * kk][3]), a2 = pk2(s[mq][2 * kk + 1][0], s[mq][2 * kk + 1][1]), a3 = pk2(s[mq][2 * kk + 1][2], s[mq][2 * kk + 1][3]);
                    pf[mq][kk] = __builtin_bit_cast(bf16x8, (u32x4){a0, a1, a2, a3}); } }
#pragma unroll
            for (int m = 0; m < 4; ++m)
#pragma unroll
                for (int kk = 0; kk < 2; ++kk) { const bf16x8 a = tr_frag(vb, VLD, 32 * kk + 4 * g, 32 * kk + 16 + 4 * g, 16 * m, lane); o[0][m] = mfma16(a, pf[0][kk], o[0][m]); o[1][m] = mfma16(a, pf[1][kk], o[1][m]);
                    if (kk) __builtin_amdgcn_sched_barrier(0); }
        }
        if (kt + 1 < nt) AH_STORE(cur ^ 1);
        __syncthreads();
    }
#undef AH_LOAD
#undef AH_STORE
#pragma unroll
    for (int mq = 0; mq < 2; ++mq) { float ls = lsum[mq]; ls += __shfl_xor(ls, 16); ls += __shfl_xor(ls, 32);
        const float inv = 1.0f / ls; bf16_t* orow = Og + (size_t)(row0 + q0w + 16 * mq + i) * DM;
#pragma unroll
        for (int m = 0; m < 4; ++m) { u32x2 ov; ov.x = pk2(o[mq][m][0] * inv, o[mq][m][1] * inv); ov.y = pk2(o[mq][m][2] * inv, o[mq][m][3] * inv); *(u32x2*)(orow + 16 * m + 4 * g) = ov; } }
}

__device__ __forceinline__ void ssd_scan(Ctx& C) {
    typedef float f32x2 __attribute__((ext_vector_type(2)));
    const float* STG = WSP(float, WS_ST); const float* CD = WSP(float, WS_CDEC); bf16_t* PRV = WSP(bf16_t, WS_PREV);
    for (int gid = C.bx * NTHR + C.tid; gid < 65536; gid += C.G * NTHR) { const int b = gid >> 13, rem = gid & 8191, h = rem >> 11, f = rem & 2047;
        f32x2 acc = {0.f, 0.f};
#pragma unroll 1
        for (int c0 = 0; c0 < 32; c0 += 16) { f32x2 v[16]; float d[16];
#pragma unroll
            for (int k = 0; k < 16; ++k) { const int cuu = b * 32 + c0 + k; v[k] = *(const f32x2*)(STG + (size_t)(cuu * 4 + h) * 4096 + f * 2); d[k] = CD[cuu * 4 + h]; }
#pragma unroll
            for (int k = 0; k < 16; ++k) { const int cuu = b * 32 + c0 + k; *(unsigned*)(PRV + (size_t)(cuu * 4 + h) * 4096 + f * 2) = pk2(acc.x, acc.y); acc = acc * d[k] + v[k]; } } }
}

__device__ __forceinline__ void p3_ssd_unit(Ctx& C, int l, int cu) {
    const int b = cu >> 5, c = cu & 31, t0 = cu * 64; const int tid = C.tid, lane = C.lane, w = C.wave, g = lane >> 4, i = lane & 15;
    const bf16_t* PM = WSP(bf16_t, WS_PM); bf16_t* Y = WSP(bf16_t, WS_S1);
    ssd_fill(C, l, cu);
    const LAS float* AC = (const LAS float*)(C.lds + ACUM_OFF); const LAS float* DT = (const LAS float*)(C.lds + DT_OFF);
    { const bf16_t* PRV = WSP(bf16_t, WS_PREV) + (size_t)cu * 16384;
#pragma unroll
      for (int k = 0; k < 4; ++k) { const int f = tid + NTHR * k, h = f >> 9, rem = f & 511, p = rem >> 3, n = (rem & 7) * 8;
          *(LAS u32x4*)(C.lds + PV_OFF + ((h * 64 + p) * ML_LD + n) * 2) = *(const u32x4*)(PRV + (size_t)f * 8); } }
    __syncthreads();
    const int h = w >> 1, rh = w & 1, grp = h >> 1; lptr MLw = C.lds + ML_OFF + w * (32 * ML_LD * 2);
    const float Dh = C.a->in[10][l * 4 + h];
#pragma unroll 1
    for (int mbl = 0; mbl < 2; ++mbl) { const int mb = 2 * rh + mbl;
#pragma unroll
        for (int nb = 0; nb < 4; ++nb) { f32x4 acc = {0.f, 0.f, 0.f, 0.f};
#pragma unroll
            for (int kk = 0; kk < 2; ++kk) { const bf16x8 a = *(const LAS bf16x8*)(C.lds + CL_OFF + ((16 * mb + i) * BC_LD + 64 * grp + 32 * kk + 8 * g) * 2);
                const bf16x8 bq = *(const LAS bf16x8*)(C.lds + BL_OFF + ((16 * nb + i) * BC_LD + 64 * grp + 32 * kk + 8 * g) * 2); acc = mfma16(a, bq, acc); }
            const int s = 16 * nb + i; const float as = AC[s * 4 + h], ds = DT[s * 4 + h];
#pragma unroll
            for (int r = 0; r < 4; ++r) { const int lr = 16 * mb + 4 * g + r; const float v = (s <= lr) ? acc[r] * __expf(AC[lr * 4 + h] - as) * ds : 0.f;
                *(LAS unsigned short*)(MLw + ((16 * mbl + 4 * g + r) * ML_LD + s) * 2) = (unsigned short)f2bf(v); } }
        LDS_WAIT(); asm volatile("" ::: "memory");
        f32x4 ad[4], ao[4];
#pragma unroll
        for (int nb = 0; nb < 4; ++nb) { ad[nb] = (f32x4){0.f, 0.f, 0.f, 0.f}; ao[nb] = (f32x4){0.f, 0.f, 0.f, 0.f};
#pragma unroll
            for (int kk = 0; kk < 2; ++kk) {
                const bf16x8 a = *(const LAS bf16x8*)(MLw + ((16 * mbl + i) * ML_LD + 32 * kk + 8 * g) * 2);
                const bf16x8 bx = tr_frag(C.lds + XS_OFF, XS_LD, 32 * kk + 8 * g, 32 * kk + 8 * g + 4, 64 * h + 16 * nb, lane);
                ad[nb] = mfma16(a, bx, ad[nb]);
                const bf16x8 a2 = *(const LAS bf16x8*)(C.lds + CL_OFF + ((16 * mb + i) * BC_LD + 64 * grp + 32 * kk + 8 * g) * 2);
                const bf16x8 b2 = *(const LAS bf16x8*)(C.lds + PV_OFF + ((h * 64 + 16 * nb + i) * ML_LD + 32 * kk + 8 * g) * 2);
                ao[nb] = mfma16(a2, b2, ao[nb]); } }
        LDS_WAIT(); asm volatile("" ::: "memory");
        float ssq[4] = {0.f, 0.f, 0.f, 0.f};
#pragma unroll
        for (int nb = 0; nb < 4; ++nb)
#pragma unroll
            for (int r = 0; r < 4; ++r) { const int lr = 16 * mb + 4 * g + r; const int ch = 64 * h + 16 * nb + i;
                const float xs = bf2f(*(const LAS unsigned short*)(C.lds + XS_OFF + (lr * XS_LD + ch) * 2));
                float y = ad[nb][r] + __expf(AC[lr * 4 + h]) * ao[nb][r] + Dh * xs;
                const float z = bf2f(PM[(size_t)(t0 + lr) * NPROJ + C_Z + ch]); y *= silu_f(z);
                ssq[r] += y * y;
                *(LAS unsigned short*)(MLw + ((16 * mbl + 4 * g + r) * ML_LD + 16 * nb + i) * 2) = (unsigned short)f2bf(y); }
#pragma unroll
        for (int r = 0; r < 4; ++r) { float q = ssq[r]; q += __shfl_xor(q, 1); q += __shfl_xor(q, 2); q += __shfl_xor(q, 4); q += __shfl_xor(q, 8);
            if (i == 0) ((LAS float*)(C.lds + SSQ_OFF))[(16 * mb + 4 * g + r) * 4 + h] = q; } }
    __syncthreads();
    { const float* gn = C.a->in[11] + l * 256;
      const int lr_l = lane >> 1, hf = lane & 1, lr = 32 * rh + lr_l; const f32x4 q4 = *(const LAS f32x4*)(C.lds + SSQ_OFF + lr * 16);
      const float rs = 1.0f / sqrtf(((q4.x + q4.y) + (q4.z + q4.w)) * (1.0f / 256.0f) + RMS_EPS);
#pragma unroll
      for (int k = 0; k < 4; ++k) { const int ch = 64 * h + 32 * hf + 8 * k; const u32x4 yv = *(const LAS u32x4*)(MLw + (lr_l * ML_LD + 32 * hf + 8 * k) * 2);
          u32x4 o; o.x = pk2(bflo(yv.x) * rs * gn[ch + 0], bfhi(yv.x) * rs * gn[ch + 1]); o.y = pk2(bflo(yv.y) * rs * gn[ch + 2], bfhi(yv.y) * rs * gn[ch + 3]);
          o.z = pk2(bflo(yv.z) * rs * gn[ch + 4], bfhi(yv.z) * rs * gn[ch + 5]); o.w = pk2(bflo(yv.w) * rs * gn[ch + 6], bfhi(yv.w) * rs * gn[ch + 7]);
          *(u32x4*)(Y + (size_t)(t0 + lr) * DM + 512 + ch) = o; } }
    __syncthreads();
}

__device__ __forceinline__ void moe_tables(Ctx& C, int l) {
    LAS int* cnt = (LAS int*)(C.lds + LDS_SCR + SCR_CNT); LAS int* tb = (LAS int*)(C.lds + LDS_SCR + SCR_TBASE); LAS int* te = (LAS int*)(C.lds + LDS_SCR + SCR_TILEE); LAS int* ntp = (LAS int*)(C.lds + LDS_SCR + SCR_NT);
    if (C.tid < 32) cnt[C.tid] = (int)__hip_atomic_load(WSP(unsigned, WS_CTL) + CW_CNT + l * 32 + C.tid, __ATOMIC_RELAXED, __HIP_MEMORY_SCOPE_AGENT);
    __syncthreads();
    if (C.tid == 0) { int a = 0; for (int e = 0; e < 32; ++e) { tb[e] = a; a += (cnt[e] + 255) >> 8; } tb[32] = a; *ntp = a; }
    __syncthreads();
    if (C.tid < 160) { int e = 0; for (int k = 1; k < 32; ++k) if (tb[k] <= C.tid) e = k; te[C.tid] = e; }
    __syncthreads();
}
template <int NPN> struct MoeOrder {
    static constexpr int npn = NPN; int G, c; const LAS int* cnt; const LAS int* tb; const LAS int* te; int ntile; const int* rowl;
    __device__ __forceinline__ bool next(int i, pg8::Unit& u) const {
        const int L = i * G + c; if (L >= ntile * npn) return false;
        const int ti = L / npn, pnl = L % npn; const int e = __builtin_amdgcn_readfirstlane(te[ti]);
        u.pm = ti; u.pn = e * npn + pnl; u.e = e; u.r0 = (ti - __builtin_amdgcn_readfirstlane(tb[e])) * 256; u.ne = __builtin_amdgcn_readfirstlane(cnt[e]); return true;
    }
    __device__ __forceinline__ int arow(const pg8::Unit& u, int r) const { const int rr = u.r0 + r; return rr < u.ne ? rowl[(size_t)u.e * T + rr] : 0; }
    __device__ __forceinline__ void a_ready(const pg8::Unit&) const {}
    __device__ __forceinline__ void done(const pg8::Unit&) const {}
};

__device__ __forceinline__ TrItem p5_item(Ctx& C, int l, int it, int lane) {
    const int e = it / 384, r = it % 384, c4 = (lane & 7) * 4; TrItem t;
    if (r < 256) { const int kb = r >> 4, nb = r & 15, n = 32 * nb, pn = n >> 8, bj = (n >> 7) & 1, ff = (n & 127) + c4;
        t.W = (bj ? C.a->in[23] : C.a->in[22]) + (size_t)(l * 32 + e) * 1024 * 256; t.ldw = 256; t.scol4 = 128 * pn + ff; t.k0 = 64 * kb; t.gk = C.a->in[17] + l * 1024;
        t.dst = WSP(bf16_t, WS_BGU) + (size_t)e * 512 * 1024 + (size_t)(32 * nb) * 1024 + 64 * kb; t.K = 1024; }
    else { const int r2 = r - 256, kb = r2 >> 5, nb = r2 & 31;
        t.W = C.a->in[24] + (size_t)(l * 32 + e) * 256 * 1024; t.ldw = 1024; t.scol4 = 32 * nb + c4; t.k0 = 64 * kb; t.gk = nullptr;
        t.dst = WSP(bf16_t, WS_BD) + (size_t)e * 1024 * 256 + (size_t)(32 * nb) * 256 + 64 * kb; t.K = 256; }
    return t;
}
__device__ __forceinline__ void p5_router(Ctx& C, int l, int en) {
    const int gw = C.bx * NWAVES + C.wave, NGW = C.G * NWAVES, lane = C.lane;
    if (!(en & 16)) return;
    { LAS float* scr = (LAS float*)(C.lds + C.wave * 8704); f32x4 cur[8], nx[8]; int it = gw;
      if (it < 32 * 384) { TrItem t = p5_item(C, l, it, lane); tr_load(t, cur, lane); }
#pragma unroll 1
      for (; it < 32 * 384; it += NGW) { const bool more = it + NGW < 32 * 384;
          if (more) { TrItem tn = p5_item(C, l, it + NGW, lane); tr_load(tn, nx, lane); }
          TrItem t = p5_item(C, l, it, lane); tr_store(t, cur, scr, lane);
#pragma unroll
          for (int i = 0; i < 8; ++i) cur[i] = nx[i]; } }
    __syncthreads();
    LAS float* WR = (LAS float*)C.lds;
    { const f32x4* src = (const f32x4*)(WSP(float, WS_WR) + (size_t)l * 36864);
#pragma unroll 1
      for (int it = 0; it < 18; it += 6) { f32x4 v[6];
#pragma unroll
          for (int k = 0; k < 6; ++k) v[k] = src[C.tid + NTHR * (it + k)];
#pragma unroll
          for (int k = 0; k < 6; ++k) ((LAS f32x4*)WR)[C.tid + NTHR * (it + k)] = v[k]; } }
    LAS int* cntL = (LAS int*)(C.lds + LDS_SCR + SCR_CNT); LAS int* baseL = (LAS int*)(C.lds + LDS_SCR + SCR_TBASE);
    const float* X1 = WSP(float, WS_X1); bf16_t* HB = WSP(bf16_t, WS_S1);
    unsigned* CNT = WSP(unsigned, WS_CTL) + CW_CNT + l * 32; int* ROWL = WSP(int, WS_ROWL); int* TE = WSP(int, WS_TOKE); int* TP = WSP(int, WS_TOKP); float* TW = WSP(float, WS_TOKW);
    for (int chunk = C.bx; chunk < T / 64; chunk += C.G) {
        if (C.tid < 32) cntL[C.tid] = 0;
        __syncthreads();
        const int tb0 = chunk * 64 + C.wave * 8; int mE0 = 0, mE1 = 0; float mW0 = 0.f, mW1 = 0.f;
        f32x4 xn[4];
        { const f32x4* xr = (const f32x4*)(X1 + (size_t)tb0 * DM) + lane;
#pragma unroll
          for (int j = 0; j < 4; ++j) xn[j] = xr[64 * j]; }
#pragma unroll 1
        for (int jt = 0; jt < 8; ++jt) { const int t = tb0 + jt;
            f32x4 xv[4];
#pragma unroll
            for (int j = 0; j < 4; ++j) xv[j] = xn[j];
            if (jt + 1 < 8) { const f32x4* xr = (const f32x4*)(X1 + (size_t)(t + 1) * DM) + lane;
#pragma unroll
                for (int j = 0; j < 4; ++j) xn[j] = xr[64 * j]; }
            float sq = 0.f;
#pragma unroll
            for (int j = 0; j < 4; ++j) sq += (xv[j].x * xv[j].x + xv[j].y * xv[j].y) + (xv[j].z * xv[j].z + xv[j].w * xv[j].w);
            const float rstd = 1.0f / sqrtf(wave_sum(sq) * (1.0f / DM) + RMS_EPS);
            { u32x2* o8 = (u32x2*)(HB + (size_t)t * DM) + lane;
#pragma unroll
              for (int j = 0; j < 4; ++j) { u32x2 wv; wv.x = pk2(xv[j].x * rstd, xv[j].y * rstd); wv.y = pk2(xv[j].z * rstd, xv[j].w * rstd); o8[64 * j] = wv; } }
            float lg[4];
#pragma unroll
            for (int cc = 0; cc < 4; ++cc) { float p = 0.f;
#pragma unroll
                for (int j = 0; j < 4; ++j) { const f32x4 wv = *(const LAS f32x4*)(WR + cc * 1024 + 256 * j + 4 * lane); p += (xv[j].x * wv.x + xv[j].y * wv.y) + (xv[j].z * wv.z + xv[j].w * wv.w); }
                lg[cc] = wave_sum(p) * rstd + C.a->in[19][l * 4 + cc]; }
            int gi = 0; float gm = lg[0];
#pragma unroll
            for (int cc = 1; cc < 4; ++cc) if (lg[cc] > gm) { gm = lg[cc]; gi = cc; }
            float gs = 0.f;
#pragma unroll
            for (int cc = 0; cc < 4; ++cc) gs += __expf(lg[cc] - gm);
            const float gwt = 1.0f / gs;
            gi = __builtin_amdgcn_readfirstlane(gi);
            float le[8];
#pragma unroll
            for (int e = 0; e < 8; ++e) { float p = 0.f; const LAS float* wrow = WR + (4 + 8 * gi + e) * 1024;
#pragma unroll
                for (int j = 0; j < 4; ++j) { const f32x4 wv = *(const LAS f32x4*)(wrow + 256 * j + 4 * lane); p += (xv[j].x * wv.x + xv[j].y * wv.y) + (xv[j].z * wv.z + xv[j].w * wv.w); }
                le[e] = wave_sum(p) * rstd + C.a->in[21][l * 32 + 8 * gi + e]; }
            int e0 = 0; float m0 = le[0];
#pragma unroll
            for (int e = 1; e < 8; ++e) if (le[e] > m0) { m0 = le[e]; e0 = e; }
            int e1 = -1; float m1 = -INFINITY;
#pragma unroll
            for (int e = 0; e < 8; ++e) if (e != e0 && le[e] > m1) { m1 = le[e]; e1 = e; }
            const float w0 = 1.0f / (1.0f + __expf(m1 - m0)), w1 = 1.0f - w0;
            if (lane == jt) { mE0 = 8 * gi + e0; mE1 = 8 * gi + e1; mW0 = gwt * w0; mW1 = gwt * w1; }
        }
        int r0 = 0, r1 = 0;
        if (lane < 8) { r0 = __hip_atomic_fetch_add(cntL + mE0, 1, __ATOMIC_RELAXED, __HIP_MEMORY_SCOPE_WORKGROUP); r1 = __hip_atomic_fetch_add(cntL + mE1, 1, __ATOMIC_RELAXED, __HIP_MEMORY_SCOPE_WORKGROUP); }
        __syncthreads();
        if (C.tid < 32) { const int n = cntL[C.tid]; baseL[C.tid] = n ? (int)__hip_atomic_fetch_add(CNT + C.tid, (unsigned)n, __ATOMIC_RELAXED, __HIP_MEMORY_SCOPE_AGENT) : 0; }
        __syncthreads();
        if (lane < 8) { const int t = tb0 + lane; const int p0 = baseL[mE0] + r0, p1 = baseL[mE1] + r1;
            ROWL[(size_t)mE0 * T + p0] = t; ROWL[(size_t)mE1 * T + p1] = t;
            TE[t * 2] = mE0; TE[t * 2 + 1] = mE1; TP[t * 2] = p0; TP[t * 2 + 1] = p1; TW[t * 2] = mW0; TW[t * 2 + 1] = mW1; }
        __syncthreads();
    }
}

__device__ __forceinline__ void p7_combine(Ctx& C, int l, int en, bool last_layer) {
    const int gw = C.bx * NWAVES + C.wave, NGW = C.G * NWAVES, lane = C.lane;
    const LAS int* tb = (const LAS int*)(C.lds + LDS_SCR + SCR_TBASE);
    const bool moe = (en & 16) != 0;
    if (moe) moe_tables(C, l);
    float* X1 = WSP(float, WS_X1); const bf16_t* YS = WSP(bf16_t, WS_PM); const int* TE = WSP(int, WS_TOKE); const int* TP = WSP(int, WS_TOKP); const float* TW = WSP(float, WS_TOKW);
    for (int tbase = gw; tbase < T; tbase += 64 * NGW) {
        int ms0 = 0, ms1 = 0; float mw0 = 0.f, mw1 = 0.f;
        { const int t = tbase + lane * NGW;
          if (moe && t < T) { const int e0 = TE[t * 2], e1 = TE[t * 2 + 1]; ms0 = tb[e0] * 256 + TP[t * 2]; ms1 = tb[e1] * 256 + TP[t * 2 + 1]; mw0 = TW[t * 2]; mw1 = TW[t * 2 + 1]; } }
#pragma unroll 1
        for (int j0 = 0; j0 < 64; j0 += 2) { const int ta = tbase + j0 * NGW; if (ta >= T) break;
            const int tb2 = ta + NGW; const bool two = tb2 < T; const int tbb = two ? tb2 : ta;
            f32x4* xra = (f32x4*)(X1 + (size_t)ta * DM) + lane; f32x4* xrb = (f32x4*)(X1 + (size_t)tbb * DM) + lane; f32x4 xa[4], xb[4];
#pragma unroll
            for (int j = 0; j < 4; ++j) { xa[j] = xra[64 * j]; xb[j] = xrb[64 * j]; }
            if (moe) {
                const int sa0 = __builtin_amdgcn_readlane(ms0, j0), sa1 = __builtin_amdgcn_readlane(ms1, j0), sb0 = __builtin_amdgcn_readlane(ms0, j0 + 1), sb1 = __builtin_amdgcn_readlane(ms1, j0 + 1);
                const float wa0 = __builtin_bit_cast(float, __builtin_amdgcn_readlane(__builtin_bit_cast(int, mw0), j0)), wa1 = __builtin_bit_cast(float, __builtin_amdgcn_readlane(__builtin_bit_cast(int, mw1), j0));
                const float wb0 = __builtin_bit_cast(float, __builtin_amdgcn_readlane(__builtin_bit_cast(int, mw0), j0 + 1)), wb1 = __builtin_bit_cast(float, __builtin_amdgcn_readlane(__builtin_bit_cast(int, mw1), j0 + 1));
                const u32x2* ya0 = (const u32x2*)(YS + (size_t)sa0 * DM) + lane; const u32x2* ya1 = (const u32x2*)(YS + (size_t)sa1 * DM) + lane;
                const u32x2* yb0 = (const u32x2*)(YS + (size_t)sb0 * DM) + lane; const u32x2* yb1 = (const u32x2*)(YS + (size_t)sb1 * DM) + lane;
                u32x2 va0[4], va1[4], vb0[4], vb1[4];
#pragma unroll
                for (int j = 0; j < 4; ++j) { va0[j] = ya0[64 * j]; va1[j] = ya1[64 * j]; vb0[j] = yb0[64 * j]; vb1[j] = yb1[64 * j]; }
#pragma unroll
                for (int j = 0; j < 4; ++j) {
                    xa[j].x += wa0 * bflo(va0[j].x) + wa1 * bflo(va1[j].x); xa[j].y += wa0 * bfhi(va0[j].x) + wa1 * bfhi(va1[j].x); xa[j].z += wa0 * bflo(va0[j].y) + wa1 * bflo(va1[j].y); xa[j].w += wa0 * bfhi(va0[j].y) + wa1 * bfhi(va1[j].y);
                    xb[j].x += wb0 * bflo(vb0[j].x) + wb1 * bflo(vb1[j].x); xb[j].y += wb0 * bfhi(vb0[j].x) + wb1 * bfhi(vb1[j].x); xb[j].z += wb0 * bflo(vb0[j].y) + wb1 * bflo(vb1[j].y); xb[j].w += wb0 * bfhi(vb0[j].y) + wb1 * bfhi(vb1[j].y); } }
            float sa = 0.f, sb = 0.f;
#pragma unroll
            for (int j = 0; j < 4; ++j) { sa += (xa[j].x * xa[j].x + xa[j].y * xa[j].y) + (xa[j].z * xa[j].z + xa[j].w * xa[j].w); sb += (xb[j].x * xb[j].x + xb[j].y * xb[j].y) + (xb[j].z * xb[j].z + xb[j].w * xb[j].w); }
            const float ra = 1.0f / sqrtf(wave_sum(sa) * (1.0f / DM) + RMS_EPS), rb = 1.0f / sqrtf(wave_sum(sb) * (1.0f / DM) + RMS_EPS);
            if (last_layer) { f32x4* oa = (f32x4*)(C.out + (size_t)ta * DM) + lane; f32x4* ob = (f32x4*)(C.out + (size_t)tbb * DM) + lane; const f32x4* gn = (const f32x4*)C.a->in[25] + lane;
#pragma unroll
                for (int j = 0; j < 4; ++j) { const f32x4 g4 = gn[64 * j]; oa[64 * j] = xa[j] * ra * g4; if (two) ob[64 * j] = xb[j] * rb * g4; } }
            else {
#pragma unroll
                for (int j = 0; j < 4; ++j) { xra[64 * j] = xa[j]; if (two) xrb[64 * j] = xb[j]; }
                if (lane == 0) { WSP(float, WS_RSTD)[ta] = ra; if (two) WSP(float, WS_RSTD)[tbb] = rb; }
                u32x2* oa = (u32x2*)(WSP(bf16_t, WS_S1) + (size_t)ta * DM) + lane; u32x2* ob = (u32x2*)(WSP(bf16_t, WS_S1) + (size_t)tbb * DM) + lane;
#pragma unroll
                for (int j = 0; j < 4; ++j) { u32x2 wv; wv.x = pk2(xa[j].x, xa[j].y); wv.y = pk2(xa[j].z, xa[j].w); oa[64 * j] = wv;
                    if (two) { u32x2 w2; w2.x = pk2(xb[j].x, xb[j].y); w2.y = pk2(xb[j].z, xb[j].w); ob[64 * j] = w2; } } }
        }
    }
}

#ifndef PHMASK
#define PHMASK 0x3ff
#endif
#define IN(k) (((PHMASK >> ((k) == 0 ? 0 : (((k) - 1) % NPL) + 1)) & 1) && lo <= (k) && (k) < hi && ((k) == 0 || ((((k) - 1) % NPL) + 1 >= PLO && (((k) - 1) % NPL) + 1 < PHI)))
#define SEAM(k) do { if (IN(k) && IN((k) + 1)) xcd_barrier(bar); } while (0)
#ifndef REP_PHASE
#define REP_PHASE -1
#endif
#define PH_BEGIN(k) if (IN(k)) {
#define PH_END }
template <int l, int PLO = 1, int PHI = NPL + 1>
__device__ __forceinline__ void layer_phases(Ctx& C, const XcdBarrier& bar, int lo_, int hi_) {
#if MK_SPLIT
    const int lo = lo_, hi = hi_;
#else
    constexpr int lo = 0, hi = NPHASE;
#endif
        const int en = l ? EN1 : EN0; const int pb = NPL * l; const bool lastl = (l == (EN_L1 ? 1 : 0));
        LAUNDER();
        PH_BEGIN(pb + 1)
            pg8::Gemm gm{WSP(bf16_t, WS_S1), WSP(bf16_t, WS_WIN) + (size_t)l * NPROJ * 1024, T, NPROJ, DM}; pg8::StaticOrder S; S.init(T, NPROJ, C.G, C.bx);
            pg8::EpiInProj E{WSP(bf16_t, WS_PM), NPROJ, WSP(float, WS_RSTD), WSP(float, WS_FD), 10};
            pg8::gemm_phase<pg8::EpiInProj, pg8::StaticOrder, true, true>(C.lds, gm, S, E);
        PH_END
        SEAM(pb + 1);
        LAUNDER();
        PH_BEGIN(pb + 2) for (int cu = C.bx; cu < NCHK; cu += C.G) p2_unit(C, l, cu, en); PH_END
        SEAM(pb + 2);
        LAUNDER();
        PH_BEGIN(pb + 3)
            bf16_t* Y = WSP(bf16_t, WS_S1); const bf16_t* PM = WSP(bf16_t, WS_PM);
            if (en & 4) ssd_scan(C);
            if ((en & 10) == 10) {
                constexpr int FOXB = 2 * (64 * 72 * 2 + 64 * 72 * 2 + 256);
                for (int pu = C.bx; pu < 256; pu += C.G) { const int bh = pu >> 3, s = pu & 7, b = bh >> 2, h = bh & 3, row0 = b * SEQ;
#pragma unroll 1
                    for (int st = 0; st < 2; ++st) { const int qb = st ? s : 15 - s;
                        if (C.wave < 4) attn_half<64, true>(C.lds, C.tid, C.wave, C.lane, PM + C_FQ + 64 * h, NPROJ, PM + C_FK + 64 * h, NPROJ, PM + C_FV + 64 * h, NPROJ, Y + 256 + 64 * h, WSP(float, WS_CUM) + h, row0, qb, 0.125f * LOG2E);
                        else attn_half<96, false>(C.lds + FOXB, C.tid - 256, C.wave - 4, C.lane, WSP(bf16_t, WS_QM) + 96 * h, 384, WSP(bf16_t, WS_KM) + 96 * h, 384, WSP(bf16_t, WS_VM) + 64 * h, 256, Y + 768 + 64 * h, nullptr, row0, qb, 0.10206207261596575f * LOG2E); } }
            } else
            for (int pu = C.bx; pu < 256; pu += C.G) { const int bh = pu >> 3, s = pu & 7, b = bh >> 2, h = bh & 3, row0 = b * SEQ;
                if (en & 2) {
                    attn_unit<64, true>(C, PM + C_FQ + 64 * h, NPROJ, PM + C_FK + 64 * h, NPROJ, PM + C_FV + 64 * h, NPROJ, Y + 256 + 64 * h, WSP(float, WS_CUM) + h, row0, 15 - s, 0.125f * LOG2E);
                    attn_unit<64, true>(C, PM + C_FQ + 64 * h, NPROJ, PM + C_FK + 64 * h, NPROJ, PM + C_FV + 64 * h, NPROJ, Y + 256 + 64 * h, WSP(float, WS_CUM) + h, row0, s, 0.125f * LOG2E); }
                if (en & 8) {
                    attn_unit<96, false>(C, WSP(bf16_t, WS_QM) + 96 * h, 384, WSP(bf16_t, WS_KM) + 96 * h, 384, WSP(bf16_t, WS_VM) + 64 * h, 256, Y + 768 + 64 * h, nullptr, row0, 15 - s, 0.10206207261596575f * LOG2E);
                    attn_unit<96, false>(C, WSP(bf16_t, WS_QM) + 96 * h, 384, WSP(bf16_t, WS_KM) + 96 * h, 384, WSP(bf16_t, WS_VM) + 64 * h, 256, Y + 768 + 64 * h, nullptr, row0, s, 0.10206207261596575f * LOG2E); } }
        PH_END
        SEAM(pb + 3);
        LAUNDER();
        PH_BEGIN(pb + 4)
            if (en & 4) { for (int rp_ = 0; rp_ < 1 + REP_SSD; ++rp_) for (int cu = C.bx; cu < NCHK; cu += C.G) p3_ssd_unit(C, l, cu); }
        PH_END
        SEAM(pb + 4);
        LAUNDER();
        PH_BEGIN(pb + 5)
            pg8::Gemm gm{WSP(bf16_t, WS_S1), WSP(bf16_t, WS_WOUT) + (size_t)l * 1024 * 1024, T, DM, DM}; pg8::StaticOrder S; S.init(T, DM, C.G, C.bx);
            pg8::EpiResid E{l == 0 ? C.a->in[0] : WSP(float, WS_X1), WSP(float, WS_X1), DM};
            pg8::gemm_phase<pg8::EpiResid, pg8::StaticOrder, true, true>(C.lds, gm, S, E);
        PH_END
        SEAM(pb + 5);
        LAUNDER();
        PH_BEGIN(pb + 6) p5_router(C, l, en); PH_END
        SEAM(pb + 6);
        LAUNDER();
        PH_BEGIN(pb + 7) if (en & 16) {
            moe_tables(C, l);
            MoeOrder<2> S{C.G, C.bx, (const LAS int*)(C.lds + LDS_SCR + SCR_CNT), (const LAS int*)(C.lds + LDS_SCR + SCR_TBASE), (const LAS int*)(C.lds + LDS_SCR + SCR_TILEE),
                       __builtin_amdgcn_readfirstlane(*(const LAS int*)(C.lds + LDS_SCR + SCR_NT)), WSP(int, WS_ROWL)};
            pg8::Gemm gm{WSP(bf16_t, WS_S1), WSP(bf16_t, WS_BGU), T, 512, DM};
            pg8::EpiGateUp E{WSP(bf16_t, WS_HACT), 256};
            pg8::gemm_phase_gather<pg8::EpiGateUp, MoeOrder<2>, true>(C.lds, gm, S, E); } PH_END
        SEAM(pb + 7);
        LAUNDER();
        PH_BEGIN(pb + 8) if (en & 16) {
            moe_tables(C, l);
            MoeOrder<4> S{C.G, C.bx, (const LAS int*)(C.lds + LDS_SCR + SCR_CNT), (const LAS int*)(C.lds + LDS_SCR + SCR_TBASE), (const LAS int*)(C.lds + LDS_SCR + SCR_TILEE),
                       __builtin_amdgcn_readfirstlane(*(const LAS int*)(C.lds + LDS_SCR + SCR_NT)), WSP(int, WS_ROWL)};
            int kdim = 256; asm volatile("" : "+s"(kdim));
            pg8::Gemm gm{WSP(bf16_t, WS_HACT), WSP(bf16_t, WS_BD), 160 * 256, 1024, kdim};
            pg8::EpiSlotY E{WSP(bf16_t, WS_PM), DM};
            pg8::gemm_phase<pg8::EpiSlotY, MoeOrder<4>, true, true>(C.lds, gm, S, E); } PH_END
        SEAM(pb + 8);
        LAUNDER();
        PH_BEGIN(pb + 9) p7_combine(C, l, en, lastl); PH_END
        if (!lastl && IN(pb + 9)) xcd_barrier(bar);
    }
__global__ void __launch_bounds__(NTHR, 2) hcc_fwd(Args args) {
    extern __shared__ __attribute__((aligned(16))) unsigned char lds_raw[];
    Ctx C; C.lds = (lptr)lds_raw; C.tid = threadIdx.x; C.lane = C.tid & 63; C.wave = __builtin_amdgcn_readfirstlane(C.tid >> 6); C.G = gridDim.x; C.bx = blockIdx.x;
    C.a = (const __attribute__((address_space(4))) Args*)__builtin_amdgcn_kernarg_segment_ptr(); C.out = C.a->out; C.ws = C.a->ws;
    volatile LAS unsigned* MISC = (volatile LAS unsigned*)(C.lds + LDS_CTL);
    if (C.tid < 64) MISC[C.tid] = 0u;
    __syncthreads();
    XcdBarrier bar; bar.bar = WSP(unsigned, WS_CTL) + CW_BAR; bar.x = 0; bar.st = nullptr;
    if (!MK_SPLIT) bar = xcd_barrier_post(WSP(unsigned, WS_CTL) + CW_BAR, MISC + 8);
#if MK_SPLIT
    const int lo = C.a->ph_lo, hi = C.a->ph_hi;
#else
    constexpr int lo = 0, hi = NPHASE;
#endif

    constexpr int PLO = 1, PHI = NPL + 1;
    PH_BEGIN(0) p0_prologue(C); PH_END
#if REP_PHASE == 0
    xcd_barrier(bar); p0_prologue(C);
#endif
    SEAM(0);
#if REP_PHASE >= 1 && REP_PHASE <= 9
    layer_phases<0, 1, REP_PHASE + 1>(C, bar, lo, hi); xcd_barrier(bar); layer_phases<0, REP_PHASE, NPL + 1>(C, bar, lo, hi);
#else
    layer_phases<0>(C, bar, lo, hi);
#endif
    if (EN_L1) layer_phases<1>(C, bar, lo, hi);
#undef IN
#undef SEAM
}

extern "C" void kernel_launch(void* const* d_in, const int* in_sizes, int n_in, void* d_out, int out_size, void* d_ws, size_t ws_size, hipStream_t stream) {
    static int grid = 0;
    if (grid == 0) {
        if (n_in != 26 || in_sizes[0] != T * DM || out_size != T * DM || ws_size < WS_NEED) { fprintf(stderr, "kernel_launch: unexpected shapes (n_in %d, in0 %d, out %d, ws %zu)\n", n_in, n_in > 0 ? in_sizes[0] : -1, out_size, ws_size); grid = -1; return; }
        int dev = 0, cus = 0, per_cu = 0;
        if (hipGetDevice(&dev) != hipSuccess || hipDeviceGetAttribute(&cus, hipDeviceAttributeMultiprocessorCount, dev) != hipSuccess) { grid = -1; return; }
        if (hipFuncSetAttribute((const void*)hcc_fwd, hipFuncAttributeMaxDynamicSharedMemorySize, LDS_BYTES) != hipSuccess) { fprintf(stderr, "kernel_launch: hipFuncSetAttribute failed\n"); grid = -1; return; }
        if (hipOccupancyMaxActiveBlocksPerMultiprocessor(&per_cu, (const void*)hcc_fwd, NTHR, LDS_BYTES) != hipSuccess || per_cu < 1) { fprintf(stderr, "kernel_launch: occupancy query says %d\n", per_cu); }
        (void)hipGetLastError();
        grid = cus;
    }
    if (grid < 0) return;
    if (hipMemsetAsync((char*)d_ws + WS_CTL, 0, CTL_ZERO_BYTES, stream) != hipSuccess) return;
    Args a{};
    for (int i = 0; i < 26; ++i) a.in[i] = (const float*)d_in[i];
    a.out = (float*)d_out; a.ws = (unsigned char*)d_ws;
#if MK_SPLIT
    for (int p = 0; p < NPHASE; ++p) { a.ph_lo = p; a.ph_hi = p + 1; hipLaunchKernelGGL(hcc_fwd, dim3(grid), dim3(NTHR), LDS_BYTES, stream, a); }
#else
    a.ph_lo = 0; a.ph_hi = NPHASE; hipLaunchKernelGGL(hcc_fwd, dim3(grid), dim3(NTHR), LDS_BYTES, stream, a);
#endif
}
```

```cpp
#include <hip/hip_runtime.h>
#include <cstdio>
#include <cstdint>
#include <cmath>
#define GAS __attribute__((address_space(1)))
#define LAS __attribute__((address_space(3)))
namespace pg8 {
#define PG8_LAS __attribute__((address_space(3)))
typedef unsigned short bf16_t;
typedef short bf16x8 __attribute__((ext_vector_type(8)));
typedef float f32x4 __attribute__((ext_vector_type(4)));
typedef unsigned u32x4 __attribute__((ext_vector_type(4)));
constexpr int BM = 256, BK = 64, HALF = 128, HTB = HALF * BK * 2  , STAGE_BYTES = 8 * HTB, NXCD = 8, WGM = 8;

__host__ __device__ __forceinline__ int lds_byte(int r, int c) { const int st = (r >> 4) * 2 + (c >> 5), rr = r & 15, cc = c & 31, ob = rr * 64 + cc * 2; return st * 1024 + (ob ^ (((ob >> 9) & 1) << 5)); }
__host__ __device__ __forceinline__ void stage_rc(int b, int& R, int& C) { const int st = b / 1024, sb = b % 1024, swz = sb ^ (((sb >> 9) & 1) << 5); R = (st >> 1) * 16 + swz / 64; C = (st & 1) * 32 + (swz % 64) / 2; }
__host__ __device__ __forceinline__ int perm32(int rho) { const int n = rho >> 4, i = rho & 15; return 8 * (i >> 2) + 4 * n + (i & 3); }

struct Unit { int pm, pn, e, r0, ne; };
struct Gemm { const bf16_t* A; const bf16_t* Bt; int M, N, K; };

struct StaticOrder {
    int nM, nN, nwg, G, c;
    __host__ __device__ void init(int M, int N, int G_, int c_) { nM = M / BM; nN = N / BM; nwg = nM * nN; G = G_; c = c_; }
    __host__ __device__ bool next(int i, Unit& u) const {
        const long L = (long)i * G + c; if (L >= nwg) return false;
        int wgid = (int)L; { const int q = nwg / NXCD, r = nwg % NXCD, xcd = wgid % NXCD, off = wgid / NXCD; wgid = (xcd < r ? xcd * (q + 1) : r * (q + 1) + (xcd - r) * q) + off; }
        const int nig = WGM * nN, gid = wgid / nig, fm = gid * WGM, gsz = (nM - fm) < WGM ? (nM - fm) : WGM;
        u.pm = fm + ((wgid % nig) % gsz); u.pn = (wgid % nig) / gsz; return true;
    }
    __device__ __forceinline__ void a_ready(const Unit&) const {}
    __device__ __forceinline__ void done(const Unit&) const {}
};

__device__ __forceinline__ unsigned cvt_pk_bf16(float lo, float hi) { unsigned r; asm volatile("v_cvt_pk_bf16_f32 %0, %1, %2" : "=v"(r) : "v"(lo), "v"(hi)); return r; }

struct EpiInProj {
    static constexpr bool PERM = true, AFTER_DRAIN = false;
    bf16_t* O; int ldc; const float* rstd; float* FD; int fd_pn;
    __device__ __forceinline__ void operator()(const f32x4 (&acc)[2][2][4][2], const Unit& u, int wr, int wc, int fr, int fq) const {
        const int row0 = u.pm * BM + wr * 64 + fr; const int col0 = u.pn * BM + wc * 32 + 8 * fq;
        const bool fdl = (u.pn == fd_pn) && (wc == 1) && (fq == 0);
#pragma unroll
        for (int ai = 0; ai < 2; ++ai)
#pragma unroll
            for (int m = 0; m < 4; ++m) { const int row = row0 + ai * HALF + m * 16; const float rs = rstd[row]; bf16_t* rowp = O + (size_t)row * ldc + col0;
#pragma unroll
                for (int bj = 0; bj < 2; ++bj) { const f32x4 v0 = acc[ai][bj][m][0] * rs, v1 = acc[ai][bj][m][1] * rs;
                    u32x4 w; w.x = cvt_pk_bf16(v0[0], v0[1]); w.y = cvt_pk_bf16(v0[2], v0[3]); w.z = cvt_pk_bf16(v1[0], v1[1]); w.w = cvt_pk_bf16(v1[2], v1[3]);
                    *(u32x4*)(rowp + bj * HALF) = w;
                    if (bj == 1 && fdl) { *(f32x4*)(FD + (size_t)row * 8) = v0; *(f32x4*)(FD + (size_t)row * 8 + 4) = v1; } } }
    }
};
template <bool BASE_F32> struct EpiResid {
    static constexpr bool PERM = true, AFTER_DRAIN = false;
    const float* basef; bf16_t* xr; int ldc;
    __device__ __forceinline__ void operator()(const f32x4 (&acc)[2][2][4][2], const Unit& u, int wr, int wc, int fr, int fq) const {
        const int row0 = u.pm * BM + wr * 64 + fr; const int col0 = u.pn * BM + wc * 32 + 8 * fq;
#pragma unroll
        for (int ai = 0; ai < 2; ++ai)
#pragma unroll
            for (int m = 0; m < 4; ++m) { const size_t off = (size_t)(row0 + ai * HALF + m * 16) * ldc + col0;
#pragma unroll
                for (int bj = 0; bj < 2; ++bj) { f32x4 v0 = acc[ai][bj][m][0], v1 = acc[ai][bj][m][1];
                    if (BASE_F32) { v0 = v0 + *(const f32x4*)(basef + off + bj * HALF); v1 = v1 + *(const f32x4*)(basef + off + bj * HALF + 4); }
                    else { const u32x4 b = *(const u32x4*)(xr + off + bj * HALF);
                        v0[0] += __uint_as_float(b.x << 16); v0[1] += __uint_as_float(b.x & 0xffff0000u); v0[2] += __uint_as_float(b.y << 16); v0[3] += __uint_as_float(b.y & 0xffff0000u);
                        v1[0] += __uint_as_float(b.z << 16); v1[1] += __uint_as_float(b.z & 0xffff0000u); v1[2] += __uint_as_float(b.w << 16); v1[3] += __uint_as_float(b.w & 0xffff0000u); }
                    u32x4 w; w.x = cvt_pk_bf16(v0[0], v0[1]); w.y = cvt_pk_bf16(v0[2], v0[3]); w.z = cvt_pk_bf16(v1[0], v1[1]); w.w = cvt_pk_bf16(v1[2], v1[3]);
                    *(u32x4*)(xr + off + bj * HALF) = w; } }
    }
};
struct EpiGateUp {
    static constexpr bool PERM = true, AFTER_DRAIN = false;
    bf16_t* O; int ldc; const float* rowrs; int cap;
    __device__ __forceinline__ void operator()(const f32x4 (&acc)[2][2][4][2], const Unit& u, int wr, int wc, int fr, int fq) const {
        const int rl0 = wr * 64 + fr; const int row0 = u.pm * BM + rl0; const int col0 = (u.pn & 1) * HALF + wc * 32 + 8 * fq;
#pragma unroll
        for (int ai = 0; ai < 2; ++ai)
#pragma unroll
            for (int m = 0; m < 4; ++m) { const int rl = u.r0 + rl0 + ai * HALF + m * 16; const float rs = rl < u.ne ? rowrs[(size_t)u.e * cap + rl] : 0.f;
                bf16_t* rowp = O + (size_t)(row0 + ai * HALF + m * 16) * ldc + col0; float h[8];
#pragma unroll
                for (int n = 0; n < 2; ++n)
#pragma unroll
                    for (int j = 0; j < 4; ++j) { const float gt = acc[ai][0][m][n][j] * rs, up = acc[ai][1][m][n][j] * rs; h[n * 4 + j] = gt * up / (1.0f + __expf(-gt)); }
                u32x4 w; w.x = cvt_pk_bf16(h[0], h[1]); w.y = cvt_pk_bf16(h[2], h[3]); w.z = cvt_pk_bf16(h[4], h[5]); w.w = cvt_pk_bf16(h[6], h[7]);
                *(u32x4*)rowp = w; }
    }
};
struct EpiSlotY {
    static constexpr bool PERM = true, AFTER_DRAIN = false;
    bf16_t* O; int ldc;
    __device__ __forceinline__ void operator()(const f32x4 (&acc)[2][2][4][2], const Unit& u, int wr, int wc, int fr, int fq) const {
        const int row0 = u.pm * BM + wr * 64 + fr; const int col0 = (u.pn & 3) * BM + wc * 32 + 8 * fq;
#pragma unroll
        for (int ai = 0; ai < 2; ++ai)
#pragma unroll
            for (int m = 0; m < 4; ++m) { bf16_t* rowp = O + (size_t)(row0 + ai * HALF + m * 16) * ldc + col0;
#pragma unroll
                for (int bj = 0; bj < 2; ++bj) { const f32x4 v0 = acc[ai][bj][m][0], v1 = acc[ai][bj][m][1];
                    u32x4 w; w.x = cvt_pk_bf16(v0[0], v0[1]); w.y = cvt_pk_bf16(v0[2], v0[3]); w.z = cvt_pk_bf16(v1[0], v1[1]); w.w = cvt_pk_bf16(v1[2], v1[3]);
                    *(u32x4*)(rowp + bj * HALF) = w; } }
    }
};

template <class Epi, class Sched, bool ALIGN_EPI = false, bool SP2 = false>
__device__ __forceinline__ void gemm_phase(PG8_LAS unsigned char* lds, const Gemm g, const Sched& S, const Epi& E) {
    int tid_ = threadIdx.x; asm volatile("" : "+v"(tid_));
    const int tid = tid_, wid = __builtin_amdgcn_readfirstlane(tid >> 6), lane = tid & 63, wr = wid >> 2, wc = wid & 3, fr = lane & 15, fq = lane >> 4;
    const int K = g.K, nt = K / BK;
    unsigned voffA[2], voffB[2];
#pragma unroll
    for (int i = 0; i < 2; ++i) { int R, C; stage_rc(tid * 16 + i * 8192, R, C); const int Rb = Epi::PERM ? ((R & ~31) + perm32(R & 31)) : R;
        voffA[i] = (unsigned)(R * K + C) * 2u; voffB[i] = (unsigned)(Rb * K + C) * 2u; }
    const size_t kstep = (size_t)(BK * 2);
    const size_t hstep = (size_t)HALF * K * 2;
    const size_t tstep = 2 * hstep;
    const unsigned ldsw = (unsigned)wid * 1024u;
    const int aoff = lds_byte(wr * 64 + fr, fq * 8), boff = lds_byte(wc * 32 + fr, fq * 8);
#define PG8_SA(b, h) (((b) * 2 + (h)) * HTB)
#define PG8_SB(b, h) ((4 + (b) * 2 + (h)) * HTB)
#define PG8_STAGE(bufoff, gbase, voff) do { _Pragma("unroll") for (int _i = 0; _i < 2; ++_i) \
        __builtin_amdgcn_global_load_lds((const unsigned*)((const char*)(gbase) + (voff)[_i]), (PG8_LAS unsigned*)(lds + (bufoff) + ldsw + _i * 8192), 16, 0, 0); } while (0)
#define PG8_LDA(dst, b, h) do { _Pragma("unroll") for (int m = 0; m < 4; ++m) _Pragma("unroll") for (int k = 0; k < 2; ++k) dst[m][k] = *(const PG8_LAS bf16x8*)(lds + PG8_SA(b, h) + aoff + m * 2048 + k * 1024); } while (0)
#define PG8_LDB(dst, b, h) do { _Pragma("unroll") for (int n = 0; n < 2; ++n) _Pragma("unroll") for (int k = 0; k < 2; ++k) dst[n][k] = *(const PG8_LAS bf16x8*)(lds + PG8_SB(b, h) + boff + n * 2048 + k * 1024); } while (0)
#define PG8_MMA(ai, bj, At, Bt) do { __builtin_amdgcn_s_setprio(1); _Pragma("unroll") for (int m = 0; m < 4; ++m) _Pragma("unroll") for (int n = 0; n < 2; ++n) _Pragma("unroll") for (int k = 0; k < 2; ++k) \
        acc[ai][bj][m][n] = __builtin_amdgcn_mfma_f32_16x16x32_bf16(Bt[n][k], At[m][k], acc[ai][bj][m][n], 0, 0, 0); __builtin_amdgcn_s_setprio(0); } while (0)
#define PG8_WAIT_V(n) asm volatile("s_waitcnt vmcnt(" #n ")" ::: "memory")
#define PG8_WAIT_L(n) asm volatile("s_waitcnt lgkmcnt(" #n ")" ::: "memory")
#define PG8_BAR __builtin_amdgcn_s_barrier()
#define PG8_SCHED __builtin_amdgcn_sched_barrier(0)
    Unit cur, nxt; int ui = 0;
    if (!S.next(0, cur)) return;
    f32x4 acc[2][2][4][2];
#pragma unroll
    for (int a = 0; a < 2; ++a)
#pragma unroll
        for (int b = 0; b < 2; ++b)
#pragma unroll
            for (int m = 0; m < 4; ++m)
#pragma unroll
                for (int n = 0; n < 2; ++n) acc[a][b][m][n] = (f32x4){0.f, 0.f, 0.f, 0.f};
    bf16x8 At[4][2], B0[2][2], B1[2][2];
    const char* cA = (const char*)g.A + (size_t)cur.pm * tstep; const char* cB = (const char*)g.Bt + (size_t)cur.pn * tstep;
    S.a_ready(cur);
    if constexpr (SP2) {
        PG8_STAGE(PG8_SB(0, 0), cB, voffB); PG8_STAGE(PG8_SB(0, 1), cB + hstep, voffB); PG8_STAGE(PG8_SA(0, 0), cA, voffA); PG8_STAGE(PG8_SA(0, 1), cA + hstep, voffA);
        if (wr == 1) PG8_BAR;
        PG8_WAIT_V(2); PG8_BAR;
        PG8_STAGE(PG8_SB(1, 0), cB + kstep, voffB); PG8_STAGE(PG8_SA(1, 0), cA + kstep, voffA); PG8_STAGE(PG8_SB(1, 1), cB + hstep + kstep, voffB);
        PG8_WAIT_V(6); PG8_BAR;
    } else {
        PG8_STAGE(PG8_SB(0, 0), cB, voffB); PG8_STAGE(PG8_SA(0, 0), cA, voffA); PG8_STAGE(PG8_SB(0, 1), cB + hstep, voffB); PG8_STAGE(PG8_SA(0, 1), cA + hstep, voffA);
        if (wr == 1) PG8_BAR;
        PG8_WAIT_V(4); PG8_BAR;
        PG8_STAGE(PG8_SB(1, 0), cB + kstep, voffB); PG8_STAGE(PG8_SA(1, 0), cA + kstep, voffA); PG8_STAGE(PG8_SB(1, 1), cB + hstep + kstep, voffB);
        PG8_WAIT_V(6); PG8_BAR;
    }
    for (;;) {
        const bool has_next = S.next(ui + 1, nxt);
        const char* nA = has_next ? (const char*)g.A + (size_t)nxt.pm * tstep : cA; const char* nB = has_next ? (const char*)g.Bt + (size_t)nxt.pn * tstep : cB;
        for (int t = 0; t < nt; t += 2) {
            const bool last = (t == nt - 2);
            const char* a1 = cA + (size_t)(t + 1) * kstep;
            const char* a2 = last ? nA : cA + (size_t)(t + 2) * kstep; const char* b2 = last ? nB : cB + (size_t)(t + 2) * kstep;
            const char* a3 = a2 + kstep; const char* b3 = b2 + kstep;
            if (last && has_next) S.a_ready(nxt);
            if constexpr (SP2) {
            PG8_LDB(B0, 0, 0); PG8_LDB(B1, 0, 1); PG8_SCHED; PG8_LDA(At, 0, 0); PG8_STAGE(PG8_SA(1, 1), a1 + hstep, voffA);
            PG8_WAIT_V(8); PG8_WAIT_L(0); PG8_BAR; PG8_MMA(0, 0, At, B0); PG8_MMA(0, 1, At, B1); PG8_BAR; PG8_SCHED;
            PG8_LDA(At, 0, 1); PG8_STAGE(PG8_SB(0, 0), b2, voffB); PG8_STAGE(PG8_SB(0, 1), b2 + hstep, voffB); PG8_STAGE(PG8_SA(0, 0), a2, voffA);
            PG8_WAIT_V(8); PG8_WAIT_L(0); PG8_BAR; PG8_MMA(1, 0, At, B0); PG8_MMA(1, 1, At, B1); PG8_BAR; PG8_SCHED;
            PG8_LDB(B0, 1, 0); PG8_LDB(B1, 1, 1); PG8_SCHED; PG8_LDA(At, 1, 0); PG8_STAGE(PG8_SA(0, 1), a2 + hstep, voffA);
            PG8_WAIT_V(8); PG8_WAIT_L(0); PG8_BAR; PG8_MMA(0, 0, At, B0); PG8_MMA(0, 1, At, B1); PG8_BAR; PG8_SCHED;
            PG8_LDA(At, 1, 1); PG8_STAGE(PG8_SB(1, 0), b3, voffB); PG8_STAGE(PG8_SB(1, 1), b3 + hstep, voffB); PG8_STAGE(PG8_SA(1, 0), a3, voffA);
            PG8_WAIT_V(8); PG8_WAIT_L(0); PG8_BAR; PG8_MMA(1, 0, At, B0); PG8_MMA(1, 1, At, B1); PG8_BAR; PG8_SCHED;
            } else {
            PG8_LDB(B0, 0, 0); PG8_SCHED; PG8_LDA(At, 0, 0); PG8_STAGE(PG8_SA(1, 1), a1 + hstep, voffA);
            PG8_WAIT_L(8); PG8_BAR; PG8_WAIT_L(0); PG8_MMA(0, 0, At, B0); PG8_BAR; PG8_SCHED;
            PG8_LDB(B1, 0, 1); PG8_STAGE(PG8_SB(0, 0), b2, voffB);
            PG8_BAR; PG8_WAIT_L(0); PG8_MMA(0, 1, At, B1); PG8_BAR;
            PG8_LDA(At, 0, 1); PG8_STAGE(PG8_SA(0, 0), a2, voffA);
            PG8_BAR; PG8_WAIT_L(0); PG8_MMA(1, 0, At, B0); PG8_BAR; PG8_SCHED;
            PG8_STAGE(PG8_SB(0, 1), b2 + hstep, voffB);
            PG8_WAIT_V(6); PG8_BAR; PG8_MMA(1, 1, At, B1); PG8_BAR;
            PG8_LDB(B0, 1, 0); PG8_SCHED; PG8_LDA(At, 1, 0); PG8_STAGE(PG8_SA(0, 1), a2 + hstep, voffA);
            PG8_WAIT_L(8); PG8_BAR; PG8_WAIT_L(0); PG8_MMA(0, 0, At, B0); PG8_BAR; PG8_SCHED;
            PG8_LDB(B1, 1, 1); PG8_STAGE(PG8_SB(1, 0), b3, voffB);
            PG8_BAR; PG8_WAIT_L(0); PG8_MMA(0, 1, At, B1); PG8_BAR;
            PG8_LDA(At, 1, 1); PG8_STAGE(PG8_SA(1, 0), a3, voffA);
            PG8_BAR; PG8_WAIT_L(0); PG8_MMA(1, 0, At, B0); PG8_BAR; PG8_SCHED;
            PG8_STAGE(PG8_SB(1, 1), b3 + hstep, voffB);
            PG8_WAIT_V(6); PG8_BAR; PG8_MMA(1, 1, At, B1); PG8_BAR;
            }
        }
        if constexpr (ALIGN_EPI) { if (wr == 0) PG8_BAR; }
        if constexpr (!Epi::AFTER_DRAIN) { E(acc, cur, wr, wc, fr, fq); S.done(cur); }
        if (!has_next) break;
#pragma unroll
        for (int a = 0; a < 2; ++a)
#pragma unroll
            for (int b = 0; b < 2; ++b)
#pragma unroll
                for (int m = 0; m < 4; ++m)
#pragma unroll
                    for (int n = 0; n < 2; ++n) acc[a][b][m][n] = (f32x4){0.f, 0.f, 0.f, 0.f};
        cur = nxt; cA = nA; cB = nB; ++ui;
        if constexpr (ALIGN_EPI) { if (wr == 1) PG8_BAR; }
    }
    PG8_WAIT_V(0);
    if constexpr (!ALIGN_EPI) { if (wr == 0) PG8_BAR; }
    PG8_BAR;
    if constexpr (Epi::AFTER_DRAIN) { E.fused(acc, cur, wr, wc, fr, fq, lds, wid, lane); S.done(cur); }
#undef PG8_SA
#undef PG8_SB
#undef PG8_STAGE
#undef PG8_LDA
#undef PG8_LDB
#undef PG8_MMA
#undef PG8_WAIT_V
#undef PG8_WAIT_L
#undef PG8_BAR
#undef PG8_SCHED
}
template <class Epi, class Sched, bool ALIGN_EPI = false>
__device__ __forceinline__ void gemm_phase_gather(PG8_LAS unsigned char* lds, const Gemm g, const Sched& S, const Epi& E) {
    int tid_ = threadIdx.x; asm volatile("" : "+v"(tid_));
    const int tid = tid_, wid = __builtin_amdgcn_readfirstlane(tid >> 6), lane = tid & 63, wr = wid >> 2, wc = wid & 3, fr = lane & 15, fq = lane >> 4;
    const int K = g.K, nt = K / BK;
    unsigned voffB[2]; int RA[2]; unsigned CA[2];
#pragma unroll
    for (int i = 0; i < 2; ++i) { int R, C; stage_rc(tid * 16 + i * 8192, R, C); const int Rb = Epi::PERM ? ((R & ~31) + perm32(R & 31)) : R;
        RA[i] = R; CA[i] = (unsigned)C * 2u; voffB[i] = (unsigned)(Rb * K + C) * 2u; }
    const size_t kstep = (size_t)(BK * 2);
    const size_t hstep = (size_t)HALF * K * 2;
    const size_t tstep = 2 * hstep;
    const unsigned ldsw = (unsigned)wid * 1024u;
    const int aoff = lds_byte(wr * 64 + fr, fq * 8), boff = lds_byte(wc * 32 + fr, fq * 8);
#define PG8_SA(b, h) (((b) * 2 + (h)) * HTB)
#define PG8_SB(b, h) ((4 + (b) * 2 + (h)) * HTB)
#define PG8_STAGE(bufoff, gbase, voff) do { _Pragma("unroll") for (int _i = 0; _i < 2; ++_i) \
        __builtin_amdgcn_global_load_lds((const unsigned*)((const char*)(gbase) + (voff)[_i]), (PG8_LAS unsigned*)(lds + (bufoff) + ldsw + _i * 8192), 16, 0, 0); } while (0)
#define PG8_LDA(dst, b, h) do { _Pragma("unroll") for (int m = 0; m < 4; ++m) _Pragma("unroll") for (int k = 0; k < 2; ++k) dst[m][k] = *(const PG8_LAS bf16x8*)(lds + PG8_SA(b, h) + aoff + m * 2048 + k * 1024); } while (0)
#define PG8_LDB(dst, b, h) do { _Pragma("unroll") for (int n = 0; n < 2; ++n) _Pragma("unroll") for (int k = 0; k < 2; ++k) dst[n][k] = *(const PG8_LAS bf16x8*)(lds + PG8_SB(b, h) + boff + n * 2048 + k * 1024); } while (0)
#define PG8_MMA(ai, bj, At, Bt) do { __builtin_amdgcn_s_setprio(1); _Pragma("unroll") for (int m = 0; m < 4; ++m) _Pragma("unroll") for (int n = 0; n < 2; ++n) _Pragma("unroll") for (int k = 0; k < 2; ++k) \
        acc[ai][bj][m][n] = __builtin_amdgcn_mfma_f32_16x16x32_bf16(Bt[n][k], At[m][k], acc[ai][bj][m][n], 0, 0, 0); __builtin_amdgcn_s_setprio(0); } while (0)
#define PG8_WAIT_V(n) asm volatile("s_waitcnt vmcnt(" #n ")" ::: "memory")
#define PG8_WAIT_L(n) asm volatile("s_waitcnt lgkmcnt(" #n ")" ::: "memory")
#define PG8_BAR __builtin_amdgcn_s_barrier()
#define PG8_SCHED __builtin_amdgcn_sched_barrier(0)
#define PG8_GOFFS(dst, u) do { _Pragma("unroll") for (int _h = 0; _h < 2; ++_h) _Pragma("unroll") for (int _i = 0; _i < 2; ++_i) \
        dst[_h][_i] = (unsigned)S.arow(u, _h * HALF + RA[_i]) * (unsigned)(K * 2) + CA[_i]; } while (0)
    Unit cur, nxt; int ui = 0;
    if (!S.next(0, cur)) return;
    unsigned vA[2][2], nvA[2][2];
    PG8_GOFFS(vA, cur);
    f32x4 acc[2][2][4][2];
#pragma unroll
    for (int a = 0; a < 2; ++a)
#pragma unroll
        for (int b = 0; b < 2; ++b)
#pragma unroll
            for (int m = 0; m < 4; ++m)
#pragma unroll
                for (int n = 0; n < 2; ++n) acc[a][b][m][n] = (f32x4){0.f, 0.f, 0.f, 0.f};
    bf16x8 At[4][2], B0[2][2], B1[2][2];
    const char* const cA = (const char*)g.A; const char* cB = (const char*)g.Bt + (size_t)cur.pn * tstep;
    asm volatile("s_waitcnt vmcnt(0)" ::: "memory");
    PG8_STAGE(PG8_SB(0, 0), cB, voffB); PG8_STAGE(PG8_SB(0, 1), cB + hstep, voffB); PG8_STAGE(PG8_SA(0, 0), cA, vA[0]); PG8_STAGE(PG8_SA(0, 1), cA, vA[1]);
    if (wr == 1) PG8_BAR;
    PG8_WAIT_V(2); PG8_BAR;
    PG8_STAGE(PG8_SB(1, 0), cB + kstep, voffB); PG8_STAGE(PG8_SA(1, 0), cA + kstep, vA[0]); PG8_STAGE(PG8_SB(1, 1), cB + hstep + kstep, voffB);
    PG8_WAIT_V(6); PG8_BAR;
    for (;;) {
        const bool has_next = S.next(ui + 1, nxt);
        const char* nB = has_next ? (const char*)g.Bt + (size_t)nxt.pn * tstep : cB;
        for (int t = 0; t < nt; t += 2) {
            const bool last = (t == nt - 2);
            if (last) {
                if (has_next) { PG8_GOFFS(nvA, nxt); }
                else {
#pragma unroll
                    for (int _h = 0; _h < 2; ++_h)
#pragma unroll
                        for (int _i = 0; _i < 2; ++_i) nvA[_h][_i] = vA[_h][_i]; }
            }
            unsigned s0[2], s1[2];
#pragma unroll
            for (int _i = 0; _i < 2; ++_i) { s0[_i] = last ? nvA[0][_i] : vA[0][_i]; s1[_i] = last ? nvA[1][_i] : vA[1][_i]; }
            const char* a1 = cA + (size_t)(t + 1) * kstep;
            const char* a2 = last ? cA : cA + (size_t)(t + 2) * kstep; const char* b2 = last ? nB : cB + (size_t)(t + 2) * kstep;
            const char* a3 = a2 + kstep; const char* b3 = b2 + kstep;
            PG8_LDB(B0, 0, 0); PG8_LDB(B1, 0, 1); PG8_SCHED; PG8_LDA(At, 0, 0); PG8_STAGE(PG8_SA(1, 1), a1, vA[1]);
            PG8_WAIT_V(8); PG8_WAIT_L(0); PG8_BAR; PG8_MMA(0, 0, At, B0); PG8_MMA(0, 1, At, B1); PG8_BAR; PG8_SCHED;
            PG8_LDA(At, 0, 1); PG8_STAGE(PG8_SB(0, 0), b2, voffB); PG8_STAGE(PG8_SB(0, 1), b2 + hstep, voffB); PG8_STAGE(PG8_SA(0, 0), a2, s0);
            PG8_WAIT_V(8); PG8_WAIT_L(0); PG8_BAR; PG8_MMA(1, 0, At, B0); PG8_MMA(1, 1, At, B1); PG8_BAR; PG8_SCHED;
            PG8_LDB(B0, 1, 0); PG8_LDB(B1, 1, 1); PG8_SCHED; PG8_LDA(At, 1, 0); PG8_STAGE(PG8_SA(0, 1), a2, s1);
            PG8_WAIT_V(8); PG8_WAIT_L(0); PG8_BAR; PG8_MMA(0, 0, At, B0); PG8_MMA(0, 1, At, B1); PG8_BAR; PG8_SCHED;
            PG8_LDA(At, 1, 1); PG8_STAGE(PG8_SB(1, 0), b3, voffB); PG8_STAGE(PG8_SB(1, 1), b3 + hstep, voffB); PG8_STAGE(PG8_SA(1, 0), a3, s0);
            PG8_WAIT_V(8); PG8_WAIT_L(0); PG8_BAR; PG8_MMA(1, 0, At, B0); PG8_MMA(1, 1, At, B1); PG8_BAR; PG8_SCHED;
        }
        if constexpr (ALIGN_EPI) { if (wr == 0) PG8_BAR; }
        E(acc, cur, wr, wc, fr, fq); S.done(cur);
        if (!has_next) break;
#pragma unroll
        for (int a = 0; a < 2; ++a)
#pragma unroll
            for (int b = 0; b < 2; ++b)
#pragma unroll
                for (int m = 0; m < 4; ++m)
#pragma unroll
                    for (int n = 0; n < 2; ++n) acc[a][b][m][n] = (f32x4){0.f, 0.f, 0.f, 0.f};
        cur = nxt; cB = nB; ++ui;
#pragma unroll
        for (int _h = 0; _h < 2; ++_h)
#pragma unroll
            for (int _i = 0; _i < 2; ++_i) vA[_h][_i] = nvA[_h][_i];
        if constexpr (ALIGN_EPI) { if (wr == 1) PG8_BAR; }
    }
    PG8_WAIT_V(0);
    if constexpr (!ALIGN_EPI) { if (wr == 0) PG8_BAR; }
    PG8_BAR;
#undef PG8_SA
#undef PG8_SB
#undef PG8_STAGE
#undef PG8_LDA
#undef PG8_LDB
#undef PG8_MMA
#undef PG8_WAIT_V
#undef PG8_WAIT_L
#undef PG8_BAR
#undef PG8_SCHED
#undef PG8_GOFFS
}
}

#define XB_TMO      128
#define XB_XCNT(j)  (256  + 64 * (j))
#define XB_XSUB(j)  (1280 + 64 * (j))
#define XB_XGEN(j)  (2304 + 64 * (j))
#define XB_TOP      3328
#define XB_TOPGEN   3392
#define XCD_BAR_WORDS 3456
#define XB_SPIN_CAP (1u << 18)

__device__ __forceinline__ unsigned xb_ld(unsigned* p)              { return __hip_atomic_load(p, __ATOMIC_RELAXED, __HIP_MEMORY_SCOPE_AGENT); }
__device__ __forceinline__ unsigned xb_add(unsigned* p, unsigned v) { return __hip_atomic_fetch_add(p, v, __ATOMIC_RELAXED, __HIP_MEMORY_SCOPE_AGENT); }
__device__ __forceinline__ unsigned xb_xcc_id() { return (unsigned)__builtin_amdgcn_s_getreg((3 << 11) | 20) & 0xFu; }
#define XB_SPIN(cond, bar) do { unsigned _sp = 0; while (cond) { __builtin_amdgcn_s_sleep(1); \
    if ((++_sp & 255u) == 0u) { if (xb_ld(&(bar)[XB_TMO])) break; if (_sp > XB_SPIN_CAP) { atomicAdd(&(bar)[XB_TMO], 1u); break; } } } } while (0)

struct XcdBarrier {
    unsigned* bar; unsigned x;
    volatile LAS unsigned* st;
};

__device__ __forceinline__ XcdBarrier xcd_barrier_post(unsigned* bar, volatile LAS unsigned* st) {
    XcdBarrier b; b.bar = bar; b.x = xb_xcc_id(); b.st = st;
    if (threadIdx.x == 0) (void)xb_add(&bar[XB_XCNT(b.x)], 1u);
    return b;
}
__device__ __forceinline__ void xcd_barrier_complete(unsigned* bar, unsigned x, unsigned& nloc, unsigned& nx) {
    const unsigned G = gridDim.x * gridDim.y * gridDim.z;
    unsigned sum, cnt, mine, sp = 0u;
    for (;;) {
        sum = 0u; cnt = 0u; mine = 0u;
#pragma unroll
        for (unsigned j = 0; j < 16; ++j) { const unsigned c = xb_ld(&bar[XB_XCNT(j)]); sum += c; cnt += (c > 0u) ? 1u : 0u; mine = (j == x) ? c : mine; }
        if (sum == G) break;
        __builtin_amdgcn_s_sleep(1);
        if ((++sp & 255u) == 0u) { if (xb_ld(&bar[XB_TMO])) break; if (sp > XB_SPIN_CAP) { atomicAdd(&bar[XB_TMO], 1u); break; } }
    }
    nloc = mine > 0u ? mine : 1u; nx = cnt > 0u ? cnt : 1u;
}

__device__ __forceinline__ void xcd_barrier(const XcdBarrier& b) {
    asm volatile("s_waitcnt vmcnt(0)" ::: "memory");
    __syncthreads();
    if (threadIdx.x == 0) {
        unsigned* bar = b.bar;
        __builtin_amdgcn_s_waitcnt(0);
        unsigned nloc = b.st[0], nx = b.st[1];
        if (nloc == 0u) { xcd_barrier_complete(bar, b.x, nloc, nx); b.st[0] = nloc; b.st[1] = nx; }
        const unsigned old = xb_add(&bar[XB_XSUB(b.x)], 1u);
        const unsigned gen = old / nloc;
        if (old + 1u == (gen + 1u) * nloc) {
            __builtin_amdgcn_fence(__ATOMIC_RELEASE, "agent");
            asm volatile("s_waitcnt vmcnt(0)" ::: "memory");
            const unsigned og = xb_add(&bar[XB_TOP], 1u);
            const unsigned tg = og / nx;
            if (og + 1u == (tg + 1u) * nx) xb_add(&bar[XB_TOPGEN], 1u);
            else XB_SPIN(xb_ld(&bar[XB_TOPGEN]) == tg, bar);
            __builtin_amdgcn_fence(__ATOMIC_ACQUIRE, "agent");
            xb_add(&bar[XB_XGEN(b.x)], 1u);
            asm volatile("s_waitcnt vmcnt(0)" ::: "memory");
        } else {
            XB_SPIN(xb_ld(&bar[XB_XGEN(b.x)]) == gen, bar);
            __builtin_amdgcn_fence(__ATOMIC_ACQUIRE, "agent");
            asm volatile("s_waitcnt vmcnt(0)" ::: "memory");
        }
    }
    __syncthreads();
}


constexpr int NWAVES = 8, NTHR = 512;
constexpr int T = 16384, DM = 1024, SEQ = 2048, NPROJ = 2816, NCHK = 256;
constexpr float RMS_EPS = 1e-6f, LOG2E = 1.4426950408889634f;
constexpr int C_AB = 0, C_AC = 256, C_AV = 512, C_FQ = 768, C_FK = 1024, C_FV = 1280, C_Z = 1536, C_XBC = 1792, C_CQ = 2304, C_CKV = 2560, C_KR = 2688, C_FD = 2720;
#ifndef EN0
#define EN0 31
#endif
#ifndef EN1
#define EN1 31
#endif
#ifndef EN_L1
#define EN_L1 1
#endif
#ifndef REP_ATT
#define REP_ATT 0
#endif
#ifndef REP_SSD
#define REP_SSD 0
#endif
#ifndef MK_SPLIT
#define MK_SPLIT 0
#endif
constexpr int NPL = 9, NPHASE = 1 + 2 * NPL;

constexpr size_t MiB = 1u << 20;
constexpr size_t WS_CTL = 0, CTL_ZERO_BYTES = 65536;
constexpr size_t WS_X1 = 1 * MiB;
constexpr size_t WS_PM = 65 * MiB;
constexpr size_t WS_S1 = 153 * MiB;
constexpr size_t WS_HACT = 185 * MiB;
constexpr size_t WS_XBC = WS_HACT, WS_DTAC = WS_HACT + 16 * MiB;
constexpr size_t WS_E = 205 * MiB;
constexpr size_t WS_QM = WS_E, WS_KM = WS_E + 12 * MiB, WS_VM = WS_E + 24 * MiB, WS_ST = WS_E + 32 * MiB, WS_PREV = WS_E + 48 * MiB;
constexpr size_t WS_BGU = WS_E, WS_BD = WS_E + 32 * MiB;
constexpr size_t WS_WIN = 261 * MiB;
constexpr size_t WS_WOUT = 272 * MiB;
constexpr size_t WS_WUQ = 276 * MiB;
constexpr size_t WS_WUKV = WS_WUQ + 512 * 1024;
constexpr size_t WS_MISC = 277 * MiB;
constexpr size_t WS_FD = WS_MISC;
constexpr size_t WS_RSTD = WS_FD + 512 * 1024;
constexpr size_t WS_CUM = WS_RSTD + 64 * 1024;
constexpr size_t WS_COS = WS_CUM + 256 * 1024;
constexpr size_t WS_SIN = WS_COS + 1 * MiB;
constexpr size_t WS_CDEC = WS_SIN + 1 * MiB;
constexpr size_t WS_ROWL = WS_CDEC + 64 * 1024;
constexpr size_t WS_TOKE = WS_ROWL + 2 * MiB;
constexpr size_t WS_TOKP = WS_TOKE + 128 * 1024;
constexpr size_t WS_TOKW = WS_TOKP + 128 * 1024;
constexpr size_t WS_WR = WS_TOKW + 128 * 1024;
constexpr size_t WS_END = WS_WR + 288 * 1024;
constexpr size_t WS_ROWRS = WS_X1 + 32 * MiB;
static_assert(WS_END <= 284 * MiB, "workspace map");
constexpr size_t WS_NEED = 284 * MiB;
constexpr int CW_CNT = 64;
constexpr int CW_BAR = 4096;

constexpr int LDS_BYTES = 155648;
constexpr int LDS_SCR = 147456;
constexpr int LDS_CTL = 151552;
constexpr int SCR_RED = 0;
constexpr int SCR_RQ = 256, SCR_RKV = 512;
constexpr int SCR_CNT = 768;
constexpr int SCR_TBASE = 896;
constexpr int SCR_TILEE = 1040;
constexpr int SCR_NT = 1680;

typedef unsigned short bf16_t;
typedef short bf16x8 __attribute__((ext_vector_type(8)));
typedef short s16x4 __attribute__((ext_vector_type(4)));
typedef float f32x4 __attribute__((ext_vector_type(4)));
typedef unsigned u32x4 __attribute__((ext_vector_type(4)));
typedef unsigned u32x2 __attribute__((ext_vector_type(2)));
typedef LAS unsigned char* lptr;
#define LDS_WAIT() asm volatile("s_waitcnt lgkmcnt(0)" ::: "memory")

__device__ __forceinline__ unsigned f2bf(float f) { unsigned u = __builtin_bit_cast(unsigned, f); return (u + 0x7fffu + ((u >> 16) & 1u)) >> 16; }
__device__ __forceinline__ unsigned pk2(float lo, float hi) { unsigned r; asm("v_cvt_pk_bf16_f32 %0, %1, %2" : "=v"(r) : "v"(lo), "v"(hi)); return r; }
__device__ __forceinline__ float bf2f(unsigned short u) { return __uint_as_float((unsigned)u << 16); }
__device__ __forceinline__ float bflo(unsigned u) { return __uint_as_float(u << 16); }
__device__ __forceinline__ float bfhi(unsigned u) { return __uint_as_float(u & 0xffff0000u); }
__device__ __forceinline__ float wave_sum(float v) {
#pragma unroll
    for (int o = 1; o < 64; o <<= 1) v += __shfl_xor(v, o);
    return v;
}
__device__ __forceinline__ float silu_f(float x) { return x / (1.0f + __expf(-x)); }
__device__ __forceinline__ float softplus_f(float x) { return fmaxf(x, 0.f) + log1pf(__expf(-fabsf(x))); }
__device__ __forceinline__ f32x4 mfma16(bf16x8 a, bf16x8 b, f32x4 c) { return __builtin_amdgcn_mfma_f32_16x16x32_bf16(a, b, c, 0, 0, 0); }
__device__ __forceinline__ bf16x8 tr_frag(lptr base, int ld  , int row_a, int row_b, int col0, int lane) {
    typedef short v4i16_t __attribute__((ext_vector_type(4)));
    const int i = lane & 15, q = i >> 2, p = i & 3;
    const s16x4 lo = __builtin_bit_cast(s16x4, __builtin_amdgcn_ds_read_tr16_b64_v4i16((LAS v4i16_t*)(base + ((row_a + q) * ld + col0 + 4 * p) * 2)));
    const s16x4 hi = __builtin_bit_cast(s16x4, __builtin_amdgcn_ds_read_tr16_b64_v4i16((LAS v4i16_t*)(base + ((row_b + q) * ld + col0 + 4 * p) * 2)));
    return (bf16x8){lo[0], lo[1], lo[2], lo[3], hi[0], hi[1], hi[2], hi[3]};
}

struct Args { const float* in[26]; float* out; unsigned char* ws; int ph_lo, ph_hi; };
__device__ __forceinline__ bf16x8 tr_frag2(lptr lane_base, int off_a, int off_b) {
    typedef short v4i16_t __attribute__((ext_vector_type(4)));
    const s16x4 lo = __builtin_bit_cast(s16x4, __builtin_amdgcn_ds_read_tr16_b64_v4i16((LAS v4i16_t*)(lane_base + off_a)));
    const s16x4 hi = __builtin_bit_cast(s16x4, __builtin_amdgcn_ds_read_tr16_b64_v4i16((LAS v4i16_t*)(lane_base + off_b)));
    return (bf16x8){lo[0], lo[1], lo[2], lo[3], hi[0], hi[1], hi[2], hi[3]};
}
struct Ctx {
    lptr lds;
    int tid, lane, wave, G, bx;
    const __attribute__((address_space(4))) Args* a;
    float* out; unsigned char* ws;
};
#define WSP(type, off) ((type*)(C.ws + (off)))
#define LAUNDER() do { unsigned char* p_ = C.ws; int t_ = C.tid; unsigned l_ = (unsigned)(size_t)C.lds; const __attribute__((address_space(4))) Args* a_ = C.a; asm volatile("" : "+s"(p_), "+v"(t_), "+s"(l_), "+s"(a_)); C.a = a_; C.ws = p_; C.tid = t_; C.lane = t_ & 63; C.wave = __builtin_amdgcn_readfirstlane(t_ >> 6); C.lds = (lptr)(size_t)l_; } while (0)

__device__ __forceinline__ int refcol(int n) { return n < 1536 ? n : n < 2304 ? n + 4 : n < 2720 ? n + 8 : n < 2724 ? 1536 + (n - 2720) : n < 2728 ? 2308 + (n - 2724) : -1; }

struct TrItem { const float* W; int ldw, scol4, k0; const float* gk; bf16_t* dst; int K; };
__device__ __forceinline__ void tr_load(const TrItem& t, f32x4 (&v)[8], int lane) {
    const int r8 = lane >> 3;
#pragma unroll
    for (int i = 0; i < 8; ++i) { v[i] = (f32x4){0.f, 0.f, 0.f, 0.f}; if (t.scol4 >= 0) v[i] = *(const f32x4*)(t.W + (size_t)(t.k0 + 8 * i + r8) * t.ldw + t.scol4); }
}
__device__ __forceinline__ void tr_store(const TrItem& t, const f32x4 (&v)[8], LAS float* scr, int lane) {
    const int r8 = lane >> 3, c4 = lane & 7;
#pragma unroll
    for (int i = 0; i < 8; ++i) { const int kk = 8 * i + r8; const float g = t.gk ? t.gk[t.k0 + kk] : 1.0f; LAS float* p = scr + kk * 33 + 4 * c4;
        p[0] = v[i].x * g; p[1] = v[i].y * g; p[2] = v[i].z * g; p[3] = v[i].w * g; }
    LDS_WAIT(); asm volatile("" ::: "memory");
    const int c = lane & 7;
#pragma unroll
    for (int j = 0; j < 4; ++j) { const int n = (lane >> 3) + 8 * j; const LAS float* sp = scr + (8 * c) * 33 + n;
        u32x4 o; o.x = pk2(sp[0 * 33], sp[1 * 33]); o.y = pk2(sp[2 * 33], sp[3 * 33]); o.z = pk2(sp[4 * 33], sp[5 * 33]); o.w = pk2(sp[6 * 33], sp[7 * 33]);
        *(u32x4*)(t.dst + (size_t)n * t.K + 8 * c) = o; }
    LDS_WAIT(); asm volatile("" ::: "memory");
}

__device__ __forceinline__ void row_to_bf16(const float* xrow, bf16_t* orow, float* rstd_out, int lane) {
    const f32x4* xr = (const f32x4*)xrow + lane; f32x4 v[4]; float s = 0.f;
#pragma unroll
    for (int j = 0; j < 4; ++j) { v[j] = xr[64 * j]; s += (v[j].x * v[j].x + v[j].y * v[j].y) + (v[j].z * v[j].z + v[j].w * v[j].w); }
    s = wave_sum(s);
    if (lane == 0) *rstd_out = 1.0f / sqrtf(s * (1.0f / DM) + RMS_EPS);
    u32x2* o8 = (u32x2*)orow + lane;
#pragma unroll
    for (int j = 0; j < 4; ++j) { u32x2 w; w.x = pk2(v[j].x, v[j].y); w.y = pk2(v[j].z, v[j].w); o8[64 * j] = w; }
}

constexpr int P0_I_IN = 16 * 88, P0_I_OUT = 16 * 32, P0_I_UQ = 4 * 12, P0_I_UKV = 2 * 16, P0_I_L = P0_I_IN + P0_I_OUT + P0_I_UQ + P0_I_UKV;
__device__ __forceinline__ TrItem p0_item(Ctx& C, int it, int lane) {
    const int l = it / P0_I_L; int r = it % P0_I_L; const int c4 = (lane & 7) * 4; TrItem t;
    if (r < P0_I_IN) { const int kb = r / 88, nb = r % 88; t.W = C.a->in[3] + (size_t)l * 1024 * 2728; t.ldw = 2728; t.scol4 = refcol(32 * nb + c4); t.k0 = 64 * kb; t.gk = C.a->in[2] + l * 1024;
        t.dst = WSP(bf16_t, WS_WIN) + (size_t)l * NPROJ * 1024 + (size_t)(32 * nb) * 1024 + 64 * kb; t.K = 1024; return t; }
    r -= P0_I_IN;
    if (r < P0_I_OUT) { const int kb = r / 32, nb = r % 32; t.W = C.a->in[16] + (size_t)l * 1024 * 1024; t.ldw = 1024; t.scol4 = 32 * nb + c4; t.k0 = 64 * kb; t.gk = nullptr;
        t.dst = WSP(bf16_t, WS_WOUT) + (size_t)l * 1024 * 1024 + (size_t)(32 * nb) * 1024 + 64 * kb; t.K = 1024; return t; }
    r -= P0_I_OUT;
    if (r < P0_I_UQ) { const int kb = r / 12, nb = r % 12; t.W = C.a->in[14] + (size_t)l * 256 * 384; t.ldw = 384; t.scol4 = 32 * nb + c4; t.k0 = 64 * kb; t.gk = C.a->in[12] + l * 256;
        t.dst = WSP(bf16_t, WS_WUQ) + (size_t)l * 384 * 256 + (size_t)(32 * nb) * 256 + 64 * kb; t.K = 256; return t; }
    r -= P0_I_UQ;
    { const int kb = r / 16, nb = r % 16; t.W = C.a->in[15] + (size_t)l * 128 * 512; t.ldw = 512; t.scol4 = 32 * nb + c4; t.k0 = 64 * kb; t.gk = C.a->in[13] + l * 128;
        t.dst = WSP(bf16_t, WS_WUKV) + (size_t)l * 512 * 128 + (size_t)(32 * nb) * 128 + 64 * kb; t.K = 128; return t; }
}
__device__ __forceinline__ void p0_prologue(Ctx& C) {
    LAS float* scr = (LAS float*)(C.lds + C.wave * 8704);
    const int gw = C.bx * NWAVES + C.wave, NGW = C.G * NWAVES, lane = C.lane;
    for (int m = gw; m < T; m += 2 * NGW) { const int m2 = m + NGW; const bool two = m2 < T;
        const f32x4* xa = (const f32x4*)(C.a->in[0] + (size_t)m * DM) + lane; const f32x4* xb = (const f32x4*)(C.a->in[0] + (size_t)(two ? m2 : m) * DM) + lane;
        f32x4 va[4], vb[4]; float sa = 0.f, sb = 0.f;
#pragma unroll
        for (int j = 0; j < 4; ++j) { va[j] = xa[64 * j]; vb[j] = xb[64 * j]; }
#pragma unroll
        for (int j = 0; j < 4; ++j) { sa += (va[j].x * va[j].x + va[j].y * va[j].y) + (va[j].z * va[j].z + va[j].w * va[j].w); sb += (vb[j].x * vb[j].x + vb[j].y * vb[j].y) + (vb[j].z * vb[j].z + vb[j].w * vb[j].w); }
        sa = wave_sum(sa); sb = wave_sum(sb);
        if (lane == 0) { WSP(float, WS_RSTD)[m] = 1.0f / sqrtf(sa * (1.0f / DM) + RMS_EPS); if (two) WSP(float, WS_RSTD)[m2] = 1.0f / sqrtf(sb * (1.0f / DM) + RMS_EPS); }
        u32x2* oa = (u32x2*)(WSP(bf16_t, WS_X1) + (size_t)m * DM) + lane; u32x2* ob = (u32x2*)(WSP(bf16_t, WS_X1) + (size_t)m2 * DM) + lane;
#pragma unroll
        for (int j = 0; j < 4; ++j) { u32x2 w; w.x = pk2(va[j].x, va[j].y); w.y = pk2(va[j].z, va[j].w); oa[64 * j] = w; if (two) { u32x2 w2; w2.x = pk2(vb[j].x, vb[j].y); w2.y = pk2(vb[j].z, vb[j].w); ob[64 * j] = w2; } } }
    { f32x4 cur[8], nx[8]; int it = gw;
      if (it < 2 * P0_I_L) { TrItem t = p0_item(C, it, lane); tr_load(t, cur, lane); }
#pragma unroll 1
      for (; it < 2 * P0_I_L; it += NGW) { const bool more = it + NGW < 2 * P0_I_L;
          if (more) { TrItem tn = p0_item(C, it + NGW, lane); tr_load(tn, nx, lane); }
          TrItem t = p0_item(C, it, lane); tr_store(t, cur, scr, lane);
#pragma unroll
          for (int i = 0; i < 8; ++i) cur[i] = nx[i]; } }
    { float* wr = WSP(float, WS_WR);
      for (int e = C.bx * NTHR + C.tid; e < 2 * 36 * 1024; e += C.G * NTHR) { const int l = e / 36864, r = e % 36864, cc = r >> 10, k = r & 1023;
          wr[e] = C.a->in[17][l * 1024 + k] * (cc < 4 ? C.a->in[18][(size_t)l * 4096 + k * 4 + cc] : C.a->in[20][(size_t)l * 32768 + k * 32 + (cc - 4)]); } }
    { const int* pos = (const int*)C.a->in[1]; float* cs = WSP(float, WS_COS); float* sn = WSP(float, WS_SIN);
      for (int e = C.bx * NTHR + C.tid; e < T * 16; e += C.G * NTHR) { const int t = e >> 4, i = e & 15;
          const float inv = powf(10000.0f, -(float)(2 * i) / 32.0f); const float ang = (float)pos[t] * inv;
          const double rev = (double)ang * 0.15915494309189535; const double fr = rev - floor(rev); const float a = (float)(fr * 6.283185307179586);
          cs[e] = cosf(a); sn[e] = sinf(a); } }
}

constexpr int XS_LD = 264, BC_LD = 136, ML_LD = 72;
constexpr int XS_OFF = 0, BL_OFF = 33792, CL_OFF = 51200, ACUM_OFF = 68608, DT_OFF = 69632, SSQ_OFF = 70656, ML_OFF = 71680, PV_OFF = 108544;
static_assert(PV_OFF + 36864 <= LDS_SCR, "ssd lds");
__device__ __forceinline__ float log_sigmoid_f(float x) { return -(fmaxf(-x, 0.f) + log1pf(__expf(-fabsf(x)))); }

__device__ __forceinline__ void ssd_fill(Ctx& C, int l, int cu) {
    const int c = cu & 31, t0 = cu * 64; const bf16_t* PM = WSP(bf16_t, WS_PM); bf16_t* XBC = WSP(bf16_t, WS_XBC);
    const float* cw = C.a->in[6] + l * 4 * 512; const float* cb = C.a->in[7] + l * 512;
#pragma unroll 1
    for (int it = 0; it < 8; it += 2) { u32x4 raw[2][4];
#pragma unroll
        for (int u = 0; u < 2; ++u) { const int item = C.tid + NTHR * (it + u), lt = item >> 6, ch = (item & 63) * 8;
#pragma unroll
            for (int d = 0; d < 4; ++d) { const int sp = 64 * c + lt - 3 + d; raw[u][d] = (u32x4){0u, 0u, 0u, 0u};
                if (sp >= 0) raw[u][d] = *(const u32x4*)(PM + (size_t)(t0 + lt - 3 + d) * NPROJ + C_XBC + ch); } }
#pragma unroll
        for (int u = 0; u < 2; ++u) { const int item = C.tid + NTHR * (it + u), lt = item >> 6, ch = (item & 63) * 8;
            float acc[8];
#pragma unroll
            for (int j = 0; j < 8; ++j) acc[j] = cb[ch + j];
#pragma unroll
            for (int d = 0; d < 4; ++d) { const float* w = cw + d * 512 + ch; const u32x4 rw = raw[u][d];
                acc[0] += w[0] * bflo(rw.x); acc[1] += w[1] * bfhi(rw.x); acc[2] += w[2] * bflo(rw.y); acc[3] += w[3] * bfhi(rw.y);
                acc[4] += w[4] * bflo(rw.z); acc[5] += w[5] * bfhi(rw.z); acc[6] += w[6] * bflo(rw.w); acc[7] += w[7] * bfhi(rw.w); }
            u32x4 o; o.x = pk2(silu_f(acc[0]), silu_f(acc[1])); o.y = pk2(silu_f(acc[2]), silu_f(acc[3])); o.z = pk2(silu_f(acc[4]), silu_f(acc[5])); o.w = pk2(silu_f(acc[6]), silu_f(acc[7]));
            lptr dst = ch < 256 ? C.lds + XS_OFF + (lt * XS_LD + ch) * 2 : ch < 384 ? C.lds + BL_OFF + (lt * BC_LD + (ch - 256)) * 2 : C.lds + CL_OFF + (lt * BC_LD + (ch - 384)) * 2;
            *(LAS u32x4*)dst = o; *(u32x4*)(XBC + (size_t)(t0 + lt) * 512 + ch) = o; } }
    if (C.tid < 256) { const int lt = C.tid >> 2, h = C.tid & 3;
        const float dt = softplus_f(WSP(float, WS_FD)[(size_t)(t0 + lt) * 8 + 4 + h] + C.a->in[8][l * 4 + h]);
        ((LAS float*)(C.lds + DT_OFF))[lt * 4 + h] = dt; ((LAS float*)(C.lds + ACUM_OFF))[lt * 4 + h] = -__expf(C.a->in[9][l * 4 + h]) * dt;
        WSP(float, WS_DTAC)[(size_t)(t0 + lt) * 8 + h] = dt; }
    __syncthreads();
    if (C.wave < 4) { LAS float* ac = (LAS float*)(C.lds + ACUM_OFF) + C.lane * 4 + C.wave; float v = *ac;
#pragma unroll
        for (int o = 1; o < 64; o <<= 1) { const float y = __shfl_up(v, o); if (C.lane >= o) v += y; }
        *ac = v; WSP(float, WS_DTAC)[(size_t)(t0 + C.lane) * 8 + 4 + C.wave] = v; }
    __syncthreads();
}
__device__ __forceinline__ void ssd_load(Ctx& C, int cu) {
    const int t0 = cu * 64; const bf16_t* XBC = WSP(bf16_t, WS_XBC); u32x4 v[8];
#pragma unroll
    for (int it = 0; it < 8; ++it) { const int item = C.tid + NTHR * it, lt = item >> 6, ch = (item & 63) * 8; v[it] = *(const u32x4*)(XBC + (size_t)(t0 + lt) * 512 + ch); }
    float da = 0.f; if (C.tid < 512) da = WSP(float, WS_DTAC)[(size_t)t0 * 8 + C.tid];
#pragma unroll
    for (int it = 0; it < 8; ++it) { const int item = C.tid + NTHR * it, lt = item >> 6, ch = (item & 63) * 8;
        lptr dst = ch < 256 ? C.lds + XS_OFF + (lt * XS_LD + ch) * 2 : ch < 384 ? C.lds + BL_OFF + (lt * BC_LD + (ch - 256)) * 2 : C.lds + CL_OFF + (lt * BC_LD + (ch - 384)) * 2;
        *(LAS u32x4*)dst = v[it]; }
    { const int lt = C.tid >> 3, q = C.tid & 7; ((LAS float*)(C.lds + (q < 4 ? DT_OFF : ACUM_OFF)))[lt * 4 + (q & 3)] = da; }
    __syncthreads();
}

__device__ __forceinline__ void p2_unit(Ctx& C, int l, int cu, int en) {
    const int b = cu >> 5, c = cu & 31, t0 = cu * 64; const int tid = C.tid, lane = C.lane, w = C.wave, g = lane >> 4, i = lane & 15;
    const bf16_t* PM = WSP(bf16_t, WS_PM); bf16_t* Y = WSP(bf16_t, WS_S1);
    { const float* cw = C.a->in[4] + l * 3 * 256;
#pragma unroll 1
      for (int it = 0; it < 4; it += 2) { u32x4 cgr[2][3], vlr[2][3], bgr[2];
#pragma unroll
          for (int u = 0; u < 2; ++u) { const int item = tid + NTHR * (it + u), lt = item >> 5, ch = (item & 31) * 8;
              bgr[u] = *(const u32x4*)(PM + (size_t)(t0 + lt) * NPROJ + C_AB + ch);
#pragma unroll
              for (int d = 0; d < 3; ++d) { const int sp = 64 * c + lt - 2 + d; cgr[u][d] = (u32x4){0u, 0u, 0u, 0u}; vlr[u][d] = (u32x4){0u, 0u, 0u, 0u};
                  if (sp >= 0) { const size_t rr = (size_t)(t0 + lt - 2 + d) * NPROJ; cgr[u][d] = *(const u32x4*)(PM + rr + C_AC + ch); vlr[u][d] = *(const u32x4*)(PM + rr + C_AV + ch); } } }
#pragma unroll
          for (int u = 0; u < 2; ++u) { const int item = tid + NTHR * (it + u), lt = item >> 5, ch = (item & 31) * 8;
              float acc[8] = {0.f, 0.f, 0.f, 0.f, 0.f, 0.f, 0.f, 0.f};
              if (en & 1) {
#pragma unroll
                  for (int d = 0; d < 3; ++d) { const u32x4 cg = cgr[u][d], vl = vlr[u][d]; const float* wv = cw + d * 256 + ch;
                      acc[0] += wv[0] * bflo(cg.x) * bflo(vl.x); acc[1] += wv[1] * bfhi(cg.x) * bfhi(vl.x); acc[2] += wv[2] * bflo(cg.y) * bflo(vl.y); acc[3] += wv[3] * bfhi(cg.y) * bfhi(vl.y);
                      acc[4] += wv[4] * bflo(cg.z) * bflo(vl.z); acc[5] += wv[5] * bfhi(cg.z) * bfhi(vl.z); acc[6] += wv[6] * bflo(cg.w) * bflo(vl.w); acc[7] += wv[7] * bfhi(cg.w) * bfhi(vl.w); }
                  const u32x4 bg = bgr[u];
                  acc[0] *= bflo(bg.x); acc[1] *= bfhi(bg.x); acc[2] *= bflo(bg.y); acc[3] *= bfhi(bg.y); acc[4] *= bflo(bg.z); acc[5] *= bfhi(bg.z); acc[6] *= bflo(bg.w); acc[7] *= bfhi(bg.w); }
              u32x4 o; o.x = pk2(acc[0], acc[1]); o.y = pk2(acc[2], acc[3]); o.z = pk2(acc[4], acc[5]); o.w = pk2(acc[6], acc[7]);
              *(u32x4*)(Y + (size_t)(t0 + lt) * DM + ch) = o; } } }
    for (int mx = 1; mx < 4; ++mx) if (!((en >> mx) & 1)) {
        for (int it = 0; it < 4; ++it) { const int item = tid + NTHR * it, lt = item >> 5, ch = (item & 31) * 8; *(u32x4*)(Y + (size_t)(t0 + lt) * DM + 256 * mx + ch) = (u32x4){0u, 0u, 0u, 0u}; } }
    LAUNDER();
    if (en & 2) {
        const float* FD = WSP(float, WS_FD); const float* fb = C.a->in[5] + l * 4; LAS float* red = (LAS float*)(C.lds + LDS_SCR + SCR_RED);
        float ps[4] = {0.f, 0.f, 0.f, 0.f};
        for (int tk = tid; tk < 64 * c; tk += NTHR) { const f32x4 f = *(const f32x4*)(FD + (size_t)(b * SEQ + tk) * 8);
            ps[0] += log_sigmoid_f(f.x + fb[0]); ps[1] += log_sigmoid_f(f.y + fb[1]); ps[2] += log_sigmoid_f(f.z + fb[2]); ps[3] += log_sigmoid_f(f.w + fb[3]); }
#pragma unroll
        for (int h = 0; h < 4; ++h) ps[h] = wave_sum(ps[h]);
        if (lane == 0) { red[w * 4 + 0] = ps[0]; red[w * 4 + 1] = ps[1]; red[w * 4 + 2] = ps[2]; red[w * 4 + 3] = ps[3]; }
        __syncthreads();
        if (w < 4) { float pre = 0.f;
#pragma unroll
            for (int k = 0; k < 8; ++k) pre += red[k * 4 + w];
            float v = log_sigmoid_f(FD[(size_t)(t0 + lane) * 8 + w] + fb[w]);
#pragma unroll
            for (int o = 1; o < 64; o <<= 1) { const float y = __shfl_up(v, o); if (lane >= o) v += y; }
            WSP(float, WS_CUM)[(size_t)(t0 + lane) * 4 + w] = (pre + v) * LOG2E; }
        __syncthreads();
    }
    LAUNDER();
    if (en & 4) {
        ssd_fill(C, l, cu);
        const LAS float* AC = (const LAS float*)(C.lds + ACUM_OFF); const LAS float* DT = (const LAS float*)(C.lds + DT_OFF);
#pragma unroll 1
        for (int it = 0; it < 4; ++it) { const int item = tid + NTHR * it, lt = item >> 5, col = (item & 31) * 8, h = col >> 6, n = col & 63;
            const u32x4 s = *(const LAS u32x4*)(C.lds + BL_OFF + (lt * BC_LD + 64 * (h >> 1) + n) * 2);
            const float sc = DT[lt * 4 + h] * __expf(AC[63 * 4 + h] - AC[lt * 4 + h]);
            u32x4 o; o.x = pk2(bflo(s.x) * sc, bfhi(s.x) * sc); o.y = pk2(bflo(s.y) * sc, bfhi(s.y) * sc); o.z = pk2(bflo(s.z) * sc, bfhi(s.z) * sc); o.w = pk2(bflo(s.w) * sc, bfhi(s.w) * sc);
            *(LAS u32x4*)(C.lds + PV_OFF + (lt * XS_LD + col) * 2) = o; }
        __syncthreads();
        { const int h = w >> 1, rh = w & 1; float* ST = WSP(float, WS_ST) + (size_t)(cu * 4 + h) * 4096;
#pragma unroll
          for (int mbl = 0; mbl < 2; ++mbl) { const int mb = 2 * rh + mbl;
#pragma unroll
              for (int nb = 0; nb < 4; ++nb) { f32x4 acc = {0.f, 0.f, 0.f, 0.f};
#pragma unroll
                  for (int kk = 0; kk < 2; ++kk) { const int rb = 32 * kk + 8 * g;
                      const bf16x8 a = tr_frag(C.lds + XS_OFF, XS_LD, rb, rb + 4, 64 * h + 16 * mb, lane);
                      const bf16x8 bq = tr_frag(C.lds + PV_OFF, XS_LD, rb, rb + 4, 64 * h + 16 * nb, lane);
                      acc = mfma16(a, bq, acc); }
#pragma unroll
                  for (int r = 0; r < 4; ++r) ST[(16 * mb + 4 * g + r) * 64 + 16 * nb + i] = acc[r]; } }
          if (tid < 4) WSP(float, WS_CDEC)[cu * 4 + tid] = __expf(AC[63 * 4 + tid]); }
        __syncthreads();
    }
    LAUNDER();
    if (en & 8) {
        LAS float* RQ = (LAS float*)(C.lds + LDS_SCR + SCR_RQ); LAS float* RKV = (LAS float*)(C.lds + LDS_SCR + SCR_RKV);
        { const int lt = tid >> 3, sub = tid & 7; const bf16_t* pr = PM + (size_t)(t0 + lt) * NPROJ; float s1 = 0.f, s2 = 0.f;
#pragma unroll
          for (int k = 0; k < 4; ++k) { const u32x4 v = *(const u32x4*)(pr + C_CQ + sub * 32 + 8 * k);
              s1 += bflo(v.x) * bflo(v.x) + bfhi(v.x) * bfhi(v.x) + bflo(v.y) * bflo(v.y) + bfhi(v.y) * bfhi(v.y) + bflo(v.z) * bflo(v.z) + bfhi(v.z) * bfhi(v.z) + bflo(v.w) * bflo(v.w) + bfhi(v.w) * bfhi(v.w); }
#pragma unroll
          for (int k = 0; k < 2; ++k) { const u32x4 v = *(const u32x4*)(pr + C_CKV + sub * 16 + 8 * k);
              s2 += bflo(v.x) * bflo(v.x) + bfhi(v.x) * bfhi(v.x) + bflo(v.y) * bflo(v.y) + bfhi(v.y) * bfhi(v.y) + bflo(v.z) * bflo(v.z) + bfhi(v.z) * bfhi(v.z) + bflo(v.w) * bflo(v.w) + bfhi(v.w) * bfhi(v.w); }
          s1 += __shfl_xor(s1, 1); s1 += __shfl_xor(s1, 2); s1 += __shfl_xor(s1, 4); s2 += __shfl_xor(s2, 1); s2 += __shfl_xor(s2, 2); s2 += __shfl_xor(s2, 4);
          if (sub == 0) { RQ[lt] = 1.0f / sqrtf(s1 * (1.0f / 256.0f) + RMS_EPS); RKV[lt] = 1.0f / sqrtf(s2 * (1.0f / 128.0f) + RMS_EPS); } }
        __syncthreads();
        const float* COS = WSP(float, WS_COS); const float* SIN = WSP(float, WS_SIN);
        bf16_t* QM = WSP(bf16_t, WS_QM); bf16_t* KM = WSP(bf16_t, WS_KM); bf16_t* VM = WSP(bf16_t, WS_VM);
        {
          const bf16_t* WU = WSP(bf16_t, WS_WUQ) + (size_t)l * 384 * 256; f32x4 acc[3][4];
#pragma unroll
          for (int a = 0; a < 3; ++a)
#pragma unroll
              for (int m = 0; m < 4; ++m) acc[a][m] = (f32x4){0.f, 0.f, 0.f, 0.f};
          bf16x8 bq[2][4], af[2][3];
#define MQ_LOAD(B, kk) do { _Pragma("unroll") for (int m = 0; m < 4; ++m) bq[B][m] = *(const bf16x8*)(PM + (size_t)(t0 + 16 * m + i) * NPROJ + C_CQ + 32 * (kk) + 8 * g); \
              _Pragma("unroll") for (int a = 0; a < 3; ++a) af[B][a] = *(const bf16x8*)(WU + (size_t)(16 * (3 * w + a) + i) * 256 + 32 * (kk) + 8 * g); } while (0)
#define MQ_MMA(B) do { _Pragma("unroll") for (int a = 0; a < 3; ++a) _Pragma("unroll") for (int m = 0; m < 4; ++m) acc[a][m] = mfma16(af[B][a], bq[B][m], acc[a][m]); } while (0)
          MQ_LOAD(0, 0);
#pragma unroll 1
          for (int kk = 0; kk < 8; kk += 2) { MQ_LOAD(1, kk + 1); MQ_MMA(0); if (kk + 2 < 8) MQ_LOAD(0, kk + 2); MQ_MMA(1); }
#undef MQ_LOAD
#undef MQ_MMA
#pragma unroll
          for (int m = 0; m < 4; ++m) { const int tk = 16 * m + i; const float rq = RQ[tk];
#pragma unroll
              for (int a = 0; a < 3; ++a) acc[a][m] = acc[a][m] * rq;
              if (w & 1) { const f32x4 cs = *(const f32x4*)(COS + (size_t)(t0 + tk) * 16 + 4 * g), sn = *(const f32x4*)(SIN + (size_t)(t0 + tk) * 16 + 4 * g);
                  const f32x4 x1 = acc[1][m], x2 = acc[2][m]; acc[1][m] = x1 * cs - x2 * sn; acc[2][m] = x2 * cs + x1 * sn; }
#pragma unroll
              for (int a = 0; a < 3; ++a) { u32x2 o; o.x = pk2(acc[a][m][0], acc[a][m][1]); o.y = pk2(acc[a][m][2], acc[a][m][3]);
                  *(u32x2*)(QM + (size_t)(t0 + tk) * 384 + 16 * (3 * w + a) + 4 * g) = o; } } }
        LAUNDER();
        {
          const bf16_t* WU = WSP(bf16_t, WS_WUKV) + (size_t)l * 512 * 128; f32x4 acc[4][4];
#pragma unroll
          for (int a = 0; a < 4; ++a)
#pragma unroll
              for (int m = 0; m < 4; ++m) acc[a][m] = (f32x4){0.f, 0.f, 0.f, 0.f};
          bf16x8 bq[2][4], af[2][4];
#define MK_LOAD(B, kk) do { _Pragma("unroll") for (int m = 0; m < 4; ++m) bq[B][m] = *(const bf16x8*)(PM + (size_t)(t0 + 16 * m + i) * NPROJ + C_CKV + 32 * (kk) + 8 * g); \
              _Pragma("unroll") for (int a = 0; a < 4; ++a) af[B][a] = *(const bf16x8*)(WU + (size_t)(16 * (4 * w + a) + i) * 128 + 32 * (kk) + 8 * g); } while (0)
#define MK_MMA(B) do { _Pragma("unroll") for (int a = 0; a < 4; ++a) _Pragma("unroll") for (int m = 0; m < 4; ++m) acc[a][m] = mfma16(af[B][a], bq[B][m], acc[a][m]); } while (0)
          MK_LOAD(0, 0); MK_LOAD(1, 1); MK_MMA(0); MK_LOAD(0, 2); MK_MMA(1); MK_LOAD(1, 3); MK_MMA(0); MK_MMA(1);
#undef MK_LOAD
#undef MK_MMA
          const int hd = w >> 1;
#pragma unroll
          for (int m = 0; m < 4; ++m) { const int tk = 16 * m + i; const float rk = RKV[tk];
#pragma unroll
              for (int a = 0; a < 4; ++a) { const f32x4 v = acc[a][m] * rk; u32x2 o; o.x = pk2(v[0], v[1]); o.y = pk2(v[2], v[3]);
                  if (w & 1) *(u32x2*)(VM + (size_t)(t0 + tk) * 256 + 64 * hd + 16 * a + 4 * g) = o;
                  else       *(u32x2*)(KM + (size_t)(t0 + tk) * 384 + 96 * hd + 16 * a + 4 * g) = o; } } }
        {
          const int lt = tid >> 3, i0 = (tid & 7) * 2; const bf16_t* pr = PM + (size_t)(t0 + lt) * NPROJ + C_KR;
          const unsigned a = *(const unsigned*)(pr + i0), bb = *(const unsigned*)(pr + 16 + i0);
          const float c0 = COS[(size_t)(t0 + lt) * 16 + i0], c1 = COS[(size_t)(t0 + lt) * 16 + i0 + 1], s0 = SIN[(size_t)(t0 + lt) * 16 + i0], s1 = SIN[(size_t)(t0 + lt) * 16 + i0 + 1];
          const float x10 = bflo(a), x11 = bfhi(a), x20 = bflo(bb), x21 = bfhi(bb);
          const unsigned o1 = pk2(x10 * c0 - x20 * s0, x11 * c1 - x21 * s1), o2 = pk2(x20 * c0 + x10 * s0, x21 * c1 + x11 * s1);
#pragma unroll
          for (int hd = 0; hd < 4; ++hd) { *(unsigned*)(KM + (size_t)(t0 + lt) * 384 + 96 * hd + 64 + i0) = o1; *(unsigned*)(KM + (size_t)(t0 + lt) * 384 + 96 * hd + 80 + i0) = o2; } }
        __syncthreads();
    }
}

template <int DK, bool FOX>
__device__ __forceinline__ void attn_unit(Ctx& C, const bf16_t* Qg, int qp, const bf16_t* Kg, int kp, const bf16_t* Vg, int vp, bf16_t* Og, const float* cumg, int row0, int qb, float qscale) {
    constexpr int KLD = DK + 8, VLD = 72, KBUF = 64 * KLD * 2, VBUF = 64 * VLD * 2, BUFB = KBUF + VBUF + 256, NKK = DK / 32, CPR = DK / 8;
    const int tid = C.tid, lane = C.lane, w = C.wave, g = lane >> 4, i = lane & 15;
    const int q0w = qb * 128 + 16 * w, nt = 2 * (qb + 1);
    bf16x8 qf[NKK];
    { const bf16_t* qrow = Qg + (size_t)(row0 + q0w + i) * qp;
#pragma unroll
      for (int kk = 0; kk < NKK; ++kk) qf[kk] = *(const bf16x8*)(qrow + 32 * kk + 8 * g); }
    const float cq = FOX ? cumg[(size_t)(row0 + q0w + i) * 4] : 0.f;
    f32x4 o[4];
#pragma unroll
    for (int m = 0; m < 4; ++m) o[m] = (f32x4){0.f, 0.f, 0.f, 0.f};
    float mrun = -INFINITY, lsum = 0.f;
    const int kr0 = tid / CPR, kc0 = tid % CPR, kr1 = (tid + NTHR) / CPR, kc1 = (tid + NTHR) % CPR, vr = tid >> 3, vc = tid & 7;
    const bool k1 = (DK == 96) && (tid < 256);
    u32x4 kreg0, kreg1 = {0u, 0u, 0u, 0u}, vreg; float ckreg = 0.f;
#define AT_LOAD(kt) do { const size_t rb_ = (size_t)row0 + 64 * (kt); \
        kreg0 = *(const u32x4*)(Kg + (rb_ + kr0) * kp + 8 * kc0); if (k1) kreg1 = *(const u32x4*)(Kg + (rb_ + kr1) * kp + 8 * kc1); \
        vreg = *(const u32x4*)(Vg + (rb_ + vr) * vp + 8 * vc); if (FOX && tid < 64) ckreg = cumg[(rb_ + tid) * 4]; } while (0)
#define AT_STORE(buf) do { lptr b_ = C.lds + (buf) * BUFB; \
        *(LAS u32x4*)(b_ + (kr0 * KLD + 8 * kc0) * 2) = kreg0; if (k1) *(LAS u32x4*)(b_ + (kr1 * KLD + 8 * kc1) * 2) = kreg1; \
        *(LAS u32x4*)(b_ + KBUF + (vr * VLD + 8 * vc) * 2) = vreg; if (FOX && tid < 64) *(LAS float*)(b_ + KBUF + VBUF + tid * 4) = ckreg; } while (0)
    AT_LOAD(0); AT_STORE(0); __syncthreads();
#pragma unroll 1
    for (int kt = 0; kt < nt; ++kt) {
        const int cur = kt & 1;
        if (kt + 1 < nt) AT_LOAD(kt + 1);
        const bool active = FOX ? (64 * kt <= q0w + 15) : (kt <= (q0w >> 6));
        if (active) {
            lptr kb = C.lds + cur * BUFB; lptr vb = kb + KBUF; lptr ckb = vb + VBUF;
            f32x4 s[4];
#pragma unroll
            for (int n = 0; n < 4; ++n) { s[n] = (f32x4){0.f, 0.f, 0.f, 0.f};
#pragma unroll
                for (int kk = 0; kk < NKK; ++kk) { const bf16x8 a = *(const LAS bf16x8*)(kb + ((16 * n + i) * KLD + 32 * kk + 8 * g) * 2); s[n] = mfma16(a, qf[kk], s[n]); } }
            const bool needmask = FOX && (64 * kt + 63 > q0w);
            float mx = -INFINITY;
            if (FOX) {
#pragma unroll
                for (int n = 0; n < 4; ++n) { const f32x4 ck4 = *(const LAS f32x4*)(ckb + (16 * n + 4 * g) * 4);
#pragma unroll
                    for (int r = 0; r < 4; ++r) { float v = __builtin_fmaf(s[n][r], qscale, cq - ck4[r]);
                        if (needmask && (64 * kt + 16 * n + 4 * g + r > q0w + i)) v = -INFINITY;
                        s[n][r] = v; mx = fmaxf(mx, v); } }
            } else {
#pragma unroll
                for (int n = 0; n < 4; ++n)
#pragma unroll
                    for (int r = 0; r < 4; ++r) mx = fmaxf(mx, s[n][r]);
                mx *= qscale;
            }
            mx = fmaxf(mx, __shfl_xor(mx, 16)); mx = fmaxf(mx, __shfl_xor(mx, 32));
            if (__any(mx > mrun)) {
                const float mnew = fmaxf(mrun, mx), alpha = __builtin_amdgcn_exp2f(mrun - mnew); mrun = mnew; lsum *= alpha;
#pragma unroll
                for (int m = 0; m < 4; ++m) o[m] = o[m] * alpha; }
            float psum = 0.f;
#pragma unroll
            for (int n = 0; n < 4; ++n)
#pragma unroll
                for (int r = 0; r < 4; ++r) { const float p = __builtin_amdgcn_exp2f(FOX ? s[n][r] - mrun : __builtin_fmaf(s[n][r], qscale, -mrun)); s[n][r] = p; psum += p; }
            lsum += psum;
            bf16x8 pf[2];
#pragma unroll
            for (int kk = 0; kk < 2; ++kk) { const unsigned a0 = pk2(s[2 * kk][0], s[2 * kk][1]), a1 = pk2(s[2 * kk][2], s[2 * kk][3]), a2 = pk2(s[2 * kk + 1][0], s[2 * kk + 1][1]), a3 = pk2(s[2 * kk + 1][2], s[2 * kk + 1][3]);
                pf[kk] = __builtin_bit_cast(bf16x8, (u32x4){a0, a1, a2, a3}); }
#pragma unroll
            for (int m = 0; m < 4; ++m)
#pragma unroll
                for (int kk = 0; kk < 2; ++kk) { const bf16x8 a = tr_frag(vb, VLD, 32 * kk + 4 * g, 32 * kk + 16 + 4 * g, 16 * m, lane); o[m] = mfma16(a, pf[kk], o[m]); }
        }
        if (kt + 1 < nt) AT_STORE(cur ^ 1);
        __syncthreads();
    }
#undef AT_LOAD
#undef AT_STORE
    lsum += __shfl_xor(lsum, 16); lsum += __shfl_xor(lsum, 32);
    const float inv = 1.0f / lsum; bf16_t* orow = Og + (size_t)(row0 + q0w + i) * DM;
#pragma unroll
    for (int m = 0; m < 4; ++m) { u32x2 ov; ov.x = pk2(o[m][0] * inv, o[m][1] * inv); ov.y = pk2(o[m][2] * inv, o[m][3] * inv); *(u32x2*)(orow + 16 * m + 4 * g) = ov; }
}

template <int DK, bool FOX>
__device__ __forceinline__ void attn_half(lptr lds, int htid, int hw, int lane, const bf16_t* Qg, int qp, const bf16_t* Kg, int kp, const bf16_t* Vg, int vp, bf16_t* Og, const float* cumg, int row0, int qb, float qscale) {
    constexpr int KLD = DK + 8, VLD = 72, KBUF = 64 * KLD * 2, VBUF = 64 * VLD * 2, BUFB = KBUF + VBUF + 256, NKK = DK / 32, CPR = DK / 8, NKC = (64 * CPR) / 256;
    asm volatile("" : "+s"(Qg), "+s"(Kg), "+s"(Vg), "+s"(Og), "+s"(cumg), "+v"(htid), "+v"(lane));
    const int g = lane >> 4, i = lane & 15;
    const int q0w = qb * 128 + 32 * hw, nt = 2 * (qb + 1);
    bf16x8 qf[2][NKK]; float cq[2];
#pragma unroll
    for (int mq = 0; mq < 2; ++mq) { const bf16_t* qrow = Qg + (size_t)(row0 + q0w + 16 * mq + i) * qp;
#pragma unroll
        for (int kk = 0; kk < NKK; ++kk) qf[mq][kk] = *(const bf16x8*)(qrow + 32 * kk + 8 * g);
        cq[mq] = FOX ? cumg[(size_t)(row0 + q0w + 16 * mq + i) * 4] : 0.f; }
    f32x4 o[2][4];
#pragma unroll
    for (int mq = 0; mq < 2; ++mq)
#pragma unroll
        for (int m = 0; m < 4; ++m) o[mq][m] = (f32x4){0.f, 0.f, 0.f, 0.f};
    float mrun[2] = {-INFINITY, -INFINITY}, lsum[2] = {0.f, 0.f};
    u32x4 kreg[NKC], vreg[2]; float ckreg = 0.f;
    unsigned kgo[NKC], klo[NKC], vgo[2], vlo[2];
#pragma unroll
    for (int c_ = 0; c_ < NKC; ++c_) { const int id_ = htid + 256 * c_; kgo[c_] = (unsigned)((id_ / CPR) * kp + 8 * (id_ % CPR)) * 2u; klo[c_] = (unsigned)((id_ / CPR) * KLD + 8 * (id_ % CPR)) * 2u; }
#pragma unroll
    for (int c_ = 0; c_ < 2; ++c_) { const int id_ = htid + 256 * c_; vgo[c_] = (unsigned)((id_ >> 3) * vp + 8 * (id_ & 7)) * 2u; vlo[c_] = (unsigned)(KBUF + ((id_ >> 3) * VLD + 8 * (id_ & 7)) * 2); }
#define AH_LOAD(kt) do { const size_t rb_ = (size_t)row0 + 64 * (kt); const char* kbase_ = (const char*)(Kg + rb_ * kp); const char* vbase_ = (const char*)(Vg + rb_ * vp); \
        _Pragma("unroll") for (int c_ = 0; c_ < NKC; ++c_) kreg[c_] = *(const u32x4*)(kbase_ + kgo[c_]); \
        _Pragma("unroll") for (int c_ = 0; c_ < 2; ++c_) vreg[c_] = *(const u32x4*)(vbase_ + vgo[c_]); \
        if (FOX && htid < 64) ckreg = cumg[(rb_ + htid) * 4]; } while (0)
#define AH_STORE(buf) do { lptr b_ = lds + (buf) * BUFB; \
        _Pragma("unroll") for (int c_ = 0; c_ < NKC; ++c_) *(LAS u32x4*)(b_ + klo[c_]) = kreg[c_]; \
        _Pragma("unroll") for (int c_ = 0; c_ < 2; ++c_) *(LAS u32x4*)(b_ + vlo[c_]) = vreg[c_]; \
        if (FOX && htid < 64) *(LAS float*)(b_ + KBUF + VBUF + htid * 4) = ckreg; } while (0)
    AH_LOAD(0); AH_STORE(0); __syncthreads();
#pragma unroll 1
    for (int kt = 0; kt < nt; ++kt) {
        const int cur = kt & 1;
        if (kt + 1 < nt) AH_LOAD(kt + 1);
        const bool active = FOX ? (64 * kt <= q0w + 31) : (kt <= (q0w >> 6));
        if (active) {
            lptr kb = lds + cur * BUFB; lptr vb = kb + KBUF; lptr ckb = vb + VBUF; lptr vtr = vb + ((4 * g + (i >> 2)) * VLD + 4 * (i & 3)) * 2;
            f32x4 s[2][4];
#pragma unroll
            for (int n = 0; n < 4; ++n) { s[0][n] = (f32x4){0.f, 0.f, 0.f, 0.f}; s[1][n] = (f32x4){0.f, 0.f, 0.f, 0.f};
#pragma unroll
                for (int kk = 0; kk < NKK; ++kk) { const bf16x8 a = *(const LAS bf16x8*)(kb + ((16 * n + i) * KLD + 32 * kk + 8 * g) * 2); s[0][n] = mfma16(a, qf[0][kk], s[0][n]); s[1][n] = mfma16(a, qf[1][kk], s[1][n]); }
                if (n & 1) __builtin_amdgcn_sched_barrier(0); }
            const bool needmask = FOX && (64 * kt + 63 > q0w);
            float mx[2] = {-INFINITY, -INFINITY};
            if (FOX) {
#pragma unroll
                for (int n = 0; n < 4; ++n) { const f32x4 ck4 = *(const LAS f32x4*)(ckb + (16 * n + 4 * g) * 4);
#pragma unroll
                    for (int mq = 0; mq < 2; ++mq)
#pragma unroll
                        for (int r = 0; r < 4; ++r) { float v = __builtin_fmaf(s[mq][n][r], qscale, -ck4[r]);
                            if (needmask && (64 * kt + 16 * n + 4 * g + r > q0w + 16 * mq + i)) v = -INFINITY;
                            s[mq][n][r] = v; mx[mq] = fmaxf(mx[mq], v); } }
            } else {
#pragma unroll
                for (int mq = 0; mq < 2; ++mq) {
#pragma unroll
                    for (int n = 0; n < 4; ++n)
#pragma unroll
                        for (int r = 0; r < 4; ++r) mx[mq] = fmaxf(mx[mq], s[mq][n][r]);
                    mx[mq] *= qscale; }
            }
#pragma unroll
            for (int mq = 0; mq < 2; ++mq) { mx[mq] = fmaxf(mx[mq], __shfl_xor(mx[mq], 16)); mx[mq] = fmaxf(mx[mq], __shfl_xor(mx[mq], 32)); }
            if (__any(mx[0] > mrun[0] || mx[1] > mrun[1])) {
#pragma unroll
                for (int mq = 0; mq < 2; ++mq) { const float mnew = fmaxf(mrun[mq], mx[mq]), alpha = __builtin_amdgcn_exp2f(mrun[mq] - mnew); mrun[mq] = mnew; lsum[mq] *= alpha;
#pragma unroll
                    for (int m = 0; m < 4; ++m) o[mq][m] = o[mq][m] * alpha; } }
            bf16x8 pf[2][2];
#pragma unroll
            for (int mq = 0; mq < 2; ++mq) { float psum = 0.f;
#pragma unroll
                for (int n = 0; n < 4; ++n)
#pragma unroll
                    for (int r = 0; r < 4; ++r) { const float p = __builtin_amdgcn_exp2f(FOX ? s[mq][n][r] - mrun[mq] : __builtin_fmaf(s[mq][n][r], qscale, -mrun[mq])); s[mq][n][r] = p; psum += p; }
                lsum[mq] += psum;
#pragma unroll
                for (int kk = 0; kk < 2; ++kk) { const unsigned a0 = pk2(s[mq][2 * kk][0], s[mq][2 * kk][1]), a1 = pk2(s[mq][2 * kk][2], s[mq][2 * kk][3]), a2 = pk2(s[mq][2 * kk + 1][0], s[mq][2 * kk + 1][1]), a3 = pk2(s[mq][2 * kk + 1][2], s[mq][2 * kk + 1][3]);
                    pf[mq][kk] = __builtin_bit_cast(bf16x8, (u32x4){a0, a1, a2, a3}); } }
#pragma unroll
            for (int m = 0; m < 4; ++m)
#pragma unroll
                for (int kk = 0; kk < 2; ++kk) { const bf16x8 a = tr_frag(vb, VLD, 32 * kk + 4 * g, 32 * kk + 16 + 4 * g, 16 * m, lane); o[0][m] = mfma16(a, pf[0][kk], o[0][m]); o[1][m] = mfma16(a, pf[1][kk], o[1][m]);
                    if (kk) __builtin_amdgcn_sched_barrier(0); }
        }
        if (kt + 1 < nt) AH_STORE(cur ^ 1);
        __syncthreads();
    }
#undef AH_LOAD
#undef AH_STORE
#pragma unroll
    for (int mq = 0; mq < 2; ++mq) { float ls = lsum[mq]; ls += __shfl_xor(ls, 16); ls += __shfl_xor(ls, 32);
        const float inv = 1.0f / ls; bf16_t* orow = Og + (size_t)(row0 + q0w + 16 * mq + i) * DM;
#pragma unroll
        for (int m = 0; m < 4; ++m) { u32x2 ov; ov.x = pk2(o[mq][m][0] * inv, o[mq][m][1] * inv); ov.y = pk2(o[mq][m][2] * inv, o[mq][m][3] * inv); *(u32x2*)(orow + 16 * m + 4 * g) = ov; } }
}

__device__ __forceinline__ void ssd_scan(Ctx& C) {
    typedef float f32x2 __attribute__((ext_vector_type(2)));
    const float* STG = WSP(float, WS_ST); const float* CD = WSP(float, WS_CDEC); bf16_t* PRV = WSP(bf16_t, WS_PREV);
    for (int gid = C.bx * NTHR + C.tid; gid < 65536; gid += C.G * NTHR) { const int b = gid >> 13, rem = gid & 8191, h = rem >> 11, f = rem & 2047;
        f32x2 acc = {0.f, 0.f};
#pragma unroll 1
        for (int c0 = 0; c0 < 32; c0 += 16) { f32x2 v[16]; float d[16];
#pragma unroll
            for (int k = 0; k < 16; ++k) { const int cuu = b * 32 + c0 + k; v[k] = *(const f32x2*)(STG + (size_t)(cuu * 4 + h) * 4096 + f * 2); d[k] = CD[cuu * 4 + h]; }
#pragma unroll
            for (int k = 0; k < 16; ++k) { const int cuu = b * 32 + c0 + k; *(unsigned*)(PRV + (size_t)(cuu * 4 + h) * 4096 + f * 2) = pk2(acc.x, acc.y); acc = acc * d[k] + v[k]; } } }
}

__device__ __forceinline__ void p3_ssd_unit(Ctx& C, int l, int cu) {
    const int t0 = cu * 64; const int tid = C.tid, lane = C.lane, w = C.wave, g = lane >> 4, i = lane & 15;
    const bf16_t* PM = WSP(bf16_t, WS_PM); bf16_t* Y = WSP(bf16_t, WS_S1);
    const int h = w >> 1, rh = w & 1, grp = h >> 1; const int lr_l = lane >> 1, hf = lane & 1, lr = 32 * rh + lr_l;
    u32x4 zv[4];
#pragma unroll
    for (int k = 0; k < 4; ++k) zv[k] = *(const u32x4*)(PM + (size_t)(t0 + lr) * NPROJ + C_Z + 64 * h + 32 * hf + 8 * k);
    { const bf16_t* PRV = WSP(bf16_t, WS_PREV) + (size_t)cu * 16384; u32x4 pv[4];
#pragma unroll
      for (int k = 0; k < 4; ++k) pv[k] = *(const u32x4*)(PRV + (size_t)(tid + NTHR * k) * 8);
      ssd_load(C, cu);
#pragma unroll
      for (int k = 0; k < 4; ++k) { const int f = tid + NTHR * k, hh = f >> 9, rem = f & 511, p = rem >> 3, n = (rem & 7) * 8;
          *(LAS u32x4*)(C.lds + PV_OFF + ((hh * 64 + p) * ML_LD + n) * 2) = pv[k]; } }
    __syncthreads();
    const LAS float* AC = (const LAS float*)(C.lds + ACUM_OFF); const LAS float* DT = (const LAS float*)(C.lds + DT_OFF);
    lptr MLw = C.lds + ML_OFF + w * (32 * ML_LD * 2);
    const float Dh = C.a->in[10][l * 4 + h];
#pragma unroll 1
    for (int mbl = 0; mbl < 2; ++mbl) { const int mb = 2 * rh + mbl;
#pragma unroll
        for (int nb = 0; nb < 4; ++nb) { f32x4 acc = {0.f, 0.f, 0.f, 0.f};
#pragma unroll
            for (int kk = 0; kk < 2; ++kk) { const bf16x8 a = *(const LAS bf16x8*)(C.lds + CL_OFF + ((16 * mb + i) * BC_LD + 64 * grp + 32 * kk + 8 * g) * 2);
                const bf16x8 bq = *(const LAS bf16x8*)(C.lds + BL_OFF + ((16 * nb + i) * BC_LD + 64 * grp + 32 * kk + 8 * g) * 2); acc = mfma16(a, bq, acc); }
            const int s = 16 * nb + i; const float as = AC[s * 4 + h], ds = DT[s * 4 + h];
#pragma unroll
            for (int r = 0; r < 4; ++r) { const int lrow = 16 * mb + 4 * g + r; const float v = (s <= lrow) ? acc[r] * __expf(AC[lrow * 4 + h] - as) * ds : 0.f;
                *(LAS unsigned short*)(MLw + ((16 * mbl + 4 * g + r) * ML_LD + s) * 2) = (unsigned short)f2bf(v); } }
        LDS_WAIT(); asm volatile("" ::: "memory");
        f32x4 ad[4], ao[4];
#pragma unroll
        for (int nb = 0; nb < 4; ++nb) { ad[nb] = (f32x4){0.f, 0.f, 0.f, 0.f}; ao[nb] = (f32x4){0.f, 0.f, 0.f, 0.f};
#pragma unroll
            for (int kk = 0; kk < 2; ++kk) {
                const bf16x8 a = *(const LAS bf16x8*)(MLw + ((16 * mbl + i) * ML_LD + 32 * kk + 8 * g) * 2);
                const bf16x8 bx = tr_frag(C.lds + XS_OFF, XS_LD, 32 * kk + 8 * g, 32 * kk + 8 * g + 4, 64 * h + 16 * nb, lane);
                ad[nb] = mfma16(a, bx, ad[nb]);
                const bf16x8 a2 = *(const LAS bf16x8*)(C.lds + CL_OFF + ((16 * mb + i) * BC_LD + 64 * grp + 32 * kk + 8 * g) * 2);
                const bf16x8 b2 = *(const LAS bf16x8*)(C.lds + PV_OFF + ((h * 64 + 16 * nb + i) * ML_LD + 32 * kk + 8 * g) * 2);
                ao[nb] = mfma16(a2, b2, ao[nb]); } }
        LDS_WAIT(); asm volatile("" ::: "memory");
#pragma unroll
        for (int nb = 0; nb < 4; ++nb)
#pragma unroll
            for (int r = 0; r < 4; ++r) { const int lrow = 16 * mb + 4 * g + r;
                const float y = ad[nb][r] + __expf(AC[lrow * 4 + h]) * ao[nb][r];
                *(LAS unsigned short*)(MLw + ((16 * mbl + 4 * g + r) * ML_LD + 16 * nb + i) * 2) = (unsigned short)f2bf(y); } }
    LDS_WAIT(); asm volatile("" ::: "memory");
    float yv[32]; float sq = 0.f;
#pragma unroll
    for (int k = 0; k < 4; ++k) { const u32x4 ys = *(const LAS u32x4*)(MLw + (lr_l * ML_LD + 32 * hf + 8 * k) * 2); const u32x4 xs = *(const LAS u32x4*)(C.lds + XS_OFF + (lr * XS_LD + 64 * h + 32 * hf + 8 * k) * 2); const u32x4 z = zv[k];
        const unsigned yw[4] = {ys.x, ys.y, ys.z, ys.w}, xw[4] = {xs.x, xs.y, xs.z, xs.w}, zw[4] = {z.x, z.y, z.z, z.w};
#pragma unroll
        for (int q = 0; q < 4; ++q) { const float y0 = (bflo(yw[q]) + Dh * bflo(xw[q])) * silu_f(bflo(zw[q])), y1 = (bfhi(yw[q]) + Dh * bfhi(xw[q])) * silu_f(bfhi(zw[q]));
            yv[8 * k + 2 * q] = y0; yv[8 * k + 2 * q + 1] = y1; sq += y0 * y0 + y1 * y1; } }
    sq += __shfl_xor(sq, 1);
    if (hf == 0) ((LAS float*)(C.lds + SSQ_OFF))[lr * 4 + h] = sq;
    __syncthreads();
    { const float* gn = C.a->in[11] + l * 256; const f32x4 q4 = *(const LAS f32x4*)(C.lds + SSQ_OFF + lr * 16);
      const float rs = 1.0f / sqrtf(((q4.x + q4.y) + (q4.z + q4.w)) * (1.0f / 256.0f) + RMS_EPS);
#pragma unroll
      for (int k = 0; k < 4; ++k) { const int ch = 64 * h + 32 * hf + 8 * k; const f32x4 g0 = *(const f32x4*)(gn + ch), g1 = *(const f32x4*)(gn + ch + 4);
          u32x4 o; o.x = pk2(yv[8 * k] * rs * g0.x, yv[8 * k + 1] * rs * g0.y); o.y = pk2(yv[8 * k + 2] * rs * g0.z, yv[8 * k + 3] * rs * g0.w);
          o.z = pk2(yv[8 * k + 4] * rs * g1.x, yv[8 * k + 5] * rs * g1.y); o.w = pk2(yv[8 * k + 6] * rs * g1.z, yv[8 * k + 7] * rs * g1.w);
          *(u32x4*)(Y + (size_t)(t0 + lr) * DM + 512 + ch) = o; } }
    __syncthreads();
}

__device__ __forceinline__ void moe_tables(Ctx& C, int l) {
    LAS int* cnt = (LAS int*)(C.lds + LDS_SCR + SCR_CNT); LAS int* tb = (LAS int*)(C.lds + LDS_SCR + SCR_TBASE); LAS int* te = (LAS int*)(C.lds + LDS_SCR + SCR_TILEE); LAS int* ntp = (LAS int*)(C.lds + LDS_SCR + SCR_NT);
    if (C.tid < 32) cnt[C.tid] = (int)__hip_atomic_load(WSP(unsigned, WS_CTL) + CW_CNT + l * 32 + C.tid, __ATOMIC_RELAXED, __HIP_MEMORY_SCOPE_AGENT);
    __syncthreads();
    if (C.tid == 0) { int a = 0; for (int e = 0; e < 32; ++e) { tb[e] = a; a += (cnt[e] + 255) >> 8; } tb[32] = a; *ntp = a; }
    __syncthreads();
    if (C.tid < 160) { int e = 0; for (int k = 1; k < 32; ++k) if (tb[k] <= C.tid) e = k; te[C.tid] = e; }
    __syncthreads();
}
template <int NPN> struct MoeOrder {
    static constexpr int npn = NPN; int G, c; const LAS int* cnt; const LAS int* tb; const LAS int* te; int ntile; const int* rowl;
    __device__ __forceinline__ bool next(int i, pg8::Unit& u) const {
        const int L = i * G + c; if (L >= ntile * npn) return false;
        const int ti = L / npn, pnl = L % npn; const int e = __builtin_amdgcn_readfirstlane(te[ti]);
        u.pm = ti; u.pn = e * npn + pnl; u.e = e; u.r0 = (ti - __builtin_amdgcn_readfirstlane(tb[e])) * 256; u.ne = __builtin_amdgcn_readfirstlane(cnt[e]); return true;
    }
    __device__ __forceinline__ int arow(const pg8::Unit& u, int r) const { const int rr = u.r0 + r; return rr < u.ne ? rowl[(size_t)u.e * T + rr] : 0; }
    __device__ __forceinline__ void a_ready(const pg8::Unit&) const {}
    __device__ __forceinline__ void done(const pg8::Unit&) const {}
};

__device__ __forceinline__ TrItem p5_item(Ctx& C, int l, int it, int lane) {
    const int e = it / 384, r = it % 384, c4 = (lane & 7) * 4; TrItem t;
    if (r < 256) { const int kb = r >> 4, nb = r & 15, n = 32 * nb, pn = n >> 8, bj = (n >> 7) & 1, ff = (n & 127) + c4;
        t.W = (bj ? C.a->in[23] : C.a->in[22]) + (size_t)(l * 32 + e) * 1024 * 256; t.ldw = 256; t.scol4 = 128 * pn + ff; t.k0 = 64 * kb; t.gk = C.a->in[17] + l * 1024;
        t.dst = WSP(bf16_t, WS_BGU) + (size_t)e * 512 * 1024 + (size_t)(32 * nb) * 1024 + 64 * kb; t.K = 1024; }
    else { const int r2 = r - 256, kb = r2 >> 5, nb = r2 & 31;
        t.W = C.a->in[24] + (size_t)(l * 32 + e) * 256 * 1024; t.ldw = 1024; t.scol4 = 32 * nb + c4; t.k0 = 64 * kb; t.gk = nullptr;
        t.dst = WSP(bf16_t, WS_BD) + (size_t)e * 1024 * 256 + (size_t)(32 * nb) * 256 + 64 * kb; t.K = 256; }
    return t;
}
__device__ __forceinline__ void p5_router(Ctx& C, int l, int en) {
    const int gw = C.bx * NWAVES + C.wave, NGW = C.G * NWAVES, lane = C.lane;
    if (!(en & 16)) return;
    { LAS float* scr = (LAS float*)(C.lds + C.wave * 8704); f32x4 cur[8], nx[8]; int it = gw;
      if (it < 32 * 384) { TrItem t = p5_item(C, l, it, lane); tr_load(t, cur, lane); }
#pragma unroll 1
      for (; it < 32 * 384; it += NGW) { const bool more = it + NGW < 32 * 384;
          if (more) { TrItem tn = p5_item(C, l, it + NGW, lane); tr_load(tn, nx, lane); }
          TrItem t = p5_item(C, l, it, lane); tr_store(t, cur, scr, lane);
#pragma unroll
          for (int i = 0; i < 8; ++i) cur[i] = nx[i]; } }
    __syncthreads();
    LAS float* WR = (LAS float*)C.lds;
    { const f32x4* src = (const f32x4*)(WSP(float, WS_WR) + (size_t)l * 36864);
#pragma unroll 1
      for (int it = 0; it < 18; it += 6) { f32x4 v[6];
#pragma unroll
          for (int k = 0; k < 6; ++k) v[k] = src[C.tid + NTHR * (it + k)];
#pragma unroll
          for (int k = 0; k < 6; ++k) ((LAS f32x4*)WR)[C.tid + NTHR * (it + k)] = v[k]; } }
    LAS int* cntL = (LAS int*)(C.lds + LDS_SCR + SCR_CNT); LAS int* baseL = (LAS int*)(C.lds + LDS_SCR + SCR_TBASE);
    const bf16_t* XR = WSP(bf16_t, WS_X1); float* ROWRS = WSP(float, WS_ROWRS);
    unsigned* CNT = WSP(unsigned, WS_CTL) + CW_CNT + l * 32; int* ROWL = WSP(int, WS_ROWL); int* TE = WSP(int, WS_TOKE); int* TP = WSP(int, WS_TOKP); float* TW = WSP(float, WS_TOKW);
    for (int chunk = C.bx; chunk < T / 64; chunk += C.G) {
        if (C.tid < 32) cntL[C.tid] = 0;
        __syncthreads();
        const int tb0 = chunk * 64 + C.wave * 8; int mE0 = 0, mE1 = 0; float mW0 = 0.f, mW1 = 0.f, mRS = 0.f;
        u32x2 xn[4];
        { const u32x2* xr = (const u32x2*)(XR + (size_t)tb0 * DM) + lane;
#pragma unroll
          for (int j = 0; j < 4; ++j) xn[j] = xr[64 * j]; }
#pragma unroll 1
        for (int jt = 0; jt < 8; ++jt) { const int t = tb0 + jt;
            f32x4 xv[4];
#pragma unroll
            for (int j = 0; j < 4; ++j) { xv[j].x = bflo(xn[j].x); xv[j].y = bfhi(xn[j].x); xv[j].z = bflo(xn[j].y); xv[j].w = bfhi(xn[j].y); }
            if (jt + 1 < 8) { const u32x2* xr = (const u32x2*)(XR + (size_t)(t + 1) * DM) + lane;
#pragma unroll
                for (int j = 0; j < 4; ++j) xn[j] = xr[64 * j]; }
            float sq = 0.f;
#pragma unroll
            for (int j = 0; j < 4; ++j) sq += (xv[j].x * xv[j].x + xv[j].y * xv[j].y) + (xv[j].z * xv[j].z + xv[j].w * xv[j].w);
            const float rstd = 1.0f / sqrtf(wave_sum(sq) * (1.0f / DM) + RMS_EPS);
            float lg[4];
#pragma unroll
            for (int cc = 0; cc < 4; ++cc) { float p = 0.f;
#pragma unroll
                for (int j = 0; j < 4; ++j) { const f32x4 wv = *(const LAS f32x4*)(WR + cc * 1024 + 256 * j + 4 * lane); p += (xv[j].x * wv.x + xv[j].y * wv.y) + (xv[j].z * wv.z + xv[j].w * wv.w); }
                lg[cc] = wave_sum(p) * rstd + C.a->in[19][l * 4 + cc]; }
            int gi = 0; float gm = lg[0];
#pragma unroll
            for (int cc = 1; cc < 4; ++cc) if (lg[cc] > gm) { gm = lg[cc]; gi = cc; }
            float gs = 0.f;
#pragma unroll
            for (int cc = 0; cc < 4; ++cc) gs += __expf(lg[cc] - gm);
            const float gwt = 1.0f / gs;
            gi = __builtin_amdgcn_readfirstlane(gi);
            float le[8];
#pragma unroll
            for (int e = 0; e < 8; ++e) { float p = 0.f; const LAS float* wrow = WR + (4 + 8 * gi + e) * 1024;
#pragma unroll
                for (int j = 0; j < 4; ++j) { const f32x4 wv = *(const LAS f32x4*)(wrow + 256 * j + 4 * lane); p += (xv[j].x * wv.x + xv[j].y * wv.y) + (xv[j].z * wv.z + xv[j].w * wv.w); }
                le[e] = wave_sum(p) * rstd + C.a->in[21][l * 32 + 8 * gi + e]; }
            int e0 = 0; float m0 = le[0];
#pragma unroll
            for (int e = 1; e < 8; ++e) if (le[e] > m0) { m0 = le[e]; e0 = e; }
            int e1 = (e0 == 0) ? 1 : 0; float m1 = -INFINITY;
#pragma unroll
            for (int e = 0; e < 8; ++e) if (e != e0 && le[e] > m1) { m1 = le[e]; e1 = e; }
            const float w0 = 1.0f / (1.0f + __expf(m1 - m0)), w1 = 1.0f - w0;
            if (lane == jt) { mE0 = 8 * gi + e0; mE1 = 8 * gi + e1; mW0 = gwt * w0; mW1 = gwt * w1; mRS = rstd; }
        }
        int r0 = 0, r1 = 0;
        if (lane < 8) { r0 = __hip_atomic_fetch_add(cntL + mE0, 1, __ATOMIC_RELAXED, __HIP_MEMORY_SCOPE_WORKGROUP); r1 = __hip_atomic_fetch_add(cntL + mE1, 1, __ATOMIC_RELAXED, __HIP_MEMORY_SCOPE_WORKGROUP); }
        __syncthreads();
        if (C.tid < 32) { const int n = cntL[C.tid]; baseL[C.tid] = n ? (int)__hip_atomic_fetch_add(CNT + C.tid, (unsigned)n, __ATOMIC_RELAXED, __HIP_MEMORY_SCOPE_AGENT) : 0; }
        __syncthreads();
        if (lane < 8) { const int t = tb0 + lane; const int p0 = baseL[mE0] + r0, p1 = baseL[mE1] + r1;
            ROWL[(size_t)mE0 * T + p0] = t; ROWL[(size_t)mE1 * T + p1] = t; ROWRS[(size_t)mE0 * T + p0] = mRS; ROWRS[(size_t)mE1 * T + p1] = mRS;
            TE[t * 2] = mE0; TE[t * 2 + 1] = mE1; TP[t * 2] = p0; TP[t * 2 + 1] = p1; TW[t * 2] = mW0; TW[t * 2 + 1] = mW1; }
        __syncthreads();
    }
}

__device__ __forceinline__ void p7_combine(Ctx& C, int l, int en, bool last_layer) {
    const int gw = C.bx * NWAVES + C.wave, NGW = C.G * NWAVES, lane = C.lane;
    const LAS int* tb = (const LAS int*)(C.lds + LDS_SCR + SCR_TBASE);
    const bool moe = (en & 16) != 0;
    if (moe) moe_tables(C, l);
    bf16_t* XR = WSP(bf16_t, WS_X1); const bf16_t* YS = WSP(bf16_t, WS_PM); const int* TE = WSP(int, WS_TOKE); const int* TP = WSP(int, WS_TOKP); const float* TW = WSP(float, WS_TOKW);
    for (int tbase = gw; tbase < T; tbase += 64 * NGW) {
        int ms0 = 0, ms1 = 0; float mw0 = 0.f, mw1 = 0.f;
        { const int t = tbase + lane * NGW;
          if (moe && t < T) { const int e0 = TE[t * 2], e1 = TE[t * 2 + 1]; ms0 = tb[e0] * 256 + TP[t * 2]; ms1 = tb[e1] * 256 + TP[t * 2 + 1]; mw0 = TW[t * 2]; mw1 = TW[t * 2 + 1]; } }
#pragma unroll 1
        for (int j0 = 0; j0 < 64; j0 += 2) { const int ta = tbase + j0 * NGW; if (ta >= T) break;
            const int tb2 = ta + NGW; const bool two = tb2 < T; const int tbb = two ? tb2 : ta;
            u32x2* xra = (u32x2*)(XR + (size_t)ta * DM) + lane; u32x2* xrb = (u32x2*)(XR + (size_t)tbb * DM) + lane; u32x2 ra_[4], rb_[4]; f32x4 xa[4], xb[4];
#pragma unroll
            for (int j = 0; j < 4; ++j) { ra_[j] = xra[64 * j]; rb_[j] = xrb[64 * j]; }
            u32x2 va0[4], va1[4], vb0[4], vb1[4]; float wa0 = 0.f, wa1 = 0.f, wb0 = 0.f, wb1 = 0.f;
            if (moe) {
                const int sa0 = __builtin_amdgcn_readlane(ms0, j0), sa1 = __builtin_amdgcn_readlane(ms1, j0), sb0 = __builtin_amdgcn_readlane(ms0, j0 + 1), sb1 = __builtin_amdgcn_readlane(ms1, j0 + 1);
                wa0 = __builtin_bit_cast(float, __builtin_amdgcn_readlane(__builtin_bit_cast(int, mw0), j0)); wa1 = __builtin_bit_cast(float, __builtin_amdgcn_readlane(__builtin_bit_cast(int, mw1), j0));
                wb0 = __builtin_bit_cast(float, __builtin_amdgcn_readlane(__builtin_bit_cast(int, mw0), j0 + 1)); wb1 = __builtin_bit_cast(float, __builtin_amdgcn_readlane(__builtin_bit_cast(int, mw1), j0 + 1));
                const u32x2* ya0 = (const u32x2*)(YS + (size_t)sa0 * DM) + lane; const u32x2* ya1 = (const u32x2*)(YS + (size_t)sa1 * DM) + lane;
                const u32x2* yb0 = (const u32x2*)(YS + (size_t)sb0 * DM) + lane; const u32x2* yb1 = (const u32x2*)(YS + (size_t)sb1 * DM) + lane;
#pragma unroll
                for (int j = 0; j < 4; ++j) { va0[j] = ya0[64 * j]; va1[j] = ya1[64 * j]; vb0[j] = yb0[64 * j]; vb1[j] = yb1[64 * j]; } }
#pragma unroll
            for (int j = 0; j < 4; ++j) { xa[j].x = bflo(ra_[j].x); xa[j].y = bfhi(ra_[j].x); xa[j].z = bflo(ra_[j].y); xa[j].w = bfhi(ra_[j].y);
                xb[j].x = bflo(rb_[j].x); xb[j].y = bfhi(rb_[j].x); xb[j].z = bflo(rb_[j].y); xb[j].w = bfhi(rb_[j].y); }
            if (moe) {
#pragma unroll
                for (int j = 0; j < 4; ++j) {
                    xa[j].x += wa0 * bflo(va0[j].x) + wa1 * bflo(va1[j].x); xa[j].y += wa0 * bfhi(va0[j].x) + wa1 * bfhi(va1[j].x); xa[j].z += wa0 * bflo(va0[j].y) + wa1 * bflo(va1[j].y); xa[j].w += wa0 * bfhi(va0[j].y) + wa1 * bfhi(va1[j].y);
                    xb[j].x += wb0 * bflo(vb0[j].x) + wb1 * bflo(vb1[j].x); xb[j].y += wb0 * bfhi(vb0[j].x) + wb1 * bfhi(vb1[j].x); xb[j].z += wb0 * bflo(vb0[j].y) + wb1 * bflo(vb1[j].y); xb[j].w += wb0 * bfhi(vb0[j].y) + wb1 * bfhi(vb1[j].y); } }
            float sa = 0.f, sb = 0.f;
#pragma unroll
            for (int j = 0; j < 4; ++j) { sa += (xa[j].x * xa[j].x + xa[j].y * xa[j].y) + (xa[j].z * xa[j].z + xa[j].w * xa[j].w); sb += (xb[j].x * xb[j].x + xb[j].y * xb[j].y) + (xb[j].z * xb[j].z + xb[j].w * xb[j].w); }
            const float ra = 1.0f / sqrtf(wave_sum(sa) * (1.0f / DM) + RMS_EPS), rb = 1.0f / sqrtf(wave_sum(sb) * (1.0f / DM) + RMS_EPS);
            if (last_layer) { f32x4* oa = (f32x4*)(C.out + (size_t)ta * DM) + lane; f32x4* ob = (f32x4*)(C.out + (size_t)tbb * DM) + lane; const f32x4* gn = (const f32x4*)C.a->in[25] + lane;
#pragma unroll
                for (int j = 0; j < 4; ++j) { const f32x4 g4 = gn[64 * j]; oa[64 * j] = xa[j] * ra * g4; if (two) ob[64 * j] = xb[j] * rb * g4; } }
            else {
                u32x2 wa_[4], wb_[4]; float qa = 0.f, qb = 0.f;
#pragma unroll
                for (int j = 0; j < 4; ++j) { wa_[j].x = pk2(xa[j].x, xa[j].y); wa_[j].y = pk2(xa[j].z, xa[j].w); wb_[j].x = pk2(xb[j].x, xb[j].y); wb_[j].y = pk2(xb[j].z, xb[j].w);
                    qa += (bflo(wa_[j].x) * bflo(wa_[j].x) + bfhi(wa_[j].x) * bfhi(wa_[j].x)) + (bflo(wa_[j].y) * bflo(wa_[j].y) + bfhi(wa_[j].y) * bfhi(wa_[j].y));
                    qb += (bflo(wb_[j].x) * bflo(wb_[j].x) + bfhi(wb_[j].x) * bfhi(wb_[j].x)) + (bflo(wb_[j].y) * bflo(wb_[j].y) + bfhi(wb_[j].y) * bfhi(wb_[j].y)); }
                const float ra2 = 1.0f / sqrtf(wave_sum(qa) * (1.0f / DM) + RMS_EPS), rb2 = 1.0f / sqrtf(wave_sum(qb) * (1.0f / DM) + RMS_EPS);
#pragma unroll
                for (int j = 0; j < 4; ++j) { xra[64 * j] = wa_[j]; if (two) xrb[64 * j] = wb_[j]; }
                if (lane == 0) { WSP(float, WS_RSTD)[ta] = ra2; if (two) WSP(float, WS_RSTD)[tbb] = rb2; } }
        }
    }
}

#ifndef PHMASK
#define PHMASK 0x3ff
#endif
#define IN(k) (((PHMASK >> ((k) == 0 ? 0 : (((k) - 1) % NPL) + 1)) & 1) && lo <= (k) && (k) < hi && ((k) == 0 || ((((k) - 1) % NPL) + 1 >= PLO && (((k) - 1) % NPL) + 1 < PHI)))
#define SEAM(k) do { if (IN(k) && IN((k) + 1)) xcd_barrier(bar); } while (0)
#ifndef REP_PHASE
#define REP_PHASE -1
#endif
#define PH_BEGIN(k) if (IN(k)) {
#define PH_END }
template <int l, int PLO = 1, int PHI = NPL + 1>
__device__ __forceinline__ void layer_phases(Ctx& C, const XcdBarrier& bar, int lo_, int hi_) {
#if MK_SPLIT
    const int lo = lo_, hi = hi_;
#else
    constexpr int lo = 0, hi = NPHASE;
#endif
        const int en = l ? EN1 : EN0; const int pb = NPL * l; const bool lastl = (l == (EN_L1 ? 1 : 0));
        LAUNDER();
        PH_BEGIN(pb + 1)
            pg8::Gemm gm{WSP(bf16_t, WS_X1), WSP(bf16_t, WS_WIN) + (size_t)l * NPROJ * 1024, T, NPROJ, DM}; pg8::StaticOrder S; S.init(T, NPROJ, C.G, C.bx);
            pg8::EpiInProj E{WSP(bf16_t, WS_PM), NPROJ, WSP(float, WS_RSTD), WSP(float, WS_FD), 10};
            pg8::gemm_phase<pg8::EpiInProj, pg8::StaticOrder, true, true>(C.lds, gm, S, E);
        PH_END
        SEAM(pb + 1);
        LAUNDER();
        PH_BEGIN(pb + 2) for (int cu = C.bx; cu < NCHK; cu += C.G) p2_unit(C, l, cu, en); PH_END
        SEAM(pb + 2);
        LAUNDER();
        PH_BEGIN(pb + 3)
            bf16_t* Y = WSP(bf16_t, WS_S1); const bf16_t* PM = WSP(bf16_t, WS_PM);
            if (en & 4) ssd_scan(C);
            if ((en & 10) == 10) {
                constexpr int FOXB = 2 * (64 * 72 * 2 + 64 * 72 * 2 + 256);
                for (int pu = C.bx; pu < 256; pu += C.G) { const int bh = pu >> 3, s = pu & 7, b = bh >> 2, h = bh & 3, row0 = b * SEQ;
#pragma unroll 1
                    for (int st = 0; st < 2; ++st) { const int qb = st ? s : 15 - s;
                        if (C.wave < 4) attn_half<64, true>(C.lds, C.tid, C.wave, C.lane, PM + C_FQ + 64 * h, NPROJ, PM + C_FK + 64 * h, NPROJ, PM + C_FV + 64 * h, NPROJ, Y + 256 + 64 * h, WSP(float, WS_CUM) + h, row0, qb, 0.125f * LOG2E);
                        else attn_half<96, false>(C.lds + FOXB, C.tid - 256, C.wave - 4, C.lane, WSP(bf16_t, WS_QM) + 96 * h, 384, WSP(bf16_t, WS_KM) + 96 * h, 384, WSP(bf16_t, WS_VM) + 64 * h, 256, Y + 768 + 64 * h, nullptr, row0, qb, 0.10206207261596575f * LOG2E); } }
            } else
            for (int pu = C.bx; pu < 256; pu += C.G) { const int bh = pu >> 3, s = pu & 7, b = bh >> 2, h = bh & 3, row0 = b * SEQ;
                if (en & 2) {
                    attn_unit<64, true>(C, PM + C_FQ + 64 * h, NPROJ, PM + C_FK + 64 * h, NPROJ, PM + C_FV + 64 * h, NPROJ, Y + 256 + 64 * h, WSP(float, WS_CUM) + h, row0, 15 - s, 0.125f * LOG2E);
                    attn_unit<64, true>(C, PM + C_FQ + 64 * h, NPROJ, PM + C_FK + 64 * h, NPROJ, PM + C_FV + 64 * h, NPROJ, Y + 256 + 64 * h, WSP(float, WS_CUM) + h, row0, s, 0.125f * LOG2E); }
                if (en & 8) {
                    attn_unit<96, false>(C, WSP(bf16_t, WS_QM) + 96 * h, 384, WSP(bf16_t, WS_KM) + 96 * h, 384, WSP(bf16_t, WS_VM) + 64 * h, 256, Y + 768 + 64 * h, nullptr, row0, 15 - s, 0.10206207261596575f * LOG2E);
                    attn_unit<96, false>(C, WSP(bf16_t, WS_QM) + 96 * h, 384, WSP(bf16_t, WS_KM) + 96 * h, 384, WSP(bf16_t, WS_VM) + 64 * h, 256, Y + 768 + 64 * h, nullptr, row0, s, 0.10206207261596575f * LOG2E); } }
        PH_END
        SEAM(pb + 3);
        LAUNDER();
        PH_BEGIN(pb + 4)
            if (en & 4) { for (int rp_ = 0; rp_ < 1 + REP_SSD; ++rp_) for (int cu = C.bx; cu < NCHK; cu += C.G) p3_ssd_unit(C, l, cu); }
        PH_END
        SEAM(pb + 4);
        LAUNDER();
        PH_BEGIN(pb + 5)
            pg8::Gemm gm{WSP(bf16_t, WS_S1), WSP(bf16_t, WS_WOUT) + (size_t)l * 1024 * 1024, T, DM, DM}; pg8::StaticOrder S; S.init(T, DM, C.G, C.bx);
            pg8::EpiResid<l == 0> E{C.a->in[0], WSP(bf16_t, WS_X1), DM};
            pg8::gemm_phase<pg8::EpiResid<l == 0>, pg8::StaticOrder, true, true>(C.lds, gm, S, E);
        PH_END
        SEAM(pb + 5);
        LAUNDER();
        PH_BEGIN(pb + 6) p5_router(C, l, en); PH_END
        SEAM(pb + 6);
        LAUNDER();
        PH_BEGIN(pb + 7) if (en & 16) {
            moe_tables(C, l);
            MoeOrder<2> S{C.G, C.bx, (const LAS int*)(C.lds + LDS_SCR + SCR_CNT), (const LAS int*)(C.lds + LDS_SCR + SCR_TBASE), (const LAS int*)(C.lds + LDS_SCR + SCR_TILEE),
                       __builtin_amdgcn_readfirstlane(*(const LAS int*)(C.lds + LDS_SCR + SCR_NT)), WSP(int, WS_ROWL)};
            pg8::Gemm gm{WSP(bf16_t, WS_X1), WSP(bf16_t, WS_BGU), T, 512, DM};
            pg8::EpiGateUp E{WSP(bf16_t, WS_HACT), 256, WSP(float, WS_ROWRS), T};
            pg8::gemm_phase_gather<pg8::EpiGateUp, MoeOrder<2>, true>(C.lds, gm, S, E); } PH_END
        SEAM(pb + 7);
        LAUNDER();
        PH_BEGIN(pb + 8) if (en & 16) {
            moe_tables(C, l);
            MoeOrder<4> S{C.G, C.bx, (const LAS int*)(C.lds + LDS_SCR + SCR_CNT), (const LAS int*)(C.lds + LDS_SCR + SCR_TBASE), (const LAS int*)(C.lds + LDS_SCR + SCR_TILEE),
                       __builtin_amdgcn_readfirstlane(*(const LAS int*)(C.lds + LDS_SCR + SCR_NT)), WSP(int, WS_ROWL)};
            int kdim = 256; asm volatile("" : "+s"(kdim));
            pg8::Gemm gm{WSP(bf16_t, WS_HACT), WSP(bf16_t, WS_BD), 160 * 256, 1024, kdim};
            pg8::EpiSlotY E{WSP(bf16_t, WS_PM), DM};
            pg8::gemm_phase<pg8::EpiSlotY, MoeOrder<4>, true, true>(C.lds, gm, S, E); } PH_END
        SEAM(pb + 8);
        LAUNDER();
        PH_BEGIN(pb + 9) p7_combine(C, l, en, lastl); PH_END
        if (!lastl && IN(pb + 9)) xcd_barrier(bar);
    }
__global__ void __launch_bounds__(NTHR, 2) hcc_fwd(Args args) {
    extern __shared__ __attribute__((aligned(16))) unsigned char lds_raw[];
    Ctx C; C.lds = (lptr)lds_raw; C.tid = threadIdx.x; C.lane = C.tid & 63; C.wave = __builtin_amdgcn_readfirstlane(C.tid >> 6); C.G = gridDim.x; C.bx = blockIdx.x;
    C.a = (const __attribute__((address_space(4))) Args*)__builtin_amdgcn_kernarg_segment_ptr(); C.out = C.a->out; C.ws = C.a->ws;
    volatile LAS unsigned* MISC = (volatile LAS unsigned*)(C.lds + LDS_CTL);
    if (C.tid < 64) MISC[C.tid] = 0u;
    __syncthreads();
    XcdBarrier bar; bar.bar = WSP(unsigned, WS_CTL) + CW_BAR; bar.x = 0; bar.st = nullptr;
    if (!MK_SPLIT) bar = xcd_barrier_post(WSP(unsigned, WS_CTL) + CW_BAR, MISC + 8);
#if MK_SPLIT
    const int lo = C.a->ph_lo, hi = C.a->ph_hi;
#else
    constexpr int lo = 0, hi = NPHASE;
#endif

    constexpr int PLO = 1, PHI = NPL + 1;
    PH_BEGIN(0) p0_prologue(C); PH_END
#if REP_PHASE == 0
    xcd_barrier(bar); p0_prologue(C);
#endif
    SEAM(0);
#if REP_PHASE >= 1 && REP_PHASE <= 9
    layer_phases<0, 1, REP_PHASE + 1>(C, bar, lo, hi); xcd_barrier(bar); layer_phases<0, REP_PHASE, NPL + 1>(C, bar, lo, hi);
#else
    layer_phases<0>(C, bar, lo, hi);
#endif
    if (EN_L1) layer_phases<1>(C, bar, lo, hi);
#undef IN
#undef SEAM
}

extern "C" void kernel_launch(void* const* d_in, const int* in_sizes, int n_in, void* d_out, int out_size, void* d_ws, size_t ws_size, hipStream_t stream) {
    static int grid = 0;
    if (grid == 0) {
        if (n_in != 26 || in_sizes[0] != T * DM || out_size != T * DM || ws_size < WS_NEED) { fprintf(stderr, "kernel_launch: unexpected shapes (n_in %d, in0 %d, out %d, ws %zu)\n", n_in, n_in > 0 ? in_sizes[0] : -1, out_size, ws_size); grid = -1; return; }
        int dev = 0, cus = 0, per_cu = 0;
        if (hipGetDevice(&dev) != hipSuccess || hipDeviceGetAttribute(&cus, hipDeviceAttributeMultiprocessorCount, dev) != hipSuccess) { grid = -1; return; }
        if (hipFuncSetAttribute((const void*)hcc_fwd, hipFuncAttributeMaxDynamicSharedMemorySize, LDS_BYTES) != hipSuccess) { fprintf(stderr, "kernel_launch: hipFuncSetAttribute failed\n"); grid = -1; return; }
        if (hipOccupancyMaxActiveBlocksPerMultiprocessor(&per_cu, (const void*)hcc_fwd, NTHR, LDS_BYTES) != hipSuccess || per_cu < 1) { fprintf(stderr, "kernel_launch: occupancy query says %d\n", per_cu); }
        (void)hipGetLastError();
        grid = cus;
    }
    if (grid < 0) return;
    if (hipMemsetAsync((char*)d_ws + WS_CTL, 0, CTL_ZERO_BYTES, stream) != hipSuccess) return;
    Args a{};
    for (int i = 0; i < 26; ++i) a.in[i] = (const float*)d_in[i];
    a.out = (float*)d_out; a.ws = (unsigned char*)d_ws;
#if MK_SPLIT
    for (int p = 0; p < NPHASE; ++p) { a.ph_lo = p; a.ph_hi = p + 1; hipLaunchKernelGGL(hcc_fwd, dim3(grid), dim3(NTHR), LDS_BYTES, stream, a); }
#else
    a.ph_lo = 0; a.ph_hi = NPHASE; hipLaunchKernelGGL(hcc_fwd, dim3(grid), dim3(NTHR), LDS_BYTES, stream, a);
#endif
}
```
